# Optimizing an MI355X kernel written in HIP

```python
import math
import jax, jax.numpy as jnp
from jax import lax
import numpy as np

D_MODEL = 1024
BATCH = 16
SEQ = 2048
DEPTH = 2

N_HEADS = 16
HEAD_DIM = D_MODEL // N_HEADS
N_A_LAYERS = DEPTH // 2
N_B_LAYERS = DEPTH - N_A_LAYERS
Q_BLOCK = 128
DILATED_GROUPS = ((128, 1), (512, 4), (2048, 16))
N_GROUPS = len(DILATED_GROUPS)
NUM_BUCKETS = 32
MAX_DISTANCE = 2048
D_FF = -(-8 * D_MODEL // (3 * 256)) * 256
RMS_EPS = 1e-6
NEG_INF = -1e30

kernel_name = "yoco_stickbreak_dilated_hybrid"


def rms_norm(x, g):
    xf = x.astype(jnp.float32)
    y = xf * lax.rsqrt(jnp.mean(xf * xf, axis=-1, keepdims=True) + RMS_EPS)
    return (y * g.astype(jnp.float32)).astype(x.dtype)


def swiglu(x, w_gate_up, w_down):
    gate, up = jnp.split(x @ w_gate_up, 2, axis=-1)
    return (jax.nn.silu(gate) * up) @ w_down


def stick_breaking_attention(q, k, v):
    b, h, s, dh = q.shape
    nb = s // Q_BLOCK
    scale = dh ** -0.5
    kf = k.astype(jnp.float32)
    vf = v.astype(jnp.float32)
    qb = q.reshape(b, h, nb, Q_BLOCK, dh).transpose(2, 0, 1, 3, 4)
    key_pos = jnp.arange(s)

    def one_block(args):
        q_blk, j = args
        z = jnp.einsum('bhqd,bhkd->bhqk', q_blk.astype(jnp.float32), kf) * scale
        q_pos = j * Q_BLOCK + jnp.arange(Q_BLOCK)
        strict = key_pos[None, :] < q_pos[:, None]
        log_stay = jnp.where(strict, jax.nn.log_sigmoid(-z), 0.0)
        after = jnp.concatenate([log_stay[..., 1:], jnp.zeros_like(log_stay[..., :1])], axis=-1)
        log_a = jax.nn.log_sigmoid(z) + lax.cumsum(after, axis=3, reverse=True)
        a = jnp.where(strict, jnp.exp(log_a), 0.0)
        return jnp.einsum('bhqk,bhkd->bhqd', a, vf)

    out = lax.map(one_block, (qb, jnp.arange(nb)))
    return out.transpose(1, 2, 0, 3, 4).reshape(b, h, s, dh).astype(q.dtype)


def mixer_a(xn, w_qkv, w_o):
    b, s, _ = xn.shape
    qkv = (xn @ w_qkv).reshape(b, s, 3, N_HEADS, HEAD_DIM)
    q = qkv[:, :, 0].transpose(0, 2, 1, 3)
    k = qkv[:, :, 1].transpose(0, 2, 1, 3)
    v = qkv[:, :, 2].transpose(0, 2, 1, 3)
    o = stick_breaking_attention(q, k, v)
    return o.transpose(0, 2, 1, 3).reshape(b, s, D_MODEL) @ w_o


def to_strided_blocks(t, dilation):
    b, s, h, dh = t.shape
    L = s // dilation
    nb = -(-L // Q_BLOCK)
    t = t.reshape(b, L, dilation, h, dh).transpose(0, 2, 3, 1, 4)
    t = jnp.pad(t, ((0, 0), (0, 0), (0, 0), (0, nb * Q_BLOCK - L), (0, 0)))
    return t.reshape(b, dilation, h, nb, Q_BLOCK, dh)


def banded_keys(kb):
    prev = jnp.concatenate([jnp.zeros_like(kb[:, :, :, :1]), kb[:, :, :, :-1]], axis=3)
    return jnp.concatenate([prev, kb], axis=4)


def from_strided_blocks(t, s):
    b, d, h, nb, blk = t.shape[:5]
    rest = t.shape[5:]
    L = s // d
    t = t.reshape((b, d, h, nb * blk) + rest)[:, :, :, :L]
    t = jnp.moveaxis(t, 3, 1)
    return t.reshape((b, s, h) + rest)


def relative_bucket(distance):
    max_exact = NUM_BUCKETS // 2
    n = jnp.maximum(distance, 0)
    large = max_exact + (jnp.log(jnp.maximum(n, 1).astype(jnp.float32) / max_exact)
                         / math.log(MAX_DISTANCE / max_exact)
                         * (NUM_BUCKETS - max_exact)).astype(jnp.int32)
    large = jnp.minimum(large, NUM_BUCKETS - 1)
    return jnp.where(n < max_exact, n, large)


def dilated_group_attention(qb, kk, vv, rel_bias, window, dilation):
    nb = qb.shape[3]
    w_sub = window // dilation
    scale = HEAD_DIM ** -0.5
    i = jnp.arange(Q_BLOCK)[:, None]
    m = jnp.arange(2 * Q_BLOCK)[None, :]
    rel = Q_BLOCK + i - m
    band = (rel >= 0) & (rel <= w_sub)
    blk = jnp.arange(nb)[:, None, None]
    valid = band[None] & (blk * Q_BLOCK - Q_BLOCK + m[None] >= 0)
    bias = rel_bias[relative_bucket(rel * dilation)]
    bias = jnp.transpose(bias, (2, 0, 1))[:, None].astype(jnp.float32)
    s = jnp.einsum('brhnqd,brhnkd->brhnqk', qb.astype(jnp.float32), kk.astype(jnp.float32)) * scale + bias
    s = jnp.where(valid, s, NEG_INF)
    lse = jax.nn.logsumexp(s, axis=-1)
    p = jnp.exp(s - lse[..., None])
    o = jnp.einsum('brhnqk,brhnkd->brhnqd', p, vv.astype(jnp.float32))
    return o, lse


def shared_kv_from(x, g_kv, w_kv):
    b, s, _ = x.shape
    kv = (rms_norm(x, g_kv) @ w_kv).reshape(b, s, N_GROUPS, 2, N_HEADS, HEAD_DIM)
    out = []
    for g, (_, dilation) in enumerate(DILATED_GROUPS):
        out.append(banded_keys(to_strided_blocks(kv[:, :, g, 0], dilation)))
        out.append(banded_keys(to_strided_blocks(kv[:, :, g, 1], dilation)))
    return out


def mixer_b(xn, shared_kv, w_q, w_o, rel_bias):
    b, s, _ = xn.shape
    q = (xn @ w_q).reshape(b, s, N_GROUPS, N_HEADS, HEAD_DIM)
    outs, lses = [], []
    for g, (window, dilation) in enumerate(DILATED_GROUPS):
        qb = to_strided_blocks(q[:, :, g], dilation)
        o, lse = dilated_group_attention(qb, shared_kv[2 * g], shared_kv[2 * g + 1], rel_bias, window, dilation)
        outs.append(from_strided_blocks(o, s))
        lses.append(from_strided_blocks(lse, s))
    o = jnp.stack(outs, axis=0)
    lse = jnp.stack(lses, axis=0)
    wts = jax.nn.softmax(lse, axis=0)
    o = jnp.sum(wts[..., None] * o, axis=0)
    return o.reshape(b, s, D_MODEL).astype(xn.dtype) @ w_o


def setup_inputs(seed: int = 0) -> dict:
    key = jax.random.key(seed)
    ks = jax.random.split(key, 12)
    f32 = jnp.float32
    d = D_MODEL
    x = jax.random.normal(ks[0], (BATCH, SEQ, d), f32)
    norm_gains = 1.0 + 0.1 * jax.random.normal(ks[1], (DEPTH, 4, d), f32)
    w_qkv_a = jax.random.normal(ks[2], (N_A_LAYERS, d, 3 * d), f32) * d ** -0.5
    w_o_a = jax.random.normal(ks[3], (N_A_LAYERS, d, d), f32) * d ** -0.5
    g_kv = 1.0 + 0.1 * jax.random.normal(ks[4], (d,), f32)
    w_kv_b = jax.random.normal(ks[5], (d, N_GROUPS * 2 * d), f32) * d ** -0.5
    w_q_b = jax.random.normal(ks[6], (N_B_LAYERS, d, N_GROUPS * d), f32) * d ** -0.5
    w_o_b = jax.random.normal(ks[7], (N_B_LAYERS, d, d), f32) * d ** -0.5
    rel_bias = 0.5 * jax.random.normal(ks[8], (NUM_BUCKETS, N_HEADS), f32)
    w_gate_up = jax.random.normal(ks[9], (DEPTH, d, 2 * D_FF), f32) * d ** -0.5
    w_down = jax.random.normal(ks[10], (DEPTH, D_FF, d), f32) * D_FF ** -0.5
    return {"x": x, "norm_gains": norm_gains, "w_qkv_a": w_qkv_a, "w_o_a": w_o_a,
            "g_kv": g_kv, "w_kv_b": w_kv_b, "w_q_b": w_q_b, "w_o_b": w_o_b,
            "rel_bias": rel_bias, "w_gate_up": w_gate_up, "w_down": w_down}


def reference(x, norm_gains, w_qkv_a, w_o_a, g_kv, w_kv_b, w_q_b, w_o_b, rel_bias, w_gate_up, w_down):
    shared_kv = None
    for layer in range(DEPTH):
        g = norm_gains[layer]
        h = rms_norm(x, g[0])
        if layer < N_A_LAYERS:
            h = mixer_a(h, w_qkv_a[layer], w_o_a[layer])
        else:
            if layer == N_A_LAYERS:
                shared_kv = shared_kv_from(x, g_kv, w_kv_b)
            j = layer - N_A_LAYERS
            h = mixer_b(h, shared_kv, w_q_b[j], w_o_b[j], rel_bias)
        x = x + rms_norm(h, g[1])
        h = swiglu(rms_norm(x, g[2]), w_gate_up[layer], w_down[layer])
        x = x + rms_norm(h, g[3])
    return x
```

```cpp
#include <hip/hip_runtime.h>
#include <hip/hip_cooperative_groups.h>
#include <cstdio>
#include <cstdint>
namespace cg = cooperative_groups;
namespace pg8 {
#define PG8_LAS __attribute__((address_space(3)))
typedef unsigned short bf16_t;
typedef short bf16x8 __attribute__((ext_vector_type(8)));
typedef float f32x4 __attribute__((ext_vector_type(4)));
typedef unsigned u32x4 __attribute__((ext_vector_type(4)));
constexpr int BM = 256, BK = 64, HALF = 128, HTB = HALF * BK * 2  , STAGE_BYTES = 8 * HTB, NXCD = 8, WGM = 8;

__host__ __device__ __forceinline__ int lds_byte(int r, int c) { const int st = (r >> 4) * 2 + (c >> 5), rr = r & 15, cc = c & 31, ob = rr * 64 + cc * 2; return st * 1024 + (ob ^ (((ob >> 9) & 1) << 5)); }
__host__ __device__ __forceinline__ void stage_rc(int b, int& R, int& C) { const int st = b / 1024, sb = b % 1024, swz = sb ^ (((sb >> 9) & 1) << 5); R = (st >> 1) * 16 + swz / 64; C = (st & 1) * 32 + (swz % 64) / 2; }
__host__ __device__ __forceinline__ int perm32(int rho) { const int n = rho >> 4, i = rho & 15; return 8 * (i >> 2) + 4 * n + (i & 3); }

struct Unit { int pm, pn; };
struct Gemm { const bf16_t* A; const bf16_t* Bt; int M, N, K; };

struct StaticOrder {
    int nM, nN, nwg, G, c;
    __host__ __device__ void init(int M, int N, int G_, int c_) { nM = M / BM; nN = N / BM; nwg = nM * nN; G = G_; c = c_; }
    __host__ __device__ bool next(int i, Unit& u) const {
        const long L = (long)i * G + c; if (L >= nwg) return false;
        int wgid = (int)L; { const int q = nwg / NXCD, r = nwg % NXCD, xcd = wgid % NXCD, off = wgid / NXCD; wgid = (xcd < r ? xcd * (q + 1) : r * (q + 1) + (xcd - r) * q) + off; }
        const int nig = WGM * nN, gid = wgid / nig, fm = gid * WGM, gsz = (nM - fm) < WGM ? (nM - fm) : WGM;
        u.pm = fm + ((wgid % nig) % gsz); u.pn = (wgid % nig) / gsz; return true;
    }
    __device__ __forceinline__ void a_ready(const Unit&) const {}
    __device__ __forceinline__ void done(const Unit&) const {}
};


typedef float f32x2_t __attribute__((ext_vector_type(2))); typedef __bf16 bf16x2_t __attribute__((ext_vector_type(2)));
__device__ __forceinline__ unsigned cvtpk(float lo, float hi) { f32x2_t v = {lo, hi}; bf16x2_t b = __builtin_convertvector(v, bf16x2_t); return __builtin_bit_cast(unsigned, b); }

struct EpiStore {
    static constexpr bool PERM = true, AFTER_DRAIN = false;
    bf16_t* O; int ldc;
    __device__ __forceinline__ void operator()(const f32x4 (&acc)[2][2][4][2], const Unit& u, int wr, int wc, int fr, int fq) const {
        const int row0 = u.pm * BM + wr * 64 + fr; const int col0 = u.pn * BM + wc * 32 + 8 * fq;
#pragma unroll
        for (int ai = 0; ai < 2; ++ai)
#pragma unroll
            for (int m = 0; m < 4; ++m) { bf16_t* rowp = O + (size_t)(row0 + ai * HALF + m * 16) * ldc + col0;
#pragma unroll
                for (int bj = 0; bj < 2; ++bj) { const f32x4 v0 = acc[ai][bj][m][0], v1 = acc[ai][bj][m][1];
                    u32x4 w; w.x = cvtpk(v0[0], v0[1]); w.y = cvtpk(v0[2], v0[3]); w.z = cvtpk(v1[0], v1[1]); w.w = cvtpk(v1[2], v1[3]);
                    *(u32x4*)(rowp + bj * HALF) = w; } }
    }
};
struct EpiSwiglu {
    static constexpr bool PERM = true, AFTER_DRAIN = false;
    bf16_t* O; int ldc;
    __device__ __forceinline__ float act(float g, float u) const { const float e = __builtin_amdgcn_exp2f(-1.4426950408889634f * g); return g * u * __builtin_amdgcn_rcpf(1.0f + e); }
    __device__ __forceinline__ void operator()(const f32x4 (&acc)[2][2][4][2], const Unit& u, int wr, int wc, int fr, int fq) const {
        const int row0 = u.pm * BM + wr * 64 + fr; const int col0 = u.pn * HALF + wc * 32 + 8 * fq;
#pragma unroll
        for (int ai = 0; ai < 2; ++ai)
#pragma unroll
            for (int m = 0; m < 4; ++m) { bf16_t* rowp = O + (size_t)(row0 + ai * HALF + m * 16) * ldc + col0;
                const f32x4 g0 = acc[ai][0][m][0], g1 = acc[ai][0][m][1], u0 = acc[ai][1][m][0], u1 = acc[ai][1][m][1];
                u32x4 w; w.x = cvtpk(act(g0[0], u0[0]), act(g0[1], u0[1])); w.y = cvtpk(act(g0[2], u0[2]), act(g0[3], u0[3]));
                w.z = cvtpk(act(g1[0], u1[0]), act(g1[1], u1[1])); w.w = cvtpk(act(g1[2], u1[2]), act(g1[3], u1[3]));
                *(u32x4*)rowp = w; }
    }
};

template <class Epi, class Sched, bool ALIGN_EPI = false, bool SP2 = false>
__device__ __forceinline__ void gemm_phase(PG8_LAS unsigned char* lds, const Gemm g, const Sched& S, const Epi& E) {
    const int tid = threadIdx.x, wid = __builtin_amdgcn_readfirstlane(tid >> 6), lane = tid & 63, wr = wid >> 2, wc = wid & 3, fr = lane & 15, fq = lane >> 4;
    const int K = g.K, nt = K / BK;
    unsigned voffA[2], voffB[2];
#pragma unroll
    for (int i = 0; i < 2; ++i) { int R, C; stage_rc(tid * 16 + i * 8192, R, C); const int Rb = Epi::PERM ? ((R & ~31) + perm32(R & 31)) : R;
        voffA[i] = (unsigned)(R * K + C) * 2u; voffB[i] = (unsigned)(Rb * K + C) * 2u; }
    const size_t kstep = (size_t)(BK * 2);
    const size_t hstep = (size_t)HALF * K * 2;
    const size_t tstep = 2 * hstep;
    const unsigned ldsw = (unsigned)wid * 1024u;
    const int aoff = lds_byte(wr * 64 + fr, fq * 8), boff = lds_byte(wc * 32 + fr, fq * 8);
#define PG8_SA(b, h) (((b) * 2 + (h)) * HTB)
#define PG8_SB(b, h) ((4 + (b) * 2 + (h)) * HTB)
#define PG8_STAGE(bufoff, gbase, voff) do { _Pragma("unroll") for (int _i = 0; _i < 2; ++_i) \
        __builtin_amdgcn_global_load_lds((const unsigned*)((const char*)(gbase) + (voff)[_i]), (PG8_LAS unsigned*)(lds + (bufoff) + ldsw + _i * 8192), 16, 0, 0); } while (0)
#define PG8_LDA(dst, b, h) do { _Pragma("unroll") for (int m = 0; m < 4; ++m) _Pragma("unroll") for (int k = 0; k < 2; ++k) dst[m][k] = *(const PG8_LAS bf16x8*)(lds + PG8_SA(b, h) + aoff + m * 2048 + k * 1024); } while (0)
#define PG8_LDB(dst, b, h) do { _Pragma("unroll") for (int n = 0; n < 2; ++n) _Pragma("unroll") for (int k = 0; k < 2; ++k) dst[n][k] = *(const PG8_LAS bf16x8*)(lds + PG8_SB(b, h) + boff + n * 2048 + k * 1024); } while (0)
#define PG8_MMA(ai, bj, At, Bt) do { __builtin_amdgcn_s_setprio(1); _Pragma("unroll") for (int m = 0; m < 4; ++m) _Pragma("unroll") for (int n = 0; n < 2; ++n) _Pragma("unroll") for (int k = 0; k < 2; ++k) \
        acc[ai][bj][m][n] = __builtin_amdgcn_mfma_f32_16x16x32_bf16(Bt[n][k], At[m][k], acc[ai][bj][m][n], 0, 0, 0); __builtin_amdgcn_s_setprio(0); } while (0)
#define PG8_WAIT_V(n) asm volatile("s_waitcnt vmcnt(" #n ")" ::: "memory")
#define PG8_WAIT_L(n) asm volatile("s_waitcnt lgkmcnt(" #n ")" ::: "memory")
#define PG8_BAR __builtin_amdgcn_s_barrier()
#define PG8_SCHED __builtin_amdgcn_sched_barrier(0)
    Unit cur, nxt; int ui = 0;
    if (!S.next(0, cur)) return;
    f32x4 acc[2][2][4][2];
#pragma unroll
    for (int a = 0; a < 2; ++a)
#pragma unroll
        for (int b = 0; b < 2; ++b)
#pragma unroll
            for (int m = 0; m < 4; ++m)
#pragma unroll
                for (int n = 0; n < 2; ++n) acc[a][b][m][n] = (f32x4){0.f, 0.f, 0.f, 0.f};
    bf16x8 At[4][2], B0[2][2], B1[2][2];
    const char* cA = (const char*)g.A + (size_t)cur.pm * tstep; const char* cB = (const char*)g.Bt + (size_t)cur.pn * tstep;
    S.a_ready(cur);
    if constexpr (SP2) {
        PG8_STAGE(PG8_SB(0, 0), cB, voffB); PG8_STAGE(PG8_SB(0, 1), cB + hstep, voffB); PG8_STAGE(PG8_SA(0, 0), cA, voffA); PG8_STAGE(PG8_SA(0, 1), cA + hstep, voffA);
        if (wr == 1) PG8_BAR;
        PG8_WAIT_V(2); PG8_BAR;
        PG8_STAGE(PG8_SB(1, 0), cB + kstep, voffB); PG8_STAGE(PG8_SA(1, 0), cA + kstep, voffA); PG8_STAGE(PG8_SB(1, 1), cB + hstep + kstep, voffB);
        PG8_WAIT_V(6); PG8_BAR;
    } else {
        PG8_STAGE(PG8_SB(0, 0), cB, voffB); PG8_STAGE(PG8_SA(0, 0), cA, voffA); PG8_STAGE(PG8_SB(0, 1), cB + hstep, voffB); PG8_STAGE(PG8_SA(0, 1), cA + hstep, voffA);
        if (wr == 1) PG8_BAR;
        PG8_WAIT_V(4); PG8_BAR;
        PG8_STAGE(PG8_SB(1, 0), cB + kstep, voffB); PG8_STAGE(PG8_SA(1, 0), cA + kstep, voffA); PG8_STAGE(PG8_SB(1, 1), cB + hstep + kstep, voffB);
        PG8_WAIT_V(6); PG8_BAR;
    }
    for (;;) {
        const bool has_next = S.next(ui + 1, nxt);
        const char* nA = has_next ? (const char*)g.A + (size_t)nxt.pm * tstep : cA; const char* nB = has_next ? (const char*)g.Bt + (size_t)nxt.pn * tstep : cB;
        for (int t = 0; t < nt; t += 2) {
            const bool last = (t == nt - 2);
            const char* a1 = cA + (size_t)(t + 1) * kstep;
            const char* a2 = last ? nA : cA + (size_t)(t + 2) * kstep; const char* b2 = last ? nB : cB + (size_t)(t + 2) * kstep;
            const char* a3 = a2 + kstep; const char* b3 = b2 + kstep;
            if (last && has_next) S.a_ready(nxt);
            if constexpr (SP2) {
            PG8_LDB(B0, 0, 0); PG8_LDB(B1, 0, 1); PG8_SCHED; PG8_LDA(At, 0, 0); PG8_STAGE(PG8_SA(1, 1), a1 + hstep, voffA);
            PG8_WAIT_V(8); PG8_WAIT_L(0); PG8_BAR; PG8_MMA(0, 0, At, B0); PG8_MMA(0, 1, At, B1); PG8_BAR; PG8_SCHED;
            PG8_LDA(At, 0, 1); PG8_STAGE(PG8_SB(0, 0), b2, voffB); PG8_STAGE(PG8_SB(0, 1), b2 + hstep, voffB); PG8_STAGE(PG8_SA(0, 0), a2, voffA);
            PG8_WAIT_V(8); PG8_WAIT_L(0); PG8_BAR; PG8_MMA(1, 0, At, B0); PG8_MMA(1, 1, At, B1); PG8_BAR; PG8_SCHED;
            PG8_LDB(B0, 1, 0); PG8_LDB(B1, 1, 1); PG8_SCHED; PG8_LDA(At, 1, 0); PG8_STAGE(PG8_SA(0, 1), a2 + hstep, voffA);
            PG8_WAIT_V(8); PG8_WAIT_L(0); PG8_BAR; PG8_MMA(0, 0, At, B0); PG8_MMA(0, 1, At, B1); PG8_BAR; PG8_SCHED;
            PG8_LDA(At, 1, 1); PG8_STAGE(PG8_SB(1, 0), b3, voffB); PG8_STAGE(PG8_SB(1, 1), b3 + hstep, voffB); PG8_STAGE(PG8_SA(1, 0), a3, voffA);
            PG8_WAIT_V(8); PG8_WAIT_L(0); PG8_BAR; PG8_MMA(1, 0, At, B0); PG8_MMA(1, 1, At, B1); PG8_BAR; PG8_SCHED;
            } else {
            PG8_LDB(B0, 0, 0); PG8_SCHED; PG8_LDA(At, 0, 0); PG8_STAGE(PG8_SA(1, 1), a1 + hstep, voffA);
            PG8_WAIT_L(8); PG8_BAR; PG8_WAIT_L(0); PG8_MMA(0, 0, At, B0); PG8_BAR; PG8_SCHED;
            PG8_LDB(B1, 0, 1); PG8_STAGE(PG8_SB(0, 0), b2, voffB);
            PG8_BAR; PG8_WAIT_L(0); PG8_MMA(0, 1, At, B1); PG8_BAR;
            PG8_LDA(At, 0, 1); PG8_STAGE(PG8_SA(0, 0), a2, voffA);
            PG8_BAR; PG8_WAIT_L(0); PG8_MMA(1, 0, At, B0); PG8_BAR; PG8_SCHED;
            PG8_STAGE(PG8_SB(0, 1), b2 + hstep, voffB);
            PG8_WAIT_V(6); PG8_BAR; PG8_MMA(1, 1, At, B1); PG8_BAR;
            PG8_LDB(B0, 1, 0); PG8_SCHED; PG8_LDA(At, 1, 0); PG8_STAGE(PG8_SA(0, 1), a2 + hstep, voffA);
            PG8_WAIT_L(8); PG8_BAR; PG8_WAIT_L(0); PG8_MMA(0, 0, At, B0); PG8_BAR; PG8_SCHED;
            PG8_LDB(B1, 1, 1); PG8_STAGE(PG8_SB(1, 0), b3, voffB);
            PG8_BAR; PG8_WAIT_L(0); PG8_MMA(0, 1, At, B1); PG8_BAR;
            PG8_LDA(At, 1, 1); PG8_STAGE(PG8_SA(1, 0), a3, voffA);
            PG8_BAR; PG8_WAIT_L(0); PG8_MMA(1, 0, At, B0); PG8_BAR; PG8_SCHED;
            PG8_STAGE(PG8_SB(1, 1), b3 + hstep, voffB);
            PG8_WAIT_V(6); PG8_BAR; PG8_MMA(1, 1, At, B1); PG8_BAR;
            }
        }
        if constexpr (ALIGN_EPI) { if (wr == 0) PG8_BAR; }
        if constexpr (!Epi::AFTER_DRAIN) { E(acc, cur, wr, wc, fr, fq); S.done(cur); }
        if (!has_next) break;
#pragma unroll
        for (int a = 0; a < 2; ++a)
#pragma unroll
            for (int b = 0; b < 2; ++b)
#pragma unroll
                for (int m = 0; m < 4; ++m)
#pragma unroll
                    for (int n = 0; n < 2; ++n) acc[a][b][m][n] = (f32x4){0.f, 0.f, 0.f, 0.f};
        cur = nxt; cA = nA; cB = nB; ++ui;
        if constexpr (ALIGN_EPI) { if (wr == 1) PG8_BAR; }
    }
    PG8_WAIT_V(0);
    if constexpr (!ALIGN_EPI) { if (wr == 0) PG8_BAR; }
    PG8_BAR;
    if constexpr (Epi::AFTER_DRAIN) { E.fused(acc, cur, wr, wc, fr, fq, lds, wid, lane); S.done(cur); }
#undef PG8_SA
#undef PG8_SB
#undef PG8_STAGE
#undef PG8_LDA
#undef PG8_LDB
#undef PG8_MMA
#undef PG8_WAIT_V
#undef PG8_WAIT_L
#undef PG8_BAR
#undef PG8_SCHED
}
}

#define LAS __attribute__((address_space(3)))
typedef pg8::bf16_t bf16_t; typedef pg8::bf16x8 bf16x8; typedef pg8::f32x4 f32x4; typedef pg8::u32x4 u32x4;
typedef float f32x16 __attribute__((ext_vector_type(16)));
typedef unsigned u32x2 __attribute__((ext_vector_type(2)));
typedef short v4i16_t __attribute__((ext_vector_type(4)));
using pg8::cvtpk;

constexpr int BATCH = 16, SEQ = 2048, DM = 1024, NH = 16, HD = 64, DFF = 2816, MROWS = BATCH * SEQ;
constexpr float RMS_EPS = 1e-6f;
constexpr float LOG2E = 1.4426950408889634f;
constexpr float QSCALE = 0.125f * LOG2E;
constexpr size_t MiB = 1u << 20;
constexpr size_t WS_WQKVA = 1 * MiB, WS_WOA = 7 * MiB, WS_WGU0 = 9 * MiB, WS_WD0 = 20 * MiB, WS_WB = 26 * MiB  , WS_WOB = 44 * MiB,
                 WS_WGU1 = 46 * MiB, WS_WD1 = 57 * MiB, WS_BIAS = 63 * MiB, WS_XN = 65 * MiB, WS_QKV = 129 * MiB, WS_ACT = 129 * MiB  ,
                 WS_OB = 321 * MiB, WS_H = 385 * MiB, WS_LSE0 = 449 * MiB, WS_LSE1 = 451 * MiB, WS_END = 453 * MiB;
constexpr int LDS_BYTES = 147456;

struct Params { const float *x, *gains, *w_qkv_a, *w_o_a, *g_kv, *w_kv_b, *w_q_b, *w_o_b, *rel_bias, *w_gu, *w_down; float* out; unsigned char* ws; };

#define LDS_WAIT() asm volatile("s_waitcnt lgkmcnt(0)" ::: "memory")
__device__ __forceinline__ float wave_sum(float v) {
#pragma unroll
    for (int o = 1; o < 64; o <<= 1) v += __shfl_xor(v, o);
    return v;
}
__device__ __forceinline__ int crow(int r, int hi) { return (r & 3) + 8 * (r >> 2) + 4 * hi; }
__device__ __forceinline__ float bf_lo(unsigned w) { return __uint_as_float(w << 16); }
__device__ __forceinline__ float bf_hi(unsigned w) { return __uint_as_float(w & 0xffff0000u); }

__device__ __forceinline__ void conv_item(const float* __restrict__ W, int ldw, int col, int K, const float* __restrict__ gain, float scale, bf16_t* WT, int drow, LAS float* scr, int kb, int lane) {
    const int k0 = 64 * kb;
#pragma unroll 8
    for (int i = 0; i < 32; ++i) { const int kk = 2 * i + (lane >> 5); const float v = W[(size_t)(k0 + kk) * ldw + col + (lane & 31)];
        const float gs = gain ? gain[k0 + kk] * scale : scale; scr[kk * 33 + (lane & 31)] = v * gs; }
    LDS_WAIT();
    const int c = lane & 7;
#pragma unroll
    for (int j = 0; j < 4; ++j) { const int n = (lane >> 3) + 8 * j; const LAS float* s = scr + (8 * c) * 33 + n;
        u32x4 o; o.x = cvtpk(s[0 * 33], s[1 * 33]); o.y = cvtpk(s[2 * 33], s[3 * 33]); o.z = cvtpk(s[4 * 33], s[5 * 33]); o.w = cvtpk(s[6 * 33], s[7 * 33]);
        *(u32x4*)(WT + (size_t)(drow + n) * K + k0 + 8 * c) = o; }
    LDS_WAIT();
}
template <int MODE> __device__ __forceinline__ void conv_seg(const float* src, int ld, int col0, int ncols, int K, const float* gain, float scale, bf16_t* dst, int drow0,
                                                             LAS float* scr, int gw, int NGW, int& off, int lane) {
    const int nblk = ncols >> 5, items = nblk * (K >> 6);
    int it0 = gw - (off % NGW); if (it0 < 0) it0 += NGW; off += items;
    for (int it = it0; it < items; it += NGW) {
        const int kb = it / nblk, nb = it - kb * nblk, c = 32 * nb; int drow;
        if (MODE == 1) { const int upf = c >= DFF ? 1 : 0, cc = c - upf * DFF; drow = 256 * (cc >> 7) + 128 * upf + (cc & 127); } else drow = drow0 + c;
        conv_item(src, ld, col0 + c, K, gain, scale, dst, drow, scr, kb, lane);
    }
}
__device__ __forceinline__ void norm_row_bf16(const float* xrow, bf16_t* orow, int lane) {
    const f32x4* xr = (const f32x4*)xrow + lane;
    f32x4 v[4]; float s = 0.f;
#pragma unroll
    for (int j = 0; j < 4; ++j) { v[j] = xr[64 * j]; s += (v[j].x * v[j].x + v[j].y * v[j].y) + (v[j].z * v[j].z + v[j].w * v[j].w); }
    const float r = 1.0f / sqrtf(wave_sum(s) * (1.f / DM) + RMS_EPS);
    u32x2* o8 = (u32x2*)orow + lane;
#pragma unroll
    for (int j = 0; j < 4; ++j) { u32x2 w; w.x = cvtpk(v[j].x * r, v[j].y * r); w.y = cvtpk(v[j].z * r, v[j].w * r); o8[64 * j] = w; }
}
__device__ __forceinline__ void prologue(const Params& P, LAS unsigned char* lds, int tid, int lane, int wave) {
    LAS float* scr = (LAS float*)(lds + wave * 16384);
    const int G = gridDim.x, gw = blockIdx.x * 8 + wave, NGW = G * 8;
    unsigned char* ws = P.ws; int off = 0;
    const float* g00 = P.gains + 0 * DM; const float* g02 = P.gains + 2 * DM; const float* g10 = P.gains + 4 * DM; const float* g12 = P.gains + 6 * DM;
    conv_seg<0>(P.w_qkv_a, 3072, 0, 1024, 1024, g00, QSCALE, (bf16_t*)(ws + WS_WQKVA), 0, scr, gw, NGW, off, lane);
    conv_seg<0>(P.w_qkv_a, 3072, 1024, 2048, 1024, g00, 1.0f, (bf16_t*)(ws + WS_WQKVA), 1024, scr, gw, NGW, off, lane);
    conv_seg<0>(P.w_o_a, 1024, 0, 1024, 1024, nullptr, 1.0f, (bf16_t*)(ws + WS_WOA), 0, scr, gw, NGW, off, lane);
    conv_seg<1>(P.w_gu, 2 * DFF, 0, 2 * DFF, 1024, g02, 1.0f, (bf16_t*)(ws + WS_WGU0), 0, scr, gw, NGW, off, lane);
    conv_seg<0>(P.w_down, 1024, 0, 1024, DFF, nullptr, 1.0f, (bf16_t*)(ws + WS_WD0), 0, scr, gw, NGW, off, lane);
    for (int g = 0; g < 3; ++g) {
        bf16_t* wb = (bf16_t*)(ws + WS_WB + (size_t)g * 6 * MiB);
        conv_seg<0>(P.w_q_b, 3072, 1024 * g, 1024, 1024, g10, QSCALE, wb, 0, scr, gw, NGW, off, lane);
        conv_seg<0>(P.w_kv_b, 6144, 2048 * g, 2048, 1024, P.g_kv, 1.0f, wb, 1024, scr, gw, NGW, off, lane);
    }
    conv_seg<0>(P.w_o_b, 1024, 0, 1024, 1024, nullptr, 1.0f, (bf16_t*)(ws + WS_WOB), 0, scr, gw, NGW, off, lane);
    conv_seg<1>(P.w_gu + (size_t)DM * 2 * DFF, 2 * DFF, 0, 2 * DFF, 1024, g12, 1.0f, (bf16_t*)(ws + WS_WGU1), 0, scr, gw, NGW, off, lane);
    conv_seg<0>(P.w_down + (size_t)DFF * DM, 1024, 0, 1024, DFF, nullptr, 1.0f, (bf16_t*)(ws + WS_WD1), 0, scr, gw, NGW, off, lane);
    bf16_t* XN = (bf16_t*)(ws + WS_XN);
    for (int m = gw; m < MROWS; m += NGW) norm_row_bf16(P.x + (size_t)m * DM, XN + (size_t)m * DM, lane);
    float* BT = (float*)(ws + WS_BIAS);
    for (int idx = blockIdx.x * 512 + tid; idx < 3 * 16 * 192; idx += G * 512) {
        const int g = idx / 3072, rem = idx - g * 3072, h = rem / 192, e = rem - h * 192, rel = e - 32; float v = 0.f;
        if (rel >= 0 && rel <= 128) { const int dl = (g == 0) ? 1 : ((g == 1) ? 4 : 16); const int n = rel * dl; int bk;
            if (n < 16) bk = n;
            else { bk = 16 + (n >= 22) + (n >= 30) + (n >= 40) + (n >= 54) + (n >= 73) + (n >= 99) + (n >= 134) + (n >= 182) + (n >= 246) + (n >= 332) + (n >= 450) + (n >= 609) + (n >= 825) + (n >= 1117) + (n >= 1513); }
            v = P.rel_bias[bk * 16 + h] * LOG2E; }
        BT[idx] = v;
    }
}

__device__ __forceinline__ void norm_res_phase(const bf16_t* H, const float* gain, const float* Xin, float* Xout, bf16_t* XN, int lane, int wave) {
    const int gw = blockIdx.x * 8 + wave, NGW = gridDim.x * 8;
    f32x4 gv[4];
#pragma unroll
    for (int j = 0; j < 4; ++j) gv[j] = *((const f32x4*)gain + lane + 64 * j);
    for (int m = gw; m < MROWS; m += NGW) {
        const u32x2* hp = (const u32x2*)(H + (size_t)m * DM) + lane;
        const f32x4* xp = (const f32x4*)(Xin + (size_t)m * DM) + lane;
        f32x4 hv[4], xv[4]; float ss = 0.f;
#pragma unroll
        for (int j = 0; j < 4; ++j) { const u32x2 w = hp[64 * j]; xv[j] = xp[64 * j]; hv[j] = (f32x4){bf_lo(w.x), bf_hi(w.x), bf_lo(w.y), bf_hi(w.y)};
            ss += (hv[j].x * hv[j].x + hv[j].y * hv[j].y) + (hv[j].z * hv[j].z + hv[j].w * hv[j].w); }
        const float r = 1.0f / sqrtf(wave_sum(ss) * (1.f / DM) + RMS_EPS);
        float s2 = 0.f; f32x4* op = (f32x4*)(Xout + (size_t)m * DM) + lane;
#pragma unroll
        for (int j = 0; j < 4; ++j) { xv[j] = xv[j] + hv[j] * r * gv[j]; op[64 * j] = xv[j];
            s2 += (xv[j].x * xv[j].x + xv[j].y * xv[j].y) + (xv[j].z * xv[j].z + xv[j].w * xv[j].w); }
        if (XN) { const float r2 = 1.0f / sqrtf(wave_sum(s2) * (1.f / DM) + RMS_EPS); u32x2* o8 = (u32x2*)(XN + (size_t)m * DM) + lane;
#pragma unroll
            for (int j = 0; j < 4; ++j) { u32x2 w; w.x = cvtpk(xv[j].x * r2, xv[j].y * r2); w.y = cvtpk(xv[j].z * r2, xv[j].w * r2); o8[64 * j] = w; } }
    }
}

__device__ __forceinline__ bf16x8 vfrag(const LAS unsigned char* p) {
    const v4i16_t lo = __builtin_amdgcn_ds_read_tr16_b64_v4i16((LAS v4i16_t*)p);
    const v4i16_t hi = __builtin_amdgcn_ds_read_tr16_b64_v4i16((LAS v4i16_t*)(p + 512));
    return (bf16x8){lo[0], lo[1], lo[2], lo[3], hi[0], hi[1], hi[2], hi[3]};
}
__device__ __forceinline__ bf16x8 pack8(const float* a) {
    u32x4 w; w.x = cvtpk(a[0], a[1]); w.y = cvtpk(a[2], a[3]); w.z = cvtpk(a[4], a[5]); w.w = cvtpk(a[6], a[7]); return __builtin_bit_cast(bf16x8, w);
}

template <bool MASK> __device__ __forceinline__ void sb_subtile(const LAS unsigned char* kbuf, const LAS unsigned char* vbuf  , int sub, const bf16x8 (&qf)[4], const int (&kaddr)[4],
                                                                float& carry, f32x16 (&o)[2], int r32, int hh) {
    f32x16 S = {};
#pragma unroll
    for (int dk = 0; dk < 4; ++dk) { const bf16x8 kf = *(const LAS bf16x8*)(kbuf + kaddr[dk] + sub * 512); S = __builtin_amdgcn_mfma_f32_32x32x16_bf16(kf, qf[dk], S, 0, 0, 0); }
    float p[16];
#pragma unroll
    for (int r = 0; r < 16; ++r) { const float u = __builtin_amdgcn_exp2f(fminf(S[r], 120.f)); float wv = __builtin_amdgcn_rcpf(1.0f + u);
        if (MASK) wv = (crow(r, hh) < r32) ? wv : 1.0f; p[r] = wv; }
    float go[4], t[4];
#pragma unroll
    for (int i = 0; i < 4; ++i) { p[4 * i + 2] *= p[4 * i + 3]; p[4 * i + 1] *= p[4 * i + 2]; p[4 * i] *= p[4 * i + 1]; go[i] = __shfl_xor(p[4 * i], 32); t[i] = p[4 * i] * go[i]; }
    const float R2 = t[3], R1 = t[3] * t[2], R0 = R1 * t[1];
    float E[4];
    E[3] = carry * (hh ? 1.0f : go[3]); E[2] = carry * R2 * (hh ? 1.0f : go[2]); E[1] = carry * R1 * (hh ? 1.0f : go[1]); E[0] = carry * R0 * (hh ? 1.0f : go[0]);
    carry = carry * R0 * t[0];
    float A[16];
#pragma unroll
    for (int i = 0; i < 4; ++i) { const float I3 = E[i] * p[4 * i + 3], I2 = E[i] * p[4 * i + 2], I1 = E[i] * p[4 * i + 1], I0 = E[i] * p[4 * i];
        A[4 * i + 3] = E[i] - I3; A[4 * i + 2] = I3 - I2; A[4 * i + 1] = I2 - I1; A[4 * i] = I1 - I0; }
    const bf16x8 pf0 = pack8(A), pf1 = pack8(A + 8);
#pragma unroll
    for (int dh = 0; dh < 2; ++dh) {
        const bf16x8 v0 = vfrag(vbuf + dh * 4096 + (32 * sub) * 64), v1 = vfrag(vbuf + dh * 4096 + (32 * sub + 16) * 64);
        o[dh] = __builtin_amdgcn_mfma_f32_32x32x16_bf16(pf0, v0, o[dh], 0, 0, 0);
        o[dh] = __builtin_amdgcn_mfma_f32_32x32x16_bf16(pf1, v1, o[dh], 0, 0, 0);
    }
}

__device__ __forceinline__ void attnA_phase(LAS unsigned char* lds, const bf16_t* __restrict__ QKV, bf16_t* __restrict__ O, int tid, int lane, int wid) {
    const int r32 = lane & 31, hh = lane >> 5;
    int kaddr[4];
#pragma unroll
    for (int dk = 0; dk < 4; ++dk) { const int c = 2 * dk + hh; kaddr[dk] = c * 1024 + ((r32 ^ c) << 4); }
    const int vlane = (4 * hh + ((lane & 15) >> 2)) * 64 + ((lane >> 4) & 1) * 32 + (lane & 3) * 8;
    const int lkey = tid >> 3, lc = tid & 7;
    const int kwoff = lc * 1024 + ((lkey ^ lc) << 4), vwoff = 16384 + (lc >> 2) * 4096 + lkey * 64 + (lc & 3) * 16;
    for (int u = blockIdx.x; u < BATCH * NH * 8; u += gridDim.x) {
        const int bh = u >> 3, qb = ((u & 7) + (u >> 8)) & 7, b = bh >> 4, h = bh & 15;
        const size_t rowbase = (size_t)b * SEQ; const int q0 = qb * 256, R0 = q0 + 32 * wid;
        bf16x8 qf[4];
        { const bf16_t* qp = QKV + (rowbase + R0 + r32) * 3072 + h * 64 + 8 * hh;
#pragma unroll
          for (int dk = 0; dk < 4; ++dk) qf[dk] = *(const bf16x8*)(qp + 16 * dk); }
        const bf16_t* kvg = QKV + (rowbase + lkey) * 3072 + 1024 + h * 64 + 8 * lc;
        const int NT = 4 * qb + 4;
        { const bf16_t* kg = kvg + (size_t)(64 * (NT - 1)) * 3072; const u32x4 kr = *(const u32x4*)kg, vr = *(const u32x4*)(kg + 1024);
          *(LAS u32x4*)(lds + kwoff) = kr; *(LAS u32x4*)(lds + vwoff) = vr; }
        __syncthreads();
        float carry = 1.0f; f32x16 o[2]; o[0] = f32x16{}; o[1] = f32x16{};
        int cur = 0;
        for (int kt = NT - 1; kt >= 0; --kt) {
            u32x4 kr, vr;
            if (kt > 0) { const bf16_t* kg = kvg + (size_t)(64 * (kt - 1)) * 3072; kr = *(const u32x4*)kg; vr = *(const u32x4*)(kg + 1024); }
            const int diff = R0 - 64 * kt;
            const LAS unsigned char* kbuf = lds + cur * 8192; const LAS unsigned char* vbuf = lds + 16384 + cur * 8192 + vlane;
            if (diff >= 64) { sb_subtile<false>(kbuf, vbuf, 1, qf, kaddr, carry, o, r32, hh); sb_subtile<false>(kbuf, vbuf, 0, qf, kaddr, carry, o, r32, hh); }
            else if (diff == 32) { sb_subtile<true>(kbuf, vbuf, 1, qf, kaddr, carry, o, r32, hh); sb_subtile<false>(kbuf, vbuf, 0, qf, kaddr, carry, o, r32, hh); }
            else if (diff == 0) { sb_subtile<true>(kbuf, vbuf, 0, qf, kaddr, carry, o, r32, hh); }
            if (kt > 0) { *(LAS u32x4*)(lds + (cur ^ 1) * 8192 + kwoff) = kr; *(LAS u32x4*)(lds + (cur ^ 1) * 8192 + vwoff) = vr; }
            __syncthreads();
            cur ^= 1;
        }
        bf16_t* op = O + (rowbase + R0) * DM + h * 64 + r32;
#pragma unroll
        for (int r = 0; r < 16; ++r) { const int qq = crow(r, hh);
#pragma unroll
            for (int dh = 0; dh < 2; ++dh) op[(size_t)qq * DM + 32 * dh] = (bf16_t)(cvtpk(o[dh][r], 0.f) & 0xffffu); }
    }
}

template <int DL, bool FINAL> __device__ __forceinline__ void attnB_phase(LAS unsigned char* lds, const bf16_t* __restrict__ QKV, bf16_t* O, float* lse_out, const float* __restrict__ BT,
                                                                          const bf16_t* O1, const float* lse0, const float* lse1, int tid, int lane, int wid) {
    constexpr int NB = 16 / DL;
    const int r32 = lane & 31, hh = lane >> 5, half = wid >> 2, wq = wid & 3, ht = tid & 255;
    LAS unsigned char* kb = lds + half * 65536; LAS unsigned char* vb = kb + 32768;
    LAS float* bl = (LAS float*)(lds + 131072 + half * 768);
    LAS float* scr = (LAS float*)(lds + 131072 + 1536 + wid * 256);
    int kaddr[4];
#pragma unroll
    for (int dk = 0; dk < 4; ++dk) { const int c = 2 * dk + hh; kaddr[dk] = c * 4096 + ((r32 ^ c) << 4); }
    const int vlane = (4 * hh + ((lane & 15) >> 2)) * 64 + ((lane >> 4) & 1) * 32 + (lane & 3) * 8;
    const int key_in = ht >> 3, c8 = ht & 7;
    for (int p = blockIdx.x; p < BATCH * NH * 8; p += gridDim.x) {
        const int u = 2 * p + half, bh = u >> 4, cc = u & 15, b = bh >> 4, h = bh & 15, rr = cc / NB, n = cc % NB;
        __syncthreads();
#pragma unroll
        for (int batch = 0; batch < 2; ++batch) {
            if (batch == 0 && n == 0) continue;
            u32x4 kr[4], vr[4];
#pragma unroll
            for (int i = 0; i < 4; ++i) { const int m = 32 * (batch * 4 + i) + key_in; const int idx = (n - 1) * 128 + m;
                const bf16_t* kg = QKV + ((size_t)b * SEQ + (size_t)(idx * DL + rr)) * 3072 + 1024 + h * 64 + 8 * c8; kr[i] = *(const u32x4*)kg; vr[i] = *(const u32x4*)(kg + 1024); }
#pragma unroll
            for (int i = 0; i < 4; ++i) { const int m = 32 * (batch * 4 + i) + key_in;
                *(LAS u32x4*)(kb + c8 * 4096 + ((m ^ c8) << 4)) = kr[i]; *(LAS u32x4*)(vb + (c8 >> 2) * 16384 + m * 64 + (c8 & 3) * 16) = vr[i]; }
        }
        if (ht < 192) bl[ht] = BT[h * 192 + ht];
        bf16x8 qf[4];
        { const int i = 32 * wq + r32; const bf16_t* qp = QKV + ((size_t)b * SEQ + (size_t)((n * 128 + i) * DL + rr)) * 3072 + h * 64 + 8 * hh;
#pragma unroll
          for (int dk = 0; dk < 4; ++dk) qf[dk] = *(const bf16x8*)(qp + 16 * dk); }
        __syncthreads();
        const int jstart = (n == 0) ? (4 - wq) : 0;
        const LAS float* blp = bl + 160 + r32 - 4 * hh;
        f32x16 S[5];
        float mx = -INFINITY;
#pragma unroll
        for (int jj = 0; jj < 5; ++jj) {
            if (jj >= jstart) {
                f32x16 s = {};
#pragma unroll
                for (int dk = 0; dk < 4; ++dk) { const bf16x8 kf = *(const LAS bf16x8*)(kb + kaddr[dk] + (wq + jj) * 512); s = __builtin_amdgcn_mfma_f32_32x32x16_bf16(kf, qf[dk], s, 0, 0, 0); }
#pragma unroll
                for (int r = 0; r < 16; ++r) { const int kk = crow(r, hh); float v = s[r] + blp[-(32 * jj + (r & 3) + 8 * (r >> 2))];
                    if (jj == 0) v = (kk >= r32) ? v : -INFINITY;
                    if (jj == 4) v = (kk <= r32) ? v : -INFINITY;
                    s[r] = v; mx = fmaxf(mx, v); }
                S[jj] = s;
            } else {
#pragma unroll
                for (int r = 0; r < 16; ++r) S[jj][r] = -INFINITY;
            }
        }
        mx = fmaxf(mx, __shfl_xor(mx, 32));
        float l = 0.f; f32x16 o[2]; o[0] = f32x16{}; o[1] = f32x16{};
#pragma unroll
        for (int jj = 0; jj < 5; ++jj) {
            float pe[16];
#pragma unroll
            for (int r = 0; r < 16; ++r) { pe[r] = __builtin_amdgcn_exp2f(S[jj][r] - mx); l += pe[r]; }
            if (jj >= jstart) {
                const bf16x8 pf0 = pack8(pe), pf1 = pack8(pe + 8);
#pragma unroll
                for (int dh = 0; dh < 2; ++dh) {
                    const LAS unsigned char* vp = vb + dh * 16384 + (32 * (wq + jj)) * 64 + vlane;
                    const bf16x8 v0 = vfrag(vp), v1 = vfrag(vp + 16 * 64);
                    o[dh] = __builtin_amdgcn_mfma_f32_32x32x16_bf16(pf0, v0, o[dh], 0, 0, 0);
                    o[dh] = __builtin_amdgcn_mfma_f32_32x32x16_bf16(pf1, v1, o[dh], 0, 0, 0);
                }
            }
        }
        l += __shfl_xor(l, 32);
        const float lse2 = mx + __builtin_amdgcn_logf(l);
        if (hh == 0) { scr[r32] = __builtin_amdgcn_rcpf(l); scr[32 + r32] = lse2; }
        const size_t rowq0 = (size_t)b * SEQ + (size_t)((n * 128 + 32 * wq) * DL + rr);
        if (!FINAL) { if (hh == 0) lse_out[(rowq0 + (size_t)r32 * DL) * 16 + h] = lse2; }
        LDS_WAIT();
#pragma unroll
        for (int r = 0; r < 16; ++r) { const int qq = crow(r, hh); const size_t row = rowq0 + (size_t)qq * DL; const float linv = scr[qq];
            bf16_t* op = O + row * DM + h * 64 + r32;
            if (!FINAL) {
#pragma unroll
                for (int dh = 0; dh < 2; ++dh) op[32 * dh] = (bf16_t)(cvtpk(o[dh][r] * linv, 0.f) & 0xffffu);
            } else {
                const float l0 = lse0[row * 16 + h], l1 = lse1[row * 16 + h], l2 = scr[32 + qq];
                const float M = fmaxf(fmaxf(l0, l1), l2); const float e0 = __builtin_amdgcn_exp2f(l0 - M), e1 = __builtin_amdgcn_exp2f(l1 - M), e2 = __builtin_amdgcn_exp2f(l2 - M);
                const float inv = __builtin_amdgcn_rcpf(e0 + e1 + e2); const float w0 = e0 * inv, w1 = e1 * inv, w2 = e2 * inv * linv;
                const bf16_t* o1p = O1 + row * DM + h * 64 + r32;
#pragma unroll
                for (int dh = 0; dh < 2; ++dh) { const float a0 = __uint_as_float((unsigned)op[32 * dh] << 16), a1 = __uint_as_float((unsigned)o1p[32 * dh] << 16);
                    op[32 * dh] = (bf16_t)(cvtpk(w0 * a0 + w1 * a1 + w2 * o[dh][r], 0.f) & 0xffffu); }
            }
        }
    }
}

enum { K_PRO = 0, K_GS, K_GW, K_NR, K_AA, K_AB0, K_AB1, K_AB2 };
__global__ void __launch_bounds__(512, 2) yoco_fwd(Params P) {
    extern __shared__ __attribute__((aligned(16))) unsigned char lds_raw[];
    LAS unsigned char* lds = (LAS unsigned char*)lds_raw;
    cg::grid_group grid = cg::this_grid();
    constexpr int NPH = 19;
    grid.sync();
    for (int ph = 0; ph < NPH; ++ph) {
        int tid = threadIdx.x; asm volatile("" : "+v"(tid));
        const int lane = tid & 63, wid = __builtin_amdgcn_readfirstlane(tid >> 6);
        unsigned char* ws = P.ws; asm volatile("" : "+s"(ws));
        bf16_t* XN = (bf16_t*)(ws + WS_XN); bf16_t* QKV = (bf16_t*)(ws + WS_QKV); bf16_t* ACT = (bf16_t*)(ws + WS_ACT); bf16_t* OB = (bf16_t*)(ws + WS_OB); bf16_t* H = (bf16_t*)(ws + WS_H);
        float* LSE0 = (float*)(ws + WS_LSE0); float* LSE1 = (float*)(ws + WS_LSE1); const float* BT = (const float*)(ws + WS_BIAS);
        int kind = K_PRO; const bf16_t* A = nullptr; const bf16_t* Bt = nullptr; int N = 0, K = 0; bf16_t* Oo = nullptr;
        const float* gain = nullptr; const float* Xin = P.out; bf16_t* XNo = XN;
        switch (ph) {
            case 0: kind = K_PRO; break;
            case 1: kind = K_GS; A = XN; Bt = (const bf16_t*)(ws + WS_WQKVA); N = 3072; K = 1024; Oo = QKV; break;
            case 2: kind = K_AA; break;
            case 3: kind = K_GS; A = OB; Bt = (const bf16_t*)(ws + WS_WOA); N = 1024; K = 1024; Oo = H; break;
            case 4: kind = K_NR; gain = P.gains + 1 * DM; Xin = P.x; break;
            case 5: kind = K_GW; A = XN; Bt = (const bf16_t*)(ws + WS_WGU0); break;
            case 6: kind = K_GS; A = ACT; Bt = (const bf16_t*)(ws + WS_WD0); N = 1024; K = DFF; Oo = H; break;
            case 7: kind = K_NR; gain = P.gains + 3 * DM; break;
            case 8: kind = K_GS; A = XN; Bt = (const bf16_t*)(ws + WS_WB); N = 3072; K = 1024; Oo = QKV; break;
            case 9: kind = K_AB0; break;
            case 10: kind = K_GS; A = XN; Bt = (const bf16_t*)(ws + WS_WB + 6 * MiB); N = 3072; K = 1024; Oo = QKV; break;
            case 11: kind = K_AB1; break;
            case 12: kind = K_GS; A = XN; Bt = (const bf16_t*)(ws + WS_WB + 12 * MiB); N = 3072; K = 1024; Oo = QKV; break;
            case 13: kind = K_AB2; break;
            case 14: kind = K_GS; A = OB; Bt = (const bf16_t*)(ws + WS_WOB); N = 1024; K = 1024; Oo = H; break;
            case 15: kind = K_NR; gain = P.gains + 5 * DM; break;
            case 16: kind = K_GW; A = XN; Bt = (const bf16_t*)(ws + WS_WGU1); break;
            case 17: kind = K_GS; A = ACT; Bt = (const bf16_t*)(ws + WS_WD1); N = 1024; K = DFF; Oo = H; break;
            default: kind = K_NR; gain = P.gains + 7 * DM; XNo = nullptr; break;
        }
        if (kind == K_PRO) prologue(P, lds, tid, lane, wid);
        else if (kind == K_GS) { pg8::Gemm g{A, Bt, MROWS, N, K}; pg8::StaticOrder S; S.init(MROWS, N, (int)gridDim.x, (int)blockIdx.x); pg8::EpiStore E{Oo, N};
            pg8::gemm_phase<pg8::EpiStore, pg8::StaticOrder, true, true>(lds, g, S, E); }
        else if (kind == K_GW) { pg8::Gemm g{A, Bt, MROWS, 2 * DFF, DM}; pg8::StaticOrder S; S.init(MROWS, 2 * DFF, (int)gridDim.x, (int)blockIdx.x); pg8::EpiSwiglu E{ACT, DFF};
            pg8::gemm_phase<pg8::EpiSwiglu, pg8::StaticOrder, true, true>(lds, g, S, E); }
        else if (kind == K_NR) norm_res_phase(H, gain, Xin, P.out, XNo, lane, wid);
        else if (kind == K_AA) attnA_phase(lds, QKV, OB, tid, lane, wid);
        else if (kind == K_AB0) attnB_phase<1, false>(lds, QKV, OB, LSE0, BT, nullptr, nullptr, nullptr, tid, lane, wid);
        else if (kind == K_AB1) attnB_phase<4, false>(lds, QKV, H, LSE1, BT + 3072, nullptr, nullptr, nullptr, tid, lane, wid);
        else attnB_phase<16, true>(lds, QKV, OB, nullptr, BT + 6144, H, LSE0, LSE1, tid, lane, wid);
        if (ph + 1 < NPH) {
            asm volatile("s_waitcnt vmcnt(0)" ::: "memory");
            __builtin_amdgcn_fence(__ATOMIC_RELEASE, "agent");
            asm volatile("s_waitcnt vmcnt(0)" ::: "memory");
            __syncthreads();
            if (tid == 0) {
                unsigned* bar = (unsigned*)ws;
                __hip_atomic_fetch_add(bar, 1u, __ATOMIC_RELAXED, __HIP_MEMORY_SCOPE_AGENT);
                const unsigned want = (unsigned)(ph + 1) * gridDim.x;
                while (__hip_atomic_load(bar, __ATOMIC_RELAXED, __HIP_MEMORY_SCOPE_AGENT) < want) __builtin_amdgcn_s_sleep(2);
            }
            __syncthreads();
            __builtin_amdgcn_fence(__ATOMIC_ACQUIRE, "agent");
            asm volatile("s_waitcnt vmcnt(0)" ::: "memory");
        }
    }
}

extern "C" void kernel_launch(void* const* d_in, const int* in_sizes, int n_in, void* d_out, int out_size, void* d_ws, size_t ws_size, hipStream_t stream) {
    static int grid = 0;
    if (grid == 0) {
        if (n_in != 11 || out_size != MROWS * DM || ws_size < WS_END) { fprintf(stderr, "kernel_launch: unexpected shapes (n_in %d, out %d, ws %zu)\n", n_in, out_size, ws_size); grid = -1; return; }
        int dev = 0, cus = 0, per_cu = 0;
        (void)hipGetDevice(&dev); (void)hipDeviceGetAttribute(&cus, hipDeviceAttributeMultiprocessorCount, dev);
        if (hipFuncSetAttribute((const void*)yoco_fwd, hipFuncAttributeMaxDynamicSharedMemorySize, LDS_BYTES) != hipSuccess) { fprintf(stderr, "kernel_launch: hipFuncSetAttribute failed\n"); grid = -1; return; }
        if (hipOccupancyMaxActiveBlocksPerMultiprocessor(&per_cu, (const void*)yoco_fwd, 512, LDS_BYTES) != hipSuccess || per_cu < 1) { fprintf(stderr, "kernel_launch: occupancy query failed (%d)\n", per_cu); per_cu = 1; }
        (void)hipGetLastError();
        grid = cus * per_cu;
        if (grid <= 0) grid = 256;
    }
    if (grid < 0) return;
    if (hipMemsetAsync(d_ws, 0, 4096, stream) != hipSuccess) { fprintf(stderr, "kernel_launch: memset failed\n"); return; }
    Params p{};
    p.x = (const float*)d_in[0]; p.gains = (const float*)d_in[1]; p.w_qkv_a = (const float*)d_in[2]; p.w_o_a = (const float*)d_in[3]; p.g_kv = (const float*)d_in[4];
    p.w_kv_b = (const float*)d_in[5]; p.w_q_b = (const float*)d_in[6]; p.w_o_b = (const float*)d_in[7]; p.rel_bias = (const float*)d_in[8]; p.w_gu = (const float*)d_in[9]; p.w_down = (const float*)d_in[10];
    p.out = (float*)d_out; p.ws = (unsigned char*)d_ws;
    void* args[] = {&p};
    const hipError_t e = hipLaunchCooperativeKernel((const void*)yoco_fwd, dim3(grid), dim3(512), args, LDS_BYTES, stream);
    if (e != hipSuccess) fprintf(stderr, "kernel_launch: cooperative launch failed: %s (grid %d)\n", hipGetErrorString(e), grid);
}
```

```cpp
#include <hip/hip_runtime.h>
#include <hip/hip_cooperative_groups.h>
#include <cstdio>
#include <cstdint>
namespace cg = cooperative_groups;
namespace pg8 {
#define PG8_LAS __attribute__((address_space(3)))
typedef unsigned short bf16_t;
typedef short bf16x8 __attribute__((ext_vector_type(8)));
typedef float f32x4 __attribute__((ext_vector_type(4)));
typedef unsigned u32x4 __attribute__((ext_vector_type(4)));
constexpr int BM = 256, BK = 64, HALF = 128, HTB = HALF * BK * 2  , STAGE_BYTES = 8 * HTB, NXCD = 8, WGM = 8;

__host__ __device__ __forceinline__ int lds_byte(int r, int c) { const int st = (r >> 4) * 2 + (c >> 5), rr = r & 15, cc = c & 31, ob = rr * 64 + cc * 2; return st * 1024 + (ob ^ (((ob >> 9) & 1) << 5)); }
__host__ __device__ __forceinline__ void stage_rc(int b, int& R, int& C) { const int st = b / 1024, sb = b % 1024, swz = sb ^ (((sb >> 9) & 1) << 5); R = (st >> 1) * 16 + swz / 64; C = (st & 1) * 32 + (swz % 64) / 2; }
__host__ __device__ __forceinline__ int perm32(int rho) { const int n = rho >> 4, i = rho & 15; return 8 * (i >> 2) + 4 * n + (i & 3); }

struct Unit { int pm, pn; };
struct Gemm { const bf16_t* A; const bf16_t* Bt; int M, N, K; };

struct StaticOrder {
    int nM, nN, nwg, G, c;
    __host__ __device__ void init(int M, int N, int G_, int c_) { nM = M / BM; nN = N / BM; nwg = nM * nN; G = G_; c = c_; }
    __host__ __device__ bool next(int i, Unit& u) const {
        const long L = (long)i * G + c; if (L >= nwg) return false;
        int wgid = (int)L; { const int q = nwg / NXCD, r = nwg % NXCD, xcd = wgid % NXCD, off = wgid / NXCD; wgid = (xcd < r ? xcd * (q + 1) : r * (q + 1) + (xcd - r) * q) + off; }
        const int nig = WGM * nN, gid = wgid / nig, fm = gid * WGM, gsz = (nM - fm) < WGM ? (nM - fm) : WGM;
        u.pm = fm + ((wgid % nig) % gsz); u.pn = (wgid % nig) / gsz; return true;
    }
    __device__ __forceinline__ void a_ready(const Unit&) const {}
    __device__ __forceinline__ void done(const Unit&) const {}
};


typedef float f32x2_t __attribute__((ext_vector_type(2))); typedef __bf16 bf16x2_t __attribute__((ext_vector_type(2)));
__device__ __forceinline__ unsigned cvtpk(float lo, float hi) { f32x2_t v = {lo, hi}; bf16x2_t b = __builtin_convertvector(v, bf16x2_t); return __builtin_bit_cast(unsigned, b); }

struct EpiStore {
    static constexpr bool PERM = true, AFTER_DRAIN = false;
    bf16_t* O; int ldc;
    __device__ __forceinline__ void operator()(const f32x4 (&acc)[2][2][4][2], const Unit& u, int wr, int wc, int fr, int fq) const {
        const int row0 = u.pm * BM + wr * 64 + fr; const int col0 = u.pn * BM + wc * 32 + 8 * fq;
#pragma unroll
        for (int ai = 0; ai < 2; ++ai)
#pragma unroll
            for (int m = 0; m < 4; ++m) { bf16_t* rowp = O + (size_t)(row0 + ai * HALF + m * 16) * ldc + col0;
#pragma unroll
                for (int bj = 0; bj < 2; ++bj) { const f32x4 v0 = acc[ai][bj][m][0], v1 = acc[ai][bj][m][1];
                    u32x4 w; w.x = cvtpk(v0[0], v0[1]); w.y = cvtpk(v0[2], v0[3]); w.z = cvtpk(v1[0], v1[1]); w.w = cvtpk(v1[2], v1[3]);
                    *(u32x4*)(rowp + bj * HALF) = w; } }
    }
};
struct EpiSwiglu {
    static constexpr bool PERM = true, AFTER_DRAIN = false;
    bf16_t* O; int ldc;
    __device__ __forceinline__ float act(float g, float u) const { const float e = __builtin_amdgcn_exp2f(-1.4426950408889634f * g); return g * u * __builtin_amdgcn_rcpf(1.0f + e); }
    __device__ __forceinline__ void operator()(const f32x4 (&acc)[2][2][4][2], const Unit& u, int wr, int wc, int fr, int fq) const {
        const int row0 = u.pm * BM + wr * 64 + fr; const int col0 = u.pn * HALF + wc * 32 + 8 * fq;
#pragma unroll
        for (int ai = 0; ai < 2; ++ai)
#pragma unroll
            for (int m = 0; m < 4; ++m) { bf16_t* rowp = O + (size_t)(row0 + ai * HALF + m * 16) * ldc + col0;
                const f32x4 g0 = acc[ai][0][m][0], g1 = acc[ai][0][m][1], u0 = acc[ai][1][m][0], u1 = acc[ai][1][m][1];
                u32x4 w; w.x = cvtpk(act(g0[0], u0[0]), act(g0[1], u0[1])); w.y = cvtpk(act(g0[2], u0[2]), act(g0[3], u0[3]));
                w.z = cvtpk(act(g1[0], u1[0]), act(g1[1], u1[1])); w.w = cvtpk(act(g1[2], u1[2]), act(g1[3], u1[3]));
                *(u32x4*)rowp = w; }
    }
};

template <class Epi, class Sched, bool ALIGN_EPI = false, bool SP2 = false>
__device__ __forceinline__ void gemm_phase(PG8_LAS unsigned char* lds, const Gemm g, const Sched& S, const Epi& E) {
    const int tid = threadIdx.x, wid = __builtin_amdgcn_readfirstlane(tid >> 6), lane = tid & 63, wr = wid >> 2, wc = wid & 3, fr = lane & 15, fq = lane >> 4;
    const int K = g.K, nt = K / BK;
    unsigned voffA[2], voffB[2];
#pragma unroll
    for (int i = 0; i < 2; ++i) { int R, C; stage_rc(tid * 16 + i * 8192, R, C); const int Rb = Epi::PERM ? ((R & ~31) + perm32(R & 31)) : R;
        voffA[i] = (unsigned)(R * K + C) * 2u; voffB[i] = (unsigned)(Rb * K + C) * 2u; }
    const size_t kstep = (size_t)(BK * 2);
    const size_t hstep = (size_t)HALF * K * 2;
    const size_t tstep = 2 * hstep;
    const unsigned ldsw = (unsigned)wid * 1024u;
    const int aoff = lds_byte(wr * 64 + fr, fq * 8), boff = lds_byte(wc * 32 + fr, fq * 8);
#define PG8_SA(b, h) (((b) * 2 + (h)) * HTB)
#define PG8_SB(b, h) ((4 + (b) * 2 + (h)) * HTB)
#define PG8_STAGE(bufoff, gbase, voff) do { _Pragma("unroll") for (int _i = 0; _i < 2; ++_i) \
        __builtin_amdgcn_global_load_lds((const unsigned*)((const char*)(gbase) + (voff)[_i]), (PG8_LAS unsigned*)(lds + (bufoff) + ldsw + _i * 8192), 16, 0, 0); } while (0)
#define PG8_LDA(dst, b, h) do { _Pragma("unroll") for (int m = 0; m < 4; ++m) _Pragma("unroll") for (int k = 0; k < 2; ++k) dst[m][k] = *(const PG8_LAS bf16x8*)(lds + PG8_SA(b, h) + aoff + m * 2048 + k * 1024); } while (0)
#define PG8_LDB(dst, b, h) do { _Pragma("unroll") for (int n = 0; n < 2; ++n) _Pragma("unroll") for (int k = 0; k < 2; ++k) dst[n][k] = *(const PG8_LAS bf16x8*)(lds + PG8_SB(b, h) + boff + n * 2048 + k * 1024); } while (0)
#define PG8_MMA(ai, bj, At, Bt) do { __builtin_amdgcn_s_setprio(1); _Pragma("unroll") for (int m = 0; m < 4; ++m) _Pragma("unroll") for (int n = 0; n < 2; ++n) _Pragma("unroll") for (int k = 0; k < 2; ++k) \
        acc[ai][bj][m][n] = __builtin_amdgcn_mfma_f32_16x16x32_bf16(Bt[n][k], At[m][k], acc[ai][bj][m][n], 0, 0, 0); __builtin_amdgcn_s_setprio(0); } while (0)
#define PG8_WAIT_V(n) asm volatile("s_waitcnt vmcnt(" #n ")" ::: "memory")
#define PG8_WAIT_L(n) asm volatile("s_waitcnt lgkmcnt(" #n ")" ::: "memory")
#define PG8_BAR __builtin_amdgcn_s_barrier()
#define PG8_SCHED __builtin_amdgcn_sched_barrier(0)
    Unit cur, nxt; int ui = 0;
    if (!S.next(0, cur)) return;
    f32x4 acc[2][2][4][2];
#pragma unroll
    for (int a = 0; a < 2; ++a)
#pragma unroll
        for (int b = 0; b < 2; ++b)
#pragma unroll
            for (int m = 0; m < 4; ++m)
#pragma unroll
                for (int n = 0; n < 2; ++n) acc[a][b][m][n] = (f32x4){0.f, 0.f, 0.f, 0.f};
    bf16x8 At[4][2], B0[2][2], B1[2][2];
    const char* cA = (const char*)g.A + (size_t)cur.pm * tstep; const char* cB = (const char*)g.Bt + (size_t)cur.pn * tstep;
    S.a_ready(cur);
    if constexpr (SP2) {
        PG8_STAGE(PG8_SB(0, 0), cB, voffB); PG8_STAGE(PG8_SB(0, 1), cB + hstep, voffB); PG8_STAGE(PG8_SA(0, 0), cA, voffA); PG8_STAGE(PG8_SA(0, 1), cA + hstep, voffA);
        if (wr == 1) PG8_BAR;
        PG8_WAIT_V(2); PG8_BAR;
        PG8_STAGE(PG8_SB(1, 0), cB + kstep, voffB); PG8_STAGE(PG8_SA(1, 0), cA + kstep, voffA); PG8_STAGE(PG8_SB(1, 1), cB + hstep + kstep, voffB);
        PG8_WAIT_V(6); PG8_BAR;
    } else {
        PG8_STAGE(PG8_SB(0, 0), cB, voffB); PG8_STAGE(PG8_SA(0, 0), cA, voffA); PG8_STAGE(PG8_SB(0, 1), cB + hstep, voffB); PG8_STAGE(PG8_SA(0, 1), cA + hstep, voffA);
        if (wr == 1) PG8_BAR;
        PG8_WAIT_V(4); PG8_BAR;
        PG8_STAGE(PG8_SB(1, 0), cB + kstep, voffB); PG8_STAGE(PG8_SA(1, 0), cA + kstep, voffA); PG8_STAGE(PG8_SB(1, 1), cB + hstep + kstep, voffB);
        PG8_WAIT_V(6); PG8_BAR;
    }
    for (;;) {
        const bool has_next = S.next(ui + 1, nxt);
        const char* nA = has_next ? (const char*)g.A + (size_t)nxt.pm * tstep : cA; const char* nB = has_next ? (const char*)g.Bt + (size_t)nxt.pn * tstep : cB;
        for (int t = 0; t < nt; t += 2) {
            const bool last = (t == nt - 2);
            const char* a1 = cA + (size_t)(t + 1) * kstep;
            const char* a2 = last ? nA : cA + (size_t)(t + 2) * kstep; const char* b2 = last ? nB : cB + (size_t)(t + 2) * kstep;
            const char* a3 = a2 + kstep; const char* b3 = b2 + kstep;
            if (last && has_next) S.a_ready(nxt);
            if constexpr (SP2) {
            PG8_LDB(B0, 0, 0); PG8_LDB(B1, 0, 1); PG8_SCHED; PG8_LDA(At, 0, 0); PG8_STAGE(PG8_SA(1, 1), a1 + hstep, voffA);
            PG8_WAIT_V(8); PG8_WAIT_L(0); PG8_BAR; PG8_MMA(0, 0, At, B0); PG8_MMA(0, 1, At, B1); PG8_BAR; PG8_SCHED;
            PG8_LDA(At, 0, 1); PG8_STAGE(PG8_SB(0, 0), b2, voffB); PG8_STAGE(PG8_SB(0, 1), b2 + hstep, voffB); PG8_STAGE(PG8_SA(0, 0), a2, voffA);
            PG8_WAIT_V(8); PG8_WAIT_L(0); PG8_BAR; PG8_MMA(1, 0, At, B0); PG8_MMA(1, 1, At, B1); PG8_BAR; PG8_SCHED;
            PG8_LDB(B0, 1, 0); PG8_LDB(B1, 1, 1); PG8_SCHED; PG8_LDA(At, 1, 0); PG8_STAGE(PG8_SA(0, 1), a2 + hstep, voffA);
            PG8_WAIT_V(8); PG8_WAIT_L(0); PG8_BAR; PG8_MMA(0, 0, At, B0); PG8_MMA(0, 1, At, B1); PG8_BAR; PG8_SCHED;
            PG8_LDA(At, 1, 1); PG8_STAGE(PG8_SB(1, 0), b3, voffB); PG8_STAGE(PG8_SB(1, 1), b3 + hstep, voffB); PG8_STAGE(PG8_SA(1, 0), a3, voffA);
            PG8_WAIT_V(8); PG8_WAIT_L(0); PG8_BAR; PG8_MMA(1, 0, At, B0); PG8_MMA(1, 1, At, B1); PG8_BAR; PG8_SCHED;
            } else {
            PG8_LDB(B0, 0, 0); PG8_SCHED; PG8_LDA(At, 0, 0); PG8_STAGE(PG8_SA(1, 1), a1 + hstep, voffA);
            PG8_WAIT_L(8); PG8_BAR; PG8_WAIT_L(0); PG8_MMA(0, 0, At, B0); PG8_BAR; PG8_SCHED;
            PG8_LDB(B1, 0, 1); PG8_STAGE(PG8_SB(0, 0), b2, voffB);
            PG8_BAR; PG8_WAIT_L(0); PG8_MMA(0, 1, At, B1); PG8_BAR;
            PG8_LDA(At, 0, 1); PG8_STAGE(PG8_SA(0, 0), a2, voffA);
            PG8_BAR; PG8_WAIT_L(0); PG8_MMA(1, 0, At, B0); PG8_BAR; PG8_SCHED;
            PG8_STAGE(PG8_SB(0, 1), b2 + hstep, voffB);
            PG8_WAIT_V(6); PG8_BAR; PG8_MMA(1, 1, At, B1); PG8_BAR;
            PG8_LDB(B0, 1, 0); PG8_SCHED; PG8_LDA(At, 1, 0); PG8_STAGE(PG8_SA(0, 1), a2 + hstep, voffA);
            PG8_WAIT_L(8); PG8_BAR; PG8_WAIT_L(0); PG8_MMA(0, 0, At, B0); PG8_BAR; PG8_SCHED;
            PG8_LDB(B1, 1, 1); PG8_STAGE(PG8_SB(1, 0), b3, voffB);
            PG8_BAR; PG8_WAIT_L(0); PG8_MMA(0, 1, At, B1); PG8_BAR;
            PG8_LDA(At, 1, 1); PG8_STAGE(PG8_SA(1, 0), a3, voffA);
            PG8_BAR; PG8_WAIT_L(0); PG8_MMA(1, 0, At, B0); PG8_BAR; PG8_SCHED;
            PG8_STAGE(PG8_SB(1, 1), b3 + hstep, voffB);
            PG8_WAIT_V(6); PG8_BAR; PG8_MMA(1, 1, At, B1); PG8_BAR;
            }
        }
        if constexpr (ALIGN_EPI) { if (wr == 0) PG8_BAR; }
        if constexpr (!Epi::AFTER_DRAIN) { E(acc, cur, wr, wc, fr, fq); S.done(cur); }
        if (!has_next) break;
#pragma unroll
        for (int a = 0; a < 2; ++a)
#pragma unroll
            for (int b = 0; b < 2; ++b)
#pragma unroll
                for (int m = 0; m < 4; ++m)
#pragma unroll
                    for (int n = 0; n < 2; ++n) acc[a][b][m][n] = (f32x4){0.f, 0.f, 0.f, 0.f};
        cur = nxt; cA = nA; cB = nB; ++ui;
        if constexpr (ALIGN_EPI) { if (wr == 1) PG8_BAR; }
    }
    PG8_WAIT_V(0);
    if constexpr (!ALIGN_EPI) { if (wr == 0) PG8_BAR; }
    PG8_BAR;
    if constexpr (Epi::AFTER_DRAIN) { E.fused(acc, cur, wr, wc, fr, fq, lds, wid, lane); S.done(cur); }
#undef PG8_SA
#undef PG8_SB
#undef PG8_STAGE
#undef PG8_LDA
#undef PG8_LDB
#undef PG8_MMA
#undef PG8_WAIT_V
#undef PG8_WAIT_L
#undef PG8_BAR
#undef PG8_SCHED
}
}

#define LAS __attribute__((address_space(3)))
typedef pg8::bf16_t bf16_t; typedef pg8::bf16x8 bf16x8; typedef pg8::f32x4 f32x4; typedef pg8::u32x4 u32x4;
typedef float f32x16 __attribute__((ext_vector_type(16)));
typedef unsigned u32x2 __attribute__((ext_vector_type(2)));
typedef short v4i16_t __attribute__((ext_vector_type(4)));
using pg8::cvtpk;

constexpr int BATCH = 16, SEQ = 2048, DM = 1024, NH = 16, HD = 64, DFF = 2816, MROWS = BATCH * SEQ;
constexpr float RMS_EPS = 1e-6f;
constexpr float LOG2E = 1.4426950408889634f;
constexpr float QSCALE = 0.125f * LOG2E;
constexpr size_t MiB = 1u << 20;
constexpr size_t WS_WQKVA = 1 * MiB, WS_WOA = 7 * MiB, WS_WGU0 = 9 * MiB, WS_WD0 = 20 * MiB, WS_WB = 26 * MiB  , WS_WOB = 44 * MiB,
                 WS_WGU1 = 46 * MiB, WS_WD1 = 57 * MiB, WS_BIAS = 63 * MiB, WS_XN = 65 * MiB, WS_QKV = 129 * MiB, WS_ACT = 129 * MiB  ,
                 WS_OB = 321 * MiB, WS_H = 385 * MiB, WS_LSE0 = 449 * MiB, WS_LSE1 = 451 * MiB, WS_END = 453 * MiB;
constexpr int LDS_BYTES = 147456;

struct Params { const float *x, *gains, *w_qkv_a, *w_o_a, *g_kv, *w_kv_b, *w_q_b, *w_o_b, *rel_bias, *w_gu, *w_down; float* out; unsigned char* ws; };

#define LDS_WAIT() asm volatile("s_waitcnt lgkmcnt(0)" ::: "memory")
__device__ __forceinline__ float wave_sum(float v) {
#pragma unroll
    for (int o = 1; o < 64; o <<= 1) v += __shfl_xor(v, o);
    return v;
}
__device__ __forceinline__ int crow(int r, int hi) { return (r & 3) + 8 * (r >> 2) + 4 * hi; }
__device__ __forceinline__ float bf_lo(unsigned w) { return __uint_as_float(w << 16); }
__device__ __forceinline__ float bf_hi(unsigned w) { return __uint_as_float(w & 0xffff0000u); }

__device__ __forceinline__ void conv_item(const float* __restrict__ W, int ldw, int col, int K, const float* __restrict__ gain, float scale, bf16_t* WT, int drow, LAS float* scr, int kb, int lane) {
    const int k0 = 64 * kb;
#pragma unroll 8
    for (int i = 0; i < 32; ++i) { const int kk = 2 * i + (lane >> 5); const float v = W[(size_t)(k0 + kk) * ldw + col + (lane & 31)];
        const float gs = gain ? gain[k0 + kk] * scale : scale; scr[kk * 33 + (lane & 31)] = v * gs; }
    LDS_WAIT();
    const int c = lane & 7;
#pragma unroll
    for (int j = 0; j < 4; ++j) { const int n = (lane >> 3) + 8 * j; const LAS float* s = scr + (8 * c) * 33 + n;
        u32x4 o; o.x = cvtpk(s[0 * 33], s[1 * 33]); o.y = cvtpk(s[2 * 33], s[3 * 33]); o.z = cvtpk(s[4 * 33], s[5 * 33]); o.w = cvtpk(s[6 * 33], s[7 * 33]);
        *(u32x4*)(WT + (size_t)(drow + n) * K + k0 + 8 * c) = o; }
    LDS_WAIT();
}
template <int MODE> __device__ __forceinline__ void conv_seg(const float* src, int ld, int col0, int ncols, int K, const float* gain, float scale, bf16_t* dst, int drow0,
                                                             LAS float* scr, int gw, int NGW, int& off, int lane) {
    const int nblk = ncols >> 5, items = nblk * (K >> 6);
    int it0 = gw - (off % NGW); if (it0 < 0) it0 += NGW; off += items;
    for (int it = it0; it < items; it += NGW) {
        const int kb = it / nblk, nb = it - kb * nblk, c = 32 * nb; int drow;
        if (MODE == 1) { const int upf = c >= DFF ? 1 : 0, cc = c - upf * DFF; drow = 256 * (cc >> 7) + 128 * upf + (cc & 127); } else drow = drow0 + c;
        conv_item(src, ld, col0 + c, K, gain, scale, dst, drow, scr, kb, lane);
    }
}
__device__ __forceinline__ void norm_row_bf16(const float* xrow, bf16_t* orow, int lane) {
    const f32x4* xr = (const f32x4*)xrow + lane;
    f32x4 v[4]; float s = 0.f;
#pragma unroll
    for (int j = 0; j < 4; ++j) { v[j] = xr[64 * j]; s += (v[j].x * v[j].x + v[j].y * v[j].y) + (v[j].z * v[j].z + v[j].w * v[j].w); }
    const float r = 1.0f / sqrtf(wave_sum(s) * (1.f / DM) + RMS_EPS);
    u32x2* o8 = (u32x2*)orow + lane;
#pragma unroll
    for (int j = 0; j < 4; ++j) { u32x2 w; w.x = cvtpk(v[j].x * r, v[j].y * r); w.y = cvtpk(v[j].z * r, v[j].w * r); o8[64 * j] = w; }
}
__device__ __forceinline__ void prologue(const Params& P, LAS unsigned char* lds, int tid, int lane, int wave) {
    LAS float* scr = (LAS float*)(lds + wave * 16384);
    const int G = gridDim.x, gw = blockIdx.x * 8 + wave, NGW = G * 8;
    unsigned char* ws = P.ws; int off = 0;
    const float* g00 = P.gains + 0 * DM; const float* g02 = P.gains + 2 * DM; const float* g10 = P.gains + 4 * DM; const float* g12 = P.gains + 6 * DM;
    conv_seg<0>(P.w_qkv_a, 3072, 0, 1024, 1024, g00, QSCALE, (bf16_t*)(ws + WS_WQKVA), 0, scr, gw, NGW, off, lane);
    conv_seg<0>(P.w_qkv_a, 3072, 1024, 2048, 1024, g00, 1.0f, (bf16_t*)(ws + WS_WQKVA), 1024, scr, gw, NGW, off, lane);
    conv_seg<0>(P.w_o_a, 1024, 0, 1024, 1024, nullptr, 1.0f, (bf16_t*)(ws + WS_WOA), 0, scr, gw, NGW, off, lane);
    conv_seg<1>(P.w_gu, 2 * DFF, 0, 2 * DFF, 1024, g02, 1.0f, (bf16_t*)(ws + WS_WGU0), 0, scr, gw, NGW, off, lane);
    conv_seg<0>(P.w_down, 1024, 0, 1024, DFF, nullptr, 1.0f, (bf16_t*)(ws + WS_WD0), 0, scr, gw, NGW, off, lane);
    for (int g = 0; g < 3; ++g) {
        bf16_t* wb = (bf16_t*)(ws + WS_WB + (size_t)g * 6 * MiB);
        conv_seg<0>(P.w_q_b, 3072, 1024 * g, 1024, 1024, g10, QSCALE, wb, 0, scr, gw, NGW, off, lane);
        conv_seg<0>(P.w_kv_b, 6144, 2048 * g, 2048, 1024, P.g_kv, 1.0f, wb, 1024, scr, gw, NGW, off, lane);
    }
    conv_seg<0>(P.w_o_b, 1024, 0, 1024, 1024, nullptr, 1.0f, (bf16_t*)(ws + WS_WOB), 0, scr, gw, NGW, off, lane);
    conv_seg<1>(P.w_gu + (size_t)DM * 2 * DFF, 2 * DFF, 0, 2 * DFF, 1024, g12, 1.0f, (bf16_t*)(ws + WS_WGU1), 0, scr, gw, NGW, off, lane);
    conv_seg<0>(P.w_down + (size_t)DFF * DM, 1024, 0, 1024, DFF, nullptr, 1.0f, (bf16_t*)(ws + WS_WD1), 0, scr, gw, NGW, off, lane);
    bf16_t* XN = (bf16_t*)(ws + WS_XN);
    for (int m = gw; m < MROWS; m += NGW) norm_row_bf16(P.x + (size_t)m * DM, XN + (size_t)m * DM, lane);
    float* BT = (float*)(ws + WS_BIAS);
    for (int idx = blockIdx.x * 512 + tid; idx < 3 * 16 * 192; idx += G * 512) {
        const int g = idx / 3072, rem = idx - g * 3072, h = rem / 192, e = rem - h * 192, rel = e - 32; float v = 0.f;
        if (rel >= 0 && rel <= 128) { const int dl = (g == 0) ? 1 : ((g == 1) ? 4 : 16); const int n = rel * dl; int bk;
            if (n < 16) bk = n;
            else { bk = 16 + (n >= 22) + (n >= 30) + (n >= 40) + (n >= 54) + (n >= 73) + (n >= 99) + (n >= 134) + (n >= 182) + (n >= 246) + (n >= 332) + (n >= 450) + (n >= 609) + (n >= 825) + (n >= 1117) + (n >= 1513); }
            v = P.rel_bias[bk * 16 + h] * LOG2E; }
        BT[idx] = v;
    }
}

__device__ __forceinline__ void norm_res_phase(const bf16_t* H, const float* gain, const float* Xin, float* Xout, bf16_t* XN, int lane, int wave) {
    const int gw = blockIdx.x * 8 + wave, NGW = gridDim.x * 8;
    f32x4 gv[4];
#pragma unroll
    for (int j = 0; j < 4; ++j) gv[j] = *((const f32x4*)gain + lane + 64 * j);
    for (int m = gw; m < MROWS; m += NGW) {
        const u32x2* hp = (const u32x2*)(H + (size_t)m * DM) + lane;
        const f32x4* xp = (const f32x4*)(Xin + (size_t)m * DM) + lane;
        f32x4 hv[4], xv[4]; float ss = 0.f;
#pragma unroll
        for (int j = 0; j < 4; ++j) { const u32x2 w = hp[64 * j]; xv[j] = xp[64 * j]; hv[j] = (f32x4){bf_lo(w.x), bf_hi(w.x), bf_lo(w.y), bf_hi(w.y)};
            ss += (hv[j].x * hv[j].x + hv[j].y * hv[j].y) + (hv[j].z * hv[j].z + hv[j].w * hv[j].w); }
        const float r = 1.0f / sqrtf(wave_sum(ss) * (1.f / DM) + RMS_EPS);
        float s2 = 0.f; f32x4* op = (f32x4*)(Xout + (size_t)m * DM) + lane;
#pragma unroll
        for (int j = 0; j < 4; ++j) { xv[j] = xv[j] + hv[j] * r * gv[j]; op[64 * j] = xv[j];
            s2 += (xv[j].x * xv[j].x + xv[j].y * xv[j].y) + (xv[j].z * xv[j].z + xv[j].w * xv[j].w); }
        if (XN) { const float r2 = 1.0f / sqrtf(wave_sum(s2) * (1.f / DM) + RMS_EPS); u32x2* o8 = (u32x2*)(XN + (size_t)m * DM) + lane;
#pragma unroll
            for (int j = 0; j < 4; ++j) { u32x2 w; w.x = cvtpk(xv[j].x * r2, xv[j].y * r2); w.y = cvtpk(xv[j].z * r2, xv[j].w * r2); o8[64 * j] = w; } }
    }
}

__device__ __forceinline__ bf16x8 vfrag(const LAS unsigned char* p) {
    const v4i16_t lo = __builtin_amdgcn_ds_read_tr16_b64_v4i16((LAS v4i16_t*)p);
    const v4i16_t hi = __builtin_amdgcn_ds_read_tr16_b64_v4i16((LAS v4i16_t*)(p + 512));
    return (bf16x8){lo[0], lo[1], lo[2], lo[3], hi[0], hi[1], hi[2], hi[3]};
}
__device__ __forceinline__ bf16x8 pack8(const float* a) {
    u32x4 w; w.x = cvtpk(a[0], a[1]); w.y = cvtpk(a[2], a[3]); w.z = cvtpk(a[4], a[5]); w.w = cvtpk(a[6], a[7]); return __builtin_bit_cast(bf16x8, w);
}

template <bool MASK> __device__ __forceinline__ void sb_subtile(const LAS unsigned char* kbuf, const LAS unsigned char* vbuf  , int sub, const bf16x8 (&qf)[4], const int (&kaddr)[4],
                                                                float& carry, f32x16 (&o)[2], int r32, int hh) {
    f32x16 S = {};
#pragma unroll
    for (int dk = 0; dk < 4; ++dk) { const bf16x8 kf = *(const LAS bf16x8*)(kbuf + kaddr[dk] + sub * 512); S = __builtin_amdgcn_mfma_f32_32x32x16_bf16(kf, qf[dk], S, 0, 0, 0); }
    float p[16];
#pragma unroll
    for (int r = 0; r < 16; ++r) { const float u = __builtin_amdgcn_exp2f(fminf(S[r], 120.f)); float wv = __builtin_amdgcn_rcpf(1.0f + u);
        if (MASK) wv = (crow(r, hh) < r32) ? wv : 1.0f; p[r] = wv; }
    float go[4], t[4];
#pragma unroll
    for (int i = 0; i < 4; ++i) { p[4 * i + 2] *= p[4 * i + 3]; p[4 * i + 1] *= p[4 * i + 2]; p[4 * i] *= p[4 * i + 1]; go[i] = __shfl_xor(p[4 * i], 32); t[i] = p[4 * i] * go[i]; }
    const float R2 = t[3], R1 = t[3] * t[2], R0 = R1 * t[1];
    float E[4];
    E[3] = carry * (hh ? 1.0f : go[3]); E[2] = carry * R2 * (hh ? 1.0f : go[2]); E[1] = carry * R1 * (hh ? 1.0f : go[1]); E[0] = carry * R0 * (hh ? 1.0f : go[0]);
    carry = carry * R0 * t[0];
    float A[16];
#pragma unroll
    for (int i = 0; i < 4; ++i) { const float I3 = E[i] * p[4 * i + 3], I2 = E[i] * p[4 * i + 2], I1 = E[i] * p[4 * i + 1], I0 = E[i] * p[4 * i];
        A[4 * i + 3] = E[i] - I3; A[4 * i + 2] = I3 - I2; A[4 * i + 1] = I2 - I1; A[4 * i] = I1 - I0; }
    const bf16x8 pf0 = pack8(A), pf1 = pack8(A + 8);
#pragma unroll
    for (int dh = 0; dh < 2; ++dh) {
        const bf16x8 v0 = vfrag(vbuf + dh * 4096 + (32 * sub) * 64), v1 = vfrag(vbuf + dh * 4096 + (32 * sub + 16) * 64);
        o[dh] = __builtin_amdgcn_mfma_f32_32x32x16_bf16(pf0, v0, o[dh], 0, 0, 0);
        o[dh] = __builtin_amdgcn_mfma_f32_32x32x16_bf16(pf1, v1, o[dh], 0, 0, 0);
    }
}

__device__ __forceinline__ void attnA_phase(LAS unsigned char* lds, const bf16_t* __restrict__ QKV, bf16_t* __restrict__ O, int tid, int lane, int wid) {
    const int r32 = lane & 31, hh = lane >> 5;
    int kaddr[4];
#pragma unroll
    for (int dk = 0; dk < 4; ++dk) { const int c = 2 * dk + hh; kaddr[dk] = c * 1024 + ((r32 ^ c) << 4); }
    const int vlane = (4 * hh + ((lane & 15) >> 2)) * 64 + ((lane >> 4) & 1) * 32 + (lane & 3) * 8;
    const int lkey = tid >> 3, lc = tid & 7;
    const int kwoff = lc * 1024 + ((lkey ^ lc) << 4), vwoff = 16384 + (lc >> 2) * 4096 + lkey * 64 + (lc & 3) * 16;
    for (int u = blockIdx.x; u < BATCH * NH * 8; u += gridDim.x) {
        const int bh = u >> 3, qb = ((u & 7) + (u >> 8)) & 7, b = bh >> 4, h = bh & 15;
        const size_t rowbase = (size_t)b * SEQ; const int q0 = qb * 256, R0 = q0 + 32 * wid;
        bf16x8 qf[4];
        { const bf16_t* qp = QKV + (rowbase + R0 + r32) * 3072 + h * 64 + 8 * hh;
#pragma unroll
          for (int dk = 0; dk < 4; ++dk) qf[dk] = *(const bf16x8*)(qp + 16 * dk); }
        const bf16_t* kvg = QKV + (rowbase + lkey) * 3072 + 1024 + h * 64 + 8 * lc;
        const int NT = 4 * qb + 4;
        { const bf16_t* kg = kvg + (size_t)(64 * (NT - 1)) * 3072; const u32x4 kr = *(const u32x4*)kg, vr = *(const u32x4*)(kg + 1024);
          *(LAS u32x4*)(lds + kwoff) = kr; *(LAS u32x4*)(lds + vwoff) = vr; }
        __syncthreads();
        float carry = 1.0f; f32x16 o[2]; o[0] = f32x16{}; o[1] = f32x16{};
        int cur = 0;
        for (int kt = NT - 1; kt >= 0; --kt) {
            u32x4 kr, vr;
            if (kt > 0) { const bf16_t* kg = kvg + (size_t)(64 * (kt - 1)) * 3072; kr = *(const u32x4*)kg; vr = *(const u32x4*)(kg + 1024); }
            const int diff = R0 - 64 * kt;
            const LAS unsigned char* kbuf = lds + cur * 8192; const LAS unsigned char* vbuf = lds + 16384 + cur * 8192 + vlane;
            if (diff >= 64) { sb_subtile<false>(kbuf, vbuf, 1, qf, kaddr, carry, o, r32, hh); sb_subtile<false>(kbuf, vbuf, 0, qf, kaddr, carry, o, r32, hh); }
            else if (diff == 32) { sb_subtile<true>(kbuf, vbuf, 1, qf, kaddr, carry, o, r32, hh); sb_subtile<false>(kbuf, vbuf, 0, qf, kaddr, carry, o, r32, hh); }
            else if (diff == 0) { sb_subtile<true>(kbuf, vbuf, 0, qf, kaddr, carry, o, r32, hh); }
            if (kt > 0) { *(LAS u32x4*)(lds + (cur ^ 1) * 8192 + kwoff) = kr; *(LAS u32x4*)(lds + (cur ^ 1) * 8192 + vwoff) = vr; }
            __syncthreads();
            cur ^= 1;
        }
        bf16_t* op = O + (rowbase + R0) * DM + h * 64 + r32;
#pragma unroll
        for (int r = 0; r < 16; ++r) { const int qq = crow(r, hh);
#pragma unroll
            for (int dh = 0; dh < 2; ++dh) op[(size_t)qq * DM + 32 * dh] = (bf16_t)(cvtpk(o[dh][r], 0.f) & 0xffffu); }
    }
}

template <int DL, bool FINAL> __device__ __forceinline__ void attnB_phase(LAS unsigned char* lds, const bf16_t* __restrict__ QKV, bf16_t* O, float* lse_out, const float* __restrict__ BT,
                                                                          const bf16_t* O1, const float* lse0, const float* lse1, int tid, int lane, int wid) {
    constexpr int NB = 16 / DL;
    const int r32 = lane & 31, hh = lane >> 5, half = wid >> 2, wq = wid & 3, ht = tid & 255;
    LAS unsigned char* kb = lds + half * 65536; LAS unsigned char* vb = kb + 32768;
    LAS float* bl = (LAS float*)(lds + 131072 + half * 768);
    LAS float* scr = (LAS float*)(lds + 131072 + 1536 + wid * 256);
    int kaddr[4];
#pragma unroll
    for (int dk = 0; dk < 4; ++dk) { const int c = 2 * dk + hh; kaddr[dk] = c * 4096 + ((r32 ^ c) << 4); }
    const int vlane = (4 * hh + ((lane & 15) >> 2)) * 64 + ((lane >> 4) & 1) * 32 + (lane & 3) * 8;
    const int key_in = ht >> 3, c8 = ht & 7;
    for (int p = blockIdx.x; p < BATCH * NH * 8; p += gridDim.x) {
        const int u = 2 * p + half, bh = u >> 4, cc = u & 15, b = bh >> 4, h = bh & 15, rr = cc / NB, n = cc % NB;
        __syncthreads();
#pragma unroll
        for (int batch = 0; batch < 2; ++batch) {
            if (batch == 0 && n == 0) continue;
            u32x4 kr[4], vr[4];
#pragma unroll
            for (int i = 0; i < 4; ++i) { const int m = 32 * (batch * 4 + i) + key_in; const int idx = (n - 1) * 128 + m;
                const bf16_t* kg = QKV + ((size_t)b * SEQ + (size_t)(idx * DL + rr)) * 3072 + 1024 + h * 64 + 8 * c8; kr[i] = *(const u32x4*)kg; vr[i] = *(const u32x4*)(kg + 1024); }
#pragma unroll
            for (int i = 0; i < 4; ++i) { const int m = 32 * (batch * 4 + i) + key_in;
                *(LAS u32x4*)(kb + c8 * 4096 + ((m ^ c8) << 4)) = kr[i]; *(LAS u32x4*)(vb + (c8 >> 2) * 16384 + m * 64 + (c8 & 3) * 16) = vr[i]; }
        }
        if (ht < 192) bl[ht] = BT[h * 192 + ht];
        bf16x8 qf[4];
        { const int i = 32 * wq + r32; const bf16_t* qp = QKV + ((size_t)b * SEQ + (size_t)((n * 128 + i) * DL + rr)) * 3072 + h * 64 + 8 * hh;
#pragma unroll
          for (int dk = 0; dk < 4; ++dk) qf[dk] = *(const bf16x8*)(qp + 16 * dk); }
        __syncthreads();
        const int jstart = (n == 0) ? (4 - wq) : 0;
        const LAS float* blp = bl + 160 + r32 - 4 * hh;
        f32x16 S[5];
        float mx = -INFINITY;
#pragma unroll
        for (int jj = 0; jj < 5; ++jj) {
            if (jj >= jstart) {
                f32x16 s = {};
#pragma unroll
                for (int dk = 0; dk < 4; ++dk) { const bf16x8 kf = *(const LAS bf16x8*)(kb + kaddr[dk] + (wq + jj) * 512); s = __builtin_amdgcn_mfma_f32_32x32x16_bf16(kf, qf[dk], s, 0, 0, 0); }
#pragma unroll
                for (int r = 0; r < 16; ++r) { const int kk = crow(r, hh); float v = s[r] + blp[-(32 * jj + (r & 3) + 8 * (r >> 2))];
                    if (jj == 0) v = (kk >= r32) ? v : -INFINITY;
                    if (jj == 4) v = (kk <= r32) ? v : -INFINITY;
                    s[r] = v; mx = fmaxf(mx, v); }
                S[jj] = s;
            } else {
#pragma unroll
                for (int r = 0; r < 16; ++r) S[jj][r] = -INFINITY;
            }
        }
        mx = fmaxf(mx, __shfl_xor(mx, 32));
        float l = 0.f; f32x16 o[2]; o[0] = f32x16{}; o[1] = f32x16{};
#pragma unroll
        for (int jj = 0; jj < 5; ++jj) {
            float pe[16];
#pragma unroll
            for (int r = 0; r < 16; ++r) { pe[r] = __builtin_amdgcn_exp2f(S[jj][r] - mx); l += pe[r]; }
            if (jj >= jstart) {
                const bf16x8 pf0 = pack8(pe), pf1 = pack8(pe + 8);
#pragma unroll
                for (int dh = 0; dh < 2; ++dh) {
                    const LAS unsigned char* vp = vb + dh * 16384 + (32 * (wq + jj)) * 64 + vlane;
                    const bf16x8 v0 = vfrag(vp), v1 = vfrag(vp + 16 * 64);
                    o[dh] = __builtin_amdgcn_mfma_f32_32x32x16_bf16(pf0, v0, o[dh], 0, 0, 0);
                    o[dh] = __builtin_amdgcn_mfma_f32_32x32x16_bf16(pf1, v1, o[dh], 0, 0, 0);
                }
            }
        }
        l += __shfl_xor(l, 32);
        const float lse2 = mx + __builtin_amdgcn_logf(l);
        if (hh == 0) { scr[r32] = __builtin_amdgcn_rcpf(l); scr[32 + r32] = lse2; }
        const size_t rowq0 = (size_t)b * SEQ + (size_t)((n * 128 + 32 * wq) * DL + rr);
        if (!FINAL) { if (hh == 0) lse_out[(rowq0 + (size_t)r32 * DL) * 16 + h] = lse2; }
        LDS_WAIT();
#pragma unroll
        for (int r = 0; r < 16; ++r) { const int qq = crow(r, hh); const size_t row = rowq0 + (size_t)qq * DL; const float linv = scr[qq];
            bf16_t* op = O + row * DM + h * 64 + r32;
            if (!FINAL) {
#pragma unroll
                for (int dh = 0; dh < 2; ++dh) op[32 * dh] = (bf16_t)(cvtpk(o[dh][r] * linv, 0.f) & 0xffffu);
            } else {
                const float l0 = lse0[row * 16 + h], l1 = lse1[row * 16 + h], l2 = scr[32 + qq];
                const float M = fmaxf(fmaxf(l0, l1), l2); const float e0 = __builtin_amdgcn_exp2f(l0 - M), e1 = __builtin_amdgcn_exp2f(l1 - M), e2 = __builtin_amdgcn_exp2f(l2 - M);
                const float inv = __builtin_amdgcn_rcpf(e0 + e1 + e2); const float w0 = e0 * inv, w1 = e1 * inv, w2 = e2 * inv * linv;
                const bf16_t* o1p = O1 + row * DM + h * 64 + r32;
#pragma unroll
                for (int dh = 0; dh < 2; ++dh) { const float a0 = __uint_as_float((unsigned)op[32 * dh] << 16), a1 = __uint_as_float((unsigned)o1p[32 * dh] << 16);
                    op[32 * dh] = (bf16_t)(cvtpk(w0 * a0 + w1 * a1 + w2 * o[dh][r], 0.f) & 0xffffu); }
            }
        }
    }
}

#define XB_TMO      128
#define XB_XCNT(j)  (256  + 64 * (j))
#define XB_XSUB(j)  (1280 + 64 * (j))
#define XB_XGEN(j)  (2304 + 64 * (j))
#define XB_TOP      3328
#define XB_TOPGEN   3392
#define XCD_BAR_WORDS 3456
#define XB_SPIN_CAP (1u << 18)

__device__ __forceinline__ unsigned xb_ld(unsigned* p)              { return __hip_atomic_load(p, __ATOMIC_RELAXED, __HIP_MEMORY_SCOPE_AGENT); }
__device__ __forceinline__ unsigned xb_add(unsigned* p, unsigned v) { return __hip_atomic_fetch_add(p, v, __ATOMIC_RELAXED, __HIP_MEMORY_SCOPE_AGENT); }
__device__ __forceinline__ unsigned xb_xcc_id() { return (unsigned)__builtin_amdgcn_s_getreg((3 << 11) | 20) & 0xFu; }
#define XB_SPIN(cond, bar) do { unsigned _sp = 0; while (cond) { __builtin_amdgcn_s_sleep(1); \
    if ((++_sp & 255u) == 0u) { if (xb_ld(&(bar)[XB_TMO])) break; if (_sp > XB_SPIN_CAP) { atomicAdd(&(bar)[XB_TMO], 1u); break; } } } } while (0)

struct XcdBarrier {
    unsigned* bar; unsigned x;
    volatile LAS unsigned* st;
};

__device__ __forceinline__ XcdBarrier xcd_barrier_post(unsigned* bar, volatile LAS unsigned* st) {
    XcdBarrier b; b.bar = bar; b.x = xb_xcc_id(); b.st = st;
    if (threadIdx.x == 0) (void)xb_add(&bar[XB_XCNT(b.x)], 1u);
    return b;
}
__device__ __forceinline__ void xcd_barrier_complete(unsigned* bar, unsigned x, unsigned& nloc, unsigned& nx) {
    const unsigned G = gridDim.x * gridDim.y * gridDim.z;
    unsigned sum, cnt, mine, sp = 0u;
    for (;;) {
        sum = 0u; cnt = 0u; mine = 0u;
#pragma unroll
        for (unsigned j = 0; j < 16; ++j) { const unsigned c = xb_ld(&bar[XB_XCNT(j)]); sum += c; cnt += (c > 0u) ? 1u : 0u; mine = (j == x) ? c : mine; }
        if (sum == G) break;
        __builtin_amdgcn_s_sleep(1);
        if ((++sp & 255u) == 0u) { if (xb_ld(&bar[XB_TMO])) break; if (sp > XB_SPIN_CAP) { atomicAdd(&bar[XB_TMO], 1u); break; } }
    }
    nloc = mine > 0u ? mine : 1u; nx = cnt > 0u ? cnt : 1u;
}

__device__ __forceinline__ void xcd_barrier(const XcdBarrier& b) {
    asm volatile("s_waitcnt vmcnt(0)" ::: "memory");
    __syncthreads();
    if (threadIdx.x == 0) {
        unsigned* bar = b.bar;
        __builtin_amdgcn_s_waitcnt(0);
        unsigned nloc = b.st[0], nx = b.st[1];
        if (nloc == 0u) { xcd_barrier_complete(bar, b.x, nloc, nx); b.st[0] = nloc; b.st[1] = nx; }
        const unsigned old = xb_add(&bar[XB_XSUB(b.x)], 1u);
        const unsigned gen = old / nloc;
        if (old + 1u == (gen + 1u) * nloc) {
            __builtin_amdgcn_fence(__ATOMIC_RELEASE, "agent");
            asm volatile("s_waitcnt vmcnt(0)" ::: "memory");
            const unsigned og = xb_add(&bar[XB_TOP], 1u);
            const unsigned tg = og / nx;
            if (og + 1u == (tg + 1u) * nx) xb_add(&bar[XB_TOPGEN], 1u);
            else XB_SPIN(xb_ld(&bar[XB_TOPGEN]) == tg, bar);
            __builtin_amdgcn_fence(__ATOMIC_ACQUIRE, "agent");
            xb_add(&bar[XB_XGEN(b.x)], 1u);
            asm volatile("s_waitcnt vmcnt(0)" ::: "memory");
        } else {
            XB_SPIN(xb_ld(&bar[XB_XGEN(b.x)]) == gen, bar);
            __builtin_amdgcn_fence(__ATOMIC_ACQUIRE, "agent");
            asm volatile("s_waitcnt vmcnt(0)" ::: "memory");
        }
    }
    __syncthreads();
}

constexpr int PROBE_BAR = 0;
constexpr int PROBE_DUP = -1;
enum { K_PRO = 0, K_GS, K_GW, K_NR, K_AA, K_AB0, K_AB1, K_AB2 };
__global__ void __launch_bounds__(512, 2) yoco_fwd(Params P) {
    extern __shared__ __attribute__((aligned(16))) unsigned char lds_raw[];
    LAS unsigned char* lds = (LAS unsigned char*)lds_raw;
    cg::grid_group grid = cg::this_grid();
    volatile LAS unsigned* xst = (volatile LAS unsigned*)(lds + LDS_BYTES - 16);
    if (threadIdx.x < 4) xst[threadIdx.x] = 0u;
    __syncthreads();
    XcdBarrier xb = xcd_barrier_post((unsigned*)P.ws, xst);
    grid.sync();
#define PH_BEGIN() int tid = threadIdx.x; asm volatile("" : "+v"(tid)); const int lane = tid & 63, wid = __builtin_amdgcn_readfirstlane(tid >> 6); \
        unsigned char* ws = P.ws; asm volatile("" : "+s"(ws)); (void)lane; (void)wid;
#define BARRIER() do { for (int k_ = 0; k_ < 1 + PROBE_BAR; ++k_) xcd_barrier(xb); } while (0)
#define REPS(ph) for (int rep_ = 0; rep_ < ((PROBE_DUP == (ph)) ? 2 : 1); ++rep_)
#define PH_GS(ph, AOFF, BOFF, N_, K_, OOFF) { PH_BEGIN(); REPS(ph) { pg8::Gemm g{(const bf16_t*)(ws + (AOFF)), (const bf16_t*)(ws + (BOFF)), MROWS, N_, K_}; pg8::StaticOrder S; S.init(MROWS, N_, (int)gridDim.x, (int)blockIdx.x); \
        pg8::EpiStore E{(bf16_t*)(ws + (OOFF)), N_}; pg8::gemm_phase<pg8::EpiStore, pg8::StaticOrder, true, true>(lds, g, S, E); } } BARRIER();
#define PH_GW(ph, BOFF) { PH_BEGIN(); REPS(ph) { pg8::Gemm g{(const bf16_t*)(ws + WS_XN), (const bf16_t*)(ws + (BOFF)), MROWS, 2 * DFF, DM}; pg8::StaticOrder S; S.init(MROWS, 2 * DFF, (int)gridDim.x, (int)blockIdx.x); \
        pg8::EpiSwiglu E{(bf16_t*)(ws + WS_ACT), DFF}; pg8::gemm_phase<pg8::EpiSwiglu, pg8::StaticOrder, true, true>(lds, g, S, E); } } BARRIER();
#define PH_NR(ph, GI, XIN, XNO) { PH_BEGIN(); REPS(ph) { norm_res_phase((const bf16_t*)(ws + WS_H), P.gains + (GI) * DM, XIN, P.out, XNO, lane, wid); } }
    { PH_BEGIN(); REPS(0) { prologue(P, lds, tid, lane, wid); } } BARRIER();
    PH_GS(1, WS_XN, WS_WQKVA, 3072, 1024, WS_QKV)
    { PH_BEGIN(); REPS(2) { attnA_phase(lds, (const bf16_t*)(ws + WS_QKV), (bf16_t*)(ws + WS_OB), tid, lane, wid); } } BARRIER();
    PH_GS(3, WS_OB, WS_WOA, 1024, 1024, WS_H)
    PH_NR(4, 1, P.x, (bf16_t*)(ws + WS_XN)) BARRIER();
    PH_GW(5, WS_WGU0)
    PH_GS(6, WS_ACT, WS_WD0, 1024, DFF, WS_H)
    PH_NR(7, 3, P.out, (bf16_t*)(ws + WS_XN)) BARRIER();
    PH_GS(8, WS_XN, WS_WB, 3072, 1024, WS_QKV)
    { PH_BEGIN(); REPS(9) { attnB_phase<1, false>(lds, (const bf16_t*)(ws + WS_QKV), (bf16_t*)(ws + WS_OB), (float*)(ws + WS_LSE0), (const float*)(ws + WS_BIAS), nullptr, nullptr, nullptr, tid, lane, wid); } } BARRIER();
    PH_GS(10, WS_XN, WS_WB + 6 * MiB, 3072, 1024, WS_QKV)
    { PH_BEGIN(); REPS(11) { attnB_phase<4, false>(lds, (const bf16_t*)(ws + WS_QKV), (bf16_t*)(ws + WS_H), (float*)(ws + WS_LSE1), (const float*)(ws + WS_BIAS) + 3072, nullptr, nullptr, nullptr, tid, lane, wid); } } BARRIER();
    PH_GS(12, WS_XN, WS_WB + 12 * MiB, 3072, 1024, WS_QKV)
    { PH_BEGIN(); attnB_phase<16, true>(lds, (const bf16_t*)(ws + WS_QKV), (bf16_t*)(ws + WS_OB), nullptr, (const float*)(ws + WS_BIAS) + 6144, (const bf16_t*)(ws + WS_H), (const float*)(ws + WS_LSE0), (const float*)(ws + WS_LSE1), tid, lane, wid); } BARRIER();
    PH_GS(14, WS_OB, WS_WOB, 1024, 1024, WS_H)
    PH_NR(15, 5, P.out, (bf16_t*)(ws + WS_XN)) BARRIER();
    PH_GW(16, WS_WGU1)
    PH_GS(17, WS_ACT, WS_WD1, 1024, DFF, WS_H)
    PH_NR(18, 7, P.out, (bf16_t*)nullptr)
}

extern "C" void kernel_launch(void* const* d_in, const int* in_sizes, int n_in, void* d_out, int out_size, void* d_ws, size_t ws_size, hipStream_t stream) {
    static int grid = 0;
    if (grid == 0) {
        if (n_in != 11 || out_size != MROWS * DM || ws_size < WS_END) { fprintf(stderr, "kernel_launch: unexpected shapes (n_in %d, out %d, ws %zu)\n", n_in, out_size, ws_size); grid = -1; return; }
        int dev = 0, cus = 0, per_cu = 0;
        (void)hipGetDevice(&dev); (void)hipDeviceGetAttribute(&cus, hipDeviceAttributeMultiprocessorCount, dev);
        if (hipFuncSetAttribute((const void*)yoco_fwd, hipFuncAttributeMaxDynamicSharedMemorySize, LDS_BYTES) != hipSuccess) { fprintf(stderr, "kernel_launch: hipFuncSetAttribute failed\n"); grid = -1; return; }
        if (hipOccupancyMaxActiveBlocksPerMultiprocessor(&per_cu, (const void*)yoco_fwd, 512, LDS_BYTES) != hipSuccess || per_cu < 1) { fprintf(stderr, "kernel_launch: occupancy query failed (%d)\n", per_cu); per_cu = 1; }
        (void)hipGetLastError();
        grid = cus * per_cu;
        if (grid <= 0) grid = 256;
    }
    if (grid < 0) return;
    if (hipMemsetAsync(d_ws, 0, 16384, stream) != hipSuccess) { fprintf(stderr, "kernel_launch: memset failed\n"); return; }
    Params p{};
    p.x = (const float*)d_in[0]; p.gains = (const float*)d_in[1]; p.w_qkv_a = (const float*)d_in[2]; p.w_o_a = (const float*)d_in[3]; p.g_kv = (const float*)d_in[4];
    p.w_kv_b = (const float*)d_in[5]; p.w_q_b = (const float*)d_in[6]; p.w_o_b = (const float*)d_in[7]; p.rel_bias = (const float*)d_in[8]; p.w_gu = (const float*)d_in[9]; p.w_down = (const float*)d_in[10];
    p.out = (float*)d_out; p.ws = (unsigned char*)d_ws;
    void* args[] = {&p};
    const hipError_t e = hipLaunchCooperativeKernel((const void*)yoco_fwd, dim3(grid), dim3(512), args, LDS_BYTES, stream);
    if (e != hipSuccess) fprintf(stderr, "kernel_launch: cooperative launch failed: %s (grid %d)\n", hipGetErrorString(e), grid);
}
```

```cpp
#include <hip/hip_runtime.h>
#include <hip/hip_cooperative_groups.h>
#include <cstdio>
#include <cstdint>
namespace cg = cooperative_groups;
namespace pg8 {
#define PG8_LAS __attribute__((address_space(3)))
typedef unsigned short bf16_t;
typedef short bf16x8 __attribute__((ext_vector_type(8)));
typedef float f32x4 __attribute__((ext_vector_type(4)));
typedef unsigned u32x4 __attribute__((ext_vector_type(4)));
constexpr int BM = 256, BK = 64, HALF = 128, HTB = HALF * BK * 2  , STAGE_BYTES = 8 * HTB, NXCD = 8, WGM = 8;

__host__ __device__ __forceinline__ int lds_byte(int r, int c) { const int st = (r >> 4) * 2 + (c >> 5), rr = r & 15, cc = c & 31, ob = rr * 64 + cc * 2; return st * 1024 + (ob ^ (((ob >> 9) & 1) << 5)); }
__host__ __device__ __forceinline__ void stage_rc(int b, int& R, int& C) { const int st = b / 1024, sb = b % 1024, swz = sb ^ (((sb >> 9) & 1) << 5); R = (st >> 1) * 16 + swz / 64; C = (st & 1) * 32 + (swz % 64) / 2; }
__host__ __device__ __forceinline__ int perm32(int rho) { const int n = rho >> 4, i = rho & 15; return 8 * (i >> 2) + 4 * n + (i & 3); }

struct Unit { int pm, pn; };
struct Gemm { const bf16_t* A; const bf16_t* Bt; int M, N, K; };

struct StaticOrder {
    int nM, nN, nwg, G, c;
    __host__ __device__ void init(int M, int N, int G_, int c_) { nM = M / BM; nN = N / BM; nwg = nM * nN; G = G_; c = c_; }
    __host__ __device__ bool next(int i, Unit& u) const {
        const long L = (long)i * G + c; if (L >= nwg) return false;
        int wgid = (int)L; { const int q = nwg / NXCD, r = nwg % NXCD, xcd = wgid % NXCD, off = wgid / NXCD; wgid = (xcd < r ? xcd * (q + 1) : r * (q + 1) + (xcd - r) * q) + off; }
        const int nig = WGM * nN, gid = wgid / nig, fm = gid * WGM, gsz = (nM - fm) < WGM ? (nM - fm) : WGM;
        u.pm = fm + ((wgid % nig) % gsz); u.pn = (wgid % nig) / gsz; return true;
    }
    __device__ __forceinline__ void a_ready(const Unit&) const {}
    __device__ __forceinline__ void done(const Unit&) const {}
};


typedef float f32x2_t __attribute__((ext_vector_type(2))); typedef __bf16 bf16x2_t __attribute__((ext_vector_type(2)));
__device__ __forceinline__ unsigned cvtpk(float lo, float hi) { f32x2_t v = {lo, hi}; bf16x2_t b = __builtin_convertvector(v, bf16x2_t); return __builtin_bit_cast(unsigned, b); }

struct EpiStore {
    static constexpr bool PERM = true, AFTER_DRAIN = false;
    bf16_t* O; int ldc;
    __device__ __forceinline__ void operator()(const f32x4 (&acc)[2][2][4][2], const Unit& u, int wr, int wc, int fr, int fq) const {
        const int row0 = u.pm * BM + wr * 64 + fr; const int col0 = u.pn * BM + wc * 32 + 8 * fq;
#pragma unroll
        for (int ai = 0; ai < 2; ++ai)
#pragma unroll
            for (int m = 0; m < 4; ++m) { bf16_t* rowp = O + (size_t)(row0 + ai * HALF + m * 16) * ldc + col0;
#pragma unroll
                for (int bj = 0; bj < 2; ++bj) { const f32x4 v0 = acc[ai][bj][m][0], v1 = acc[ai][bj][m][1];
                    u32x4 w; w.x = cvtpk(v0[0], v0[1]); w.y = cvtpk(v0[2], v0[3]); w.z = cvtpk(v1[0], v1[1]); w.w = cvtpk(v1[2], v1[3]);
                    *(u32x4*)(rowp + bj * HALF) = w; } }
    }
};
struct EpiSwiglu {
    static constexpr bool PERM = true, AFTER_DRAIN = false;
    bf16_t* O; int ldc;
    __device__ __forceinline__ float act(float g, float u) const { const float e = __builtin_amdgcn_exp2f(-1.4426950408889634f * g); return g * u * __builtin_amdgcn_rcpf(1.0f + e); }
    __device__ __forceinline__ void operator()(const f32x4 (&acc)[2][2][4][2], const Unit& u, int wr, int wc, int fr, int fq) const {
        const int row0 = u.pm * BM + wr * 64 + fr; const int col0 = u.pn * HALF + wc * 32 + 8 * fq;
#pragma unroll
        for (int ai = 0; ai < 2; ++ai)
#pragma unroll
            for (int m = 0; m < 4; ++m) { bf16_t* rowp = O + (size_t)(row0 + ai * HALF + m * 16) * ldc + col0;
                const f32x4 g0 = acc[ai][0][m][0], g1 = acc[ai][0][m][1], u0 = acc[ai][1][m][0], u1 = acc[ai][1][m][1];
                u32x4 w; w.x = cvtpk(act(g0[0], u0[0]), act(g0[1], u0[1])); w.y = cvtpk(act(g0[2], u0[2]), act(g0[3], u0[3]));
                w.z = cvtpk(act(g1[0], u1[0]), act(g1[1], u1[1])); w.w = cvtpk(act(g1[2], u1[2]), act(g1[3], u1[3]));
                *(u32x4*)rowp = w; }
    }
};

template <class Epi, class Sched, bool ALIGN_EPI = false, bool SP2 = false>
__device__ __forceinline__ void gemm_phase(PG8_LAS unsigned char* lds, const Gemm g, const Sched& S, const Epi& E) {
    const int tid = threadIdx.x, wid = __builtin_amdgcn_readfirstlane(tid >> 6), lane = tid & 63, wr = wid >> 2, wc = wid & 3, fr = lane & 15, fq = lane >> 4;
    const int K = g.K, nt = K / BK;
    unsigned voffA[2], voffB[2];
#pragma unroll
    for (int i = 0; i < 2; ++i) { int R, C; stage_rc(tid * 16 + i * 8192, R, C); const int Rb = Epi::PERM ? ((R & ~31) + perm32(R & 31)) : R;
        voffA[i] = (unsigned)(R * K + C) * 2u; voffB[i] = (unsigned)(Rb * K + C) * 2u; }
    const size_t kstep = (size_t)(BK * 2);
    const size_t hstep = (size_t)HALF * K * 2;
    const size_t tstep = 2 * hstep;
    const unsigned ldsw = (unsigned)wid * 1024u;
    const int aoff = lds_byte(wr * 64 + fr, fq * 8), boff = lds_byte(wc * 32 + fr, fq * 8);
#define PG8_SA(b, h) (((b) * 2 + (h)) * HTB)
#define PG8_SB(b, h) ((4 + (b) * 2 + (h)) * HTB)
#define PG8_STAGE(bufoff, gbase, voff) do { _Pragma("unroll") for (int _i = 0; _i < 2; ++_i) \
        __builtin_amdgcn_global_load_lds((const unsigned*)((const char*)(gbase) + (voff)[_i]), (PG8_LAS unsigned*)(lds + (bufoff) + ldsw + _i * 8192), 16, 0, 0); } while (0)
#define PG8_LDA(dst, b, h) do { _Pragma("unroll") for (int m = 0; m < 4; ++m) _Pragma("unroll") for (int k = 0; k < 2; ++k) dst[m][k] = *(const PG8_LAS bf16x8*)(lds + PG8_SA(b, h) + aoff + m * 2048 + k * 1024); } while (0)
#define PG8_LDB(dst, b, h) do { _Pragma("unroll") for (int n = 0; n < 2; ++n) _Pragma("unroll") for (int k = 0; k < 2; ++k) dst[n][k] = *(const PG8_LAS bf16x8*)(lds + PG8_SB(b, h) + boff + n * 2048 + k * 1024); } while (0)
#define PG8_MMA(ai, bj, At, Bt) do { __builtin_amdgcn_s_setprio(1); _Pragma("unroll") for (int m = 0; m < 4; ++m) _Pragma("unroll") for (int n = 0; n < 2; ++n) _Pragma("unroll") for (int k = 0; k < 2; ++k) \
        acc[ai][bj][m][n] = __builtin_amdgcn_mfma_f32_16x16x32_bf16(Bt[n][k], At[m][k], acc[ai][bj][m][n], 0, 0, 0); __builtin_amdgcn_s_setprio(0); } while (0)
#define PG8_WAIT_V(n) asm volatile("s_waitcnt vmcnt(" #n ")" ::: "memory")
#define PG8_WAIT_L(n) asm volatile("s_waitcnt lgkmcnt(" #n ")" ::: "memory")
#define PG8_BAR __builtin_amdgcn_s_barrier()
#define PG8_SCHED __builtin_amdgcn_sched_barrier(0)
    Unit cur, nxt; int ui = 0;
    if (!S.next(0, cur)) return;
    f32x4 acc[2][2][4][2];
#pragma unroll
    for (int a = 0; a < 2; ++a)
#pragma unroll
        for (int b = 0; b < 2; ++b)
#pragma unroll
            for (int m = 0; m < 4; ++m)
#pragma unroll
                for (int n = 0; n < 2; ++n) acc[a][b][m][n] = (f32x4){0.f, 0.f, 0.f, 0.f};
    bf16x8 At[4][2], B0[2][2], B1[2][2];
    const char* cA = (const char*)g.A + (size_t)cur.pm * tstep; const char* cB = (const char*)g.Bt + (size_t)cur.pn * tstep;
    S.a_ready(cur);
    if constexpr (SP2) {
        PG8_STAGE(PG8_SB(0, 0), cB, voffB); PG8_STAGE(PG8_SB(0, 1), cB + hstep, voffB); PG8_STAGE(PG8_SA(0, 0), cA, voffA); PG8_STAGE(PG8_SA(0, 1), cA + hstep, voffA);
        if (wr == 1) PG8_BAR;
        PG8_WAIT_V(2); PG8_BAR;
        PG8_STAGE(PG8_SB(1, 0), cB + kstep, voffB); PG8_STAGE(PG8_SA(1, 0), cA + kstep, voffA); PG8_STAGE(PG8_SB(1, 1), cB + hstep + kstep, voffB);
        PG8_WAIT_V(6); PG8_BAR;
    } else {
        PG8_STAGE(PG8_SB(0, 0), cB, voffB); PG8_STAGE(PG8_SA(0, 0), cA, voffA); PG8_STAGE(PG8_SB(0, 1), cB + hstep, voffB); PG8_STAGE(PG8_SA(0, 1), cA + hstep, voffA);
        if (wr == 1) PG8_BAR;
        PG8_WAIT_V(4); PG8_BAR;
        PG8_STAGE(PG8_SB(1, 0), cB + kstep, voffB); PG8_STAGE(PG8_SA(1, 0), cA + kstep, voffA); PG8_STAGE(PG8_SB(1, 1), cB + hstep + kstep, voffB);
        PG8_WAIT_V(6); PG8_BAR;
    }
    for (;;) {
        const bool has_next = S.next(ui + 1, nxt);
        const char* nA = has_next ? (const char*)g.A + (size_t)nxt.pm * tstep : cA; const char* nB = has_next ? (const char*)g.Bt + (size_t)nxt.pn * tstep : cB;
        for (int t = 0; t < nt; t += 2) {
            const bool last = (t == nt - 2);
            const char* a1 = cA + (size_t)(t + 1) * kstep;
            const char* a2 = last ? nA : cA + (size_t)(t + 2) * kstep; const char* b2 = last ? nB : cB + (size_t)(t + 2) * kstep;
            const char* a3 = a2 + kstep; const char* b3 = b2 + kstep;
            if (last && has_next) S.a_ready(nxt);
            if constexpr (SP2) {
            PG8_LDB(B0, 0, 0); PG8_LDB(B1, 0, 1); PG8_SCHED; PG8_LDA(At, 0, 0); PG8_STAGE(PG8_SA(1, 1), a1 + hstep, voffA);
            PG8_WAIT_V(8); PG8_WAIT_L(0); PG8_BAR; PG8_MMA(0, 0, At, B0); PG8_MMA(0, 1, At, B1); PG8_BAR; PG8_SCHED;
            PG8_LDA(At, 0, 1); PG8_STAGE(PG8_SB(0, 0), b2, voffB); PG8_STAGE(PG8_SB(0, 1), b2 + hstep, voffB); PG8_STAGE(PG8_SA(0, 0), a2, voffA);
            PG8_WAIT_V(8); PG8_WAIT_L(0); PG8_BAR; PG8_MMA(1, 0, At, B0); PG8_MMA(1, 1, At, B1); PG8_BAR; PG8_SCHED;
            PG8_LDB(B0, 1, 0); PG8_LDB(B1, 1, 1); PG8_SCHED; PG8_LDA(At, 1, 0); PG8_STAGE(PG8_SA(0, 1), a2 + hstep, voffA);
            PG8_WAIT_V(8); PG8_WAIT_L(0); PG8_BAR; PG8_MMA(0, 0, At, B0); PG8_MMA(0, 1, At, B1); PG8_BAR; PG8_SCHED;
            PG8_LDA(At, 1, 1); PG8_STAGE(PG8_SB(1, 0), b3, voffB); PG8_STAGE(PG8_SB(1, 1), b3 + hstep, voffB); PG8_STAGE(PG8_SA(1, 0), a3, voffA);
            PG8_WAIT_V(8); PG8_WAIT_L(0); PG8_BAR; PG8_MMA(1, 0, At, B0); PG8_MMA(1, 1, At, B1); PG8_BAR; PG8_SCHED;
            } else {
            PG8_LDB(B0, 0, 0); PG8_SCHED; PG8_LDA(At, 0, 0); PG8_STAGE(PG8_SA(1, 1), a1 + hstep, voffA);
            PG8_WAIT_L(8); PG8_BAR; PG8_WAIT_L(0); PG8_MMA(0, 0, At, B0); PG8_BAR; PG8_SCHED;
            PG8_LDB(B1, 0, 1); PG8_STAGE(PG8_SB(0, 0), b2, voffB);
            PG8_BAR; PG8_WAIT_L(0); PG8_MMA(0, 1, At, B1); PG8_BAR;
            PG8_LDA(At, 0, 1); PG8_STAGE(PG8_SA(0, 0), a2, voffA);
            PG8_BAR; PG8_WAIT_L(0); PG8_MMA(1, 0, At, B0); PG8_BAR; PG8_SCHED;
            PG8_STAGE(PG8_SB(0, 1), b2 + hstep, voffB);
            PG8_WAIT_V(6); PG8_BAR; PG8_MMA(1, 1, At, B1); PG8_BAR;
            PG8_LDB(B0, 1, 0); PG8_SCHED; PG8_LDA(At, 1, 0); PG8_STAGE(PG8_SA(0, 1), a2 + hstep, voffA);
            PG8_WAIT_L(8); PG8_BAR; PG8_WAIT_L(0); PG8_MMA(0, 0, At, B0); PG8_BAR; PG8_SCHED;
            PG8_LDB(B1, 1, 1); PG8_STAGE(PG8_SB(1, 0), b3, voffB);
            PG8_BAR; PG8_WAIT_L(0); PG8_MMA(0, 1, At, B1); PG8_BAR;
            PG8_LDA(At, 1, 1); PG8_STAGE(PG8_SA(1, 0), a3, voffA);
            PG8_BAR; PG8_WAIT_L(0); PG8_MMA(1, 0, At, B0); PG8_BAR; PG8_SCHED;
            PG8_STAGE(PG8_SB(1, 1), b3 + hstep, voffB);
            PG8_WAIT_V(6); PG8_BAR; PG8_MMA(1, 1, At, B1); PG8_BAR;
            }
        }
        if constexpr (ALIGN_EPI) { if (wr == 0) PG8_BAR; }
        if constexpr (!Epi::AFTER_DRAIN) { E(acc, cur, wr, wc, fr, fq); S.done(cur); }
        if (!has_next) break;
#pragma unroll
        for (int a = 0; a < 2; ++a)
#pragma unroll
            for (int b = 0; b < 2; ++b)
#pragma unroll
                for (int m = 0; m < 4; ++m)
#pragma unroll
                    for (int n = 0; n < 2; ++n) acc[a][b][m][n] = (f32x4){0.f, 0.f, 0.f, 0.f};
        cur = nxt; cA = nA; cB = nB; ++ui;
        if constexpr (ALIGN_EPI) { if (wr == 1) PG8_BAR; }
    }
    PG8_WAIT_V(0);
    if constexpr (!ALIGN_EPI) { if (wr == 0) PG8_BAR; }
    PG8_BAR;
    if constexpr (Epi::AFTER_DRAIN) { E.fused(acc, cur, wr, wc, fr, fq, lds, wid, lane); S.done(cur); }
#undef PG8_SA
#undef PG8_SB
#undef PG8_STAGE
#undef PG8_LDA
#undef PG8_LDB
#undef PG8_MMA
#undef PG8_WAIT_V
#undef PG8_WAIT_L
#undef PG8_BAR
#undef PG8_SCHED
}
}

#define LAS __attribute__((address_space(3)))
typedef pg8::bf16_t bf16_t; typedef pg8::bf16x8 bf16x8; typedef pg8::f32x4 f32x4; typedef pg8::u32x4 u32x4;
typedef float f32x16 __attribute__((ext_vector_type(16)));
typedef unsigned u32x2 __attribute__((ext_vector_type(2)));
typedef short v4i16_t __attribute__((ext_vector_type(4)));
using pg8::cvtpk;

constexpr int BATCH = 16, SEQ = 2048, DM = 1024, NH = 16, HD = 64, DFF = 2816, MROWS = BATCH * SEQ;
constexpr float RMS_EPS = 1e-6f;
constexpr float LOG2E = 1.4426950408889634f;
constexpr float QSCALE = 0.125f * LOG2E;
constexpr size_t MiB = 1u << 20;
constexpr size_t WS_WQKVA = 1 * MiB, WS_WOA = 7 * MiB, WS_WGU0 = 9 * MiB, WS_WD0 = 20 * MiB, WS_WB = 26 * MiB  , WS_WOB = 44 * MiB,
                 WS_WGU1 = 46 * MiB, WS_WD1 = 57 * MiB, WS_BIAS = 63 * MiB, WS_XN = 65 * MiB, WS_QKV = 129 * MiB, WS_ACT = 129 * MiB  ,
                 WS_OB = 321 * MiB, WS_H = 385 * MiB, WS_LSE0 = 449 * MiB, WS_LSE1 = 451 * MiB, WS_END = 453 * MiB;
constexpr int LDS_BYTES = 147456;

struct Params { const float *x, *gains, *w_qkv_a, *w_o_a, *g_kv, *w_kv_b, *w_q_b, *w_o_b, *rel_bias, *w_gu, *w_down; float* out; unsigned char* ws; };

#define LDS_WAIT() asm volatile("s_waitcnt lgkmcnt(0)" ::: "memory")
__device__ __forceinline__ float wave_sum(float v) {
#pragma unroll
    for (int o = 1; o < 64; o <<= 1) v += __shfl_xor(v, o);
    return v;
}
__device__ __forceinline__ int crow(int r, int hi) { return (r & 3) + 8 * (r >> 2) + 4 * hi; }
__device__ __forceinline__ float bf_lo(unsigned w) { return __uint_as_float(w << 16); }
__device__ __forceinline__ float bf_hi(unsigned w) { return __uint_as_float(w & 0xffff0000u); }

__device__ __forceinline__ void conv_item(const float* __restrict__ W, int ldw, int col, int K, const float* __restrict__ gain, float scale, bf16_t* WT, int drow, LAS float* scr, int kb, int lane) {
    const int k0 = 64 * kb;
#pragma unroll 8
    for (int i = 0; i < 32; ++i) { const int kk = 2 * i + (lane >> 5); const float v = W[(size_t)(k0 + kk) * ldw + col + (lane & 31)];
        const float gs = gain ? gain[k0 + kk] * scale : scale; scr[kk * 33 + (lane & 31)] = v * gs; }
    LDS_WAIT();
    const int c = lane & 7;
#pragma unroll
    for (int j = 0; j < 4; ++j) { const int n = (lane >> 3) + 8 * j; const LAS float* s = scr + (8 * c) * 33 + n;
        u32x4 o; o.x = cvtpk(s[0 * 33], s[1 * 33]); o.y = cvtpk(s[2 * 33], s[3 * 33]); o.z = cvtpk(s[4 * 33], s[5 * 33]); o.w = cvtpk(s[6 * 33], s[7 * 33]);
        *(u32x4*)(WT + (size_t)(drow + n) * K + k0 + 8 * c) = o; }
    LDS_WAIT();
}
template <int MODE> __device__ __forceinline__ void conv_seg(const float* src, int ld, int col0, int ncols, int K, const float* gain, float scale, bf16_t* dst, int drow0,
                                                             LAS float* scr, int gw, int NGW, int& off, int lane) {
    const int nblk = ncols >> 5, items = nblk * (K >> 6);
    int it0 = gw - (off % NGW); if (it0 < 0) it0 += NGW; off += items;
    for (int it = it0; it < items; it += NGW) {
        const int kb = it / nblk, nb = it - kb * nblk, c = 32 * nb; int drow;
        if (MODE == 1) { const int upf = c >= DFF ? 1 : 0, cc = c - upf * DFF; drow = 256 * (cc >> 7) + 128 * upf + (cc & 127); } else drow = drow0 + c;
        conv_item(src, ld, col0 + c, K, gain, scale, dst, drow, scr, kb, lane);
    }
}
__device__ __forceinline__ void norm_row_bf16(const float* xrow, bf16_t* orow, int lane) {
    const f32x4* xr = (const f32x4*)xrow + lane;
    f32x4 v[4]; float s = 0.f;
#pragma unroll
    for (int j = 0; j < 4; ++j) { v[j] = xr[64 * j]; s += (v[j].x * v[j].x + v[j].y * v[j].y) + (v[j].z * v[j].z + v[j].w * v[j].w); }
    const float r = 1.0f / sqrtf(wave_sum(s) * (1.f / DM) + RMS_EPS);
    u32x2* o8 = (u32x2*)orow + lane;
#pragma unroll
    for (int j = 0; j < 4; ++j) { u32x2 w; w.x = cvtpk(v[j].x * r, v[j].y * r); w.y = cvtpk(v[j].z * r, v[j].w * r); o8[64 * j] = w; }
}
__device__ __forceinline__ void prologue(const Params& P, LAS unsigned char* lds, int tid, int lane, int wave) {
    LAS float* scr = (LAS float*)(lds + wave * 16384);
    const int G = gridDim.x, gw = blockIdx.x * 8 + wave, NGW = G * 8;
    unsigned char* ws = P.ws; int off = 0;
    const float* g00 = P.gains + 0 * DM; const float* g02 = P.gains + 2 * DM; const float* g10 = P.gains + 4 * DM; const float* g12 = P.gains + 6 * DM;
    conv_seg<0>(P.w_qkv_a, 3072, 0, 1024, 1024, g00, QSCALE, (bf16_t*)(ws + WS_WQKVA), 0, scr, gw, NGW, off, lane);
    conv_seg<0>(P.w_qkv_a, 3072, 1024, 2048, 1024, g00, 1.0f, (bf16_t*)(ws + WS_WQKVA), 1024, scr, gw, NGW, off, lane);
    conv_seg<0>(P.w_o_a, 1024, 0, 1024, 1024, nullptr, 1.0f, (bf16_t*)(ws + WS_WOA), 0, scr, gw, NGW, off, lane);
    conv_seg<1>(P.w_gu, 2 * DFF, 0, 2 * DFF, 1024, g02, 1.0f, (bf16_t*)(ws + WS_WGU0), 0, scr, gw, NGW, off, lane);
    conv_seg<0>(P.w_down, 1024, 0, 1024, DFF, nullptr, 1.0f, (bf16_t*)(ws + WS_WD0), 0, scr, gw, NGW, off, lane);
    for (int g = 0; g < 3; ++g) {
        bf16_t* wb = (bf16_t*)(ws + WS_WB + (size_t)g * 6 * MiB);
        conv_seg<0>(P.w_q_b, 3072, 1024 * g, 1024, 1024, g10, QSCALE, wb, 0, scr, gw, NGW, off, lane);
        conv_seg<0>(P.w_kv_b, 6144, 2048 * g, 2048, 1024, P.g_kv, 1.0f, wb, 1024, scr, gw, NGW, off, lane);
    }
    conv_seg<0>(P.w_o_b, 1024, 0, 1024, 1024, nullptr, 1.0f, (bf16_t*)(ws + WS_WOB), 0, scr, gw, NGW, off, lane);
    conv_seg<1>(P.w_gu + (size_t)DM * 2 * DFF, 2 * DFF, 0, 2 * DFF, 1024, g12, 1.0f, (bf16_t*)(ws + WS_WGU1), 0, scr, gw, NGW, off, lane);
    conv_seg<0>(P.w_down + (size_t)DFF * DM, 1024, 0, 1024, DFF, nullptr, 1.0f, (bf16_t*)(ws + WS_WD1), 0, scr, gw, NGW, off, lane);
    bf16_t* XN = (bf16_t*)(ws + WS_XN);
    for (int m = gw; m < MROWS; m += NGW) norm_row_bf16(P.x + (size_t)m * DM, XN + (size_t)m * DM, lane);
    float* BT = (float*)(ws + WS_BIAS);
    for (int idx = blockIdx.x * 512 + tid; idx < 3 * 16 * 192; idx += G * 512) {
        const int g = idx / 3072, rem = idx - g * 3072, h = rem / 192, e = rem - h * 192, rel = e - 32; float v = 0.f;
        if (rel >= 0 && rel <= 128) { const int dl = (g == 0) ? 1 : ((g == 1) ? 4 : 16); const int n = rel * dl; int bk;
            if (n < 16) bk = n;
            else { bk = 16 + (n >= 22) + (n >= 30) + (n >= 40) + (n >= 54) + (n >= 73) + (n >= 99) + (n >= 134) + (n >= 182) + (n >= 246) + (n >= 332) + (n >= 450) + (n >= 609) + (n >= 825) + (n >= 1117) + (n >= 1513); }
            v = P.rel_bias[bk * 16 + h] * LOG2E; }
        BT[idx] = v;
    }
}

__device__ __forceinline__ void norm_res_phase(const bf16_t* H, const float* gain, const float* Xin, float* Xout, bf16_t* XN, int lane, int wave) {
    const int gw = blockIdx.x * 8 + wave, NGW = gridDim.x * 8;
    f32x4 gv[4];
#pragma unroll
    for (int j = 0; j < 4; ++j) gv[j] = *((const f32x4*)gain + lane + 64 * j);
    for (int m = gw; m < MROWS; m += NGW) {
        const u32x2* hp = (const u32x2*)(H + (size_t)m * DM) + lane;
        const f32x4* xp = (const f32x4*)(Xin + (size_t)m * DM) + lane;
        f32x4 hv[4], xv[4]; float ss = 0.f;
#pragma unroll
        for (int j = 0; j < 4; ++j) { const u32x2 w = hp[64 * j]; xv[j] = xp[64 * j]; hv[j] = (f32x4){bf_lo(w.x), bf_hi(w.x), bf_lo(w.y), bf_hi(w.y)};
            ss += (hv[j].x * hv[j].x + hv[j].y * hv[j].y) + (hv[j].z * hv[j].z + hv[j].w * hv[j].w); }
        const float r = 1.0f / sqrtf(wave_sum(ss) * (1.f / DM) + RMS_EPS);
        float s2 = 0.f; f32x4* op = (f32x4*)(Xout + (size_t)m * DM) + lane;
#pragma unroll
        for (int j = 0; j < 4; ++j) { xv[j] = xv[j] + hv[j] * r * gv[j]; op[64 * j] = xv[j];
            s2 += (xv[j].x * xv[j].x + xv[j].y * xv[j].y) + (xv[j].z * xv[j].z + xv[j].w * xv[j].w); }
        if (XN) { const float r2 = 1.0f / sqrtf(wave_sum(s2) * (1.f / DM) + RMS_EPS); u32x2* o8 = (u32x2*)(XN + (size_t)m * DM) + lane;
#pragma unroll
            for (int j = 0; j < 4; ++j) { u32x2 w; w.x = cvtpk(xv[j].x * r2, xv[j].y * r2); w.y = cvtpk(xv[j].z * r2, xv[j].w * r2); o8[64 * j] = w; } }
    }
}

__device__ __forceinline__ bf16x8 vfrag(const LAS unsigned char* p) {
    const v4i16_t lo = __builtin_amdgcn_ds_read_tr16_b64_v4i16((LAS v4i16_t*)p);
    const v4i16_t hi = __builtin_amdgcn_ds_read_tr16_b64_v4i16((LAS v4i16_t*)(p + 512));
    return (bf16x8){lo[0], lo[1], lo[2], lo[3], hi[0], hi[1], hi[2], hi[3]};
}
__device__ __forceinline__ bf16x8 pack8(const float* a) {
    u32x4 w; w.x = cvtpk(a[0], a[1]); w.y = cvtpk(a[2], a[3]); w.z = cvtpk(a[4], a[5]); w.w = cvtpk(a[6], a[7]); return __builtin_bit_cast(bf16x8, w);
}

template <bool MASK> __device__ __forceinline__ void sb_subtile(const LAS unsigned char* kbuf, const LAS unsigned char* vbuf  , int sub, const bf16x8 (&qf)[4], const int (&kaddr)[4],
                                                                float& carry, f32x16 (&o)[2], int r32, int hh) {
    f32x16 S = {};
#pragma unroll
    for (int dk = 0; dk < 4; ++dk) { const bf16x8 kf = *(const LAS bf16x8*)(kbuf + kaddr[dk] + sub * 512); S = __builtin_amdgcn_mfma_f32_32x32x16_bf16(kf, qf[dk], S, 0, 0, 0); }
    float p[16];
#pragma unroll
    for (int r = 0; r < 16; ++r) { const float u = __builtin_amdgcn_exp2f(S[r]); float wv = __builtin_amdgcn_rcpf(1.0f + u);
        if (MASK) wv = (crow(r, hh) < r32) ? wv : 1.0f; p[r] = wv; }
    float go[4], t[4];
#pragma unroll
    for (int i = 0; i < 4; ++i) { p[4 * i + 2] *= p[4 * i + 3]; p[4 * i + 1] *= p[4 * i + 2]; p[4 * i] *= p[4 * i + 1];
        const auto rr = __builtin_amdgcn_permlane32_swap(__float_as_uint(p[4 * i]), __float_as_uint(p[4 * i]), false, false);
        go[i] = __uint_as_float(rr[1]); t[i] = __uint_as_float(rr[0]) * __uint_as_float(rr[1]); }
    const float R2 = t[3], R1 = t[3] * t[2], R0 = R1 * t[1];
    float E[4];
    E[3] = carry * (hh ? 1.0f : go[3]); E[2] = carry * R2 * (hh ? 1.0f : go[2]); E[1] = carry * R1 * (hh ? 1.0f : go[1]); E[0] = carry * R0 * (hh ? 1.0f : go[0]);
    carry = carry * R0 * t[0];
    float A[16];
#pragma unroll
    for (int i = 0; i < 4; ++i) { const float I3 = E[i] * p[4 * i + 3], I2 = E[i] * p[4 * i + 2], I1 = E[i] * p[4 * i + 1], I0 = E[i] * p[4 * i];
        A[4 * i + 3] = E[i] - I3; A[4 * i + 2] = I3 - I2; A[4 * i + 1] = I2 - I1; A[4 * i] = I1 - I0; }
    const bf16x8 pf0 = pack8(A), pf1 = pack8(A + 8);
#pragma unroll
    for (int dh = 0; dh < 2; ++dh) {
        const bf16x8 v0 = vfrag(vbuf + dh * 4096 + (32 * sub) * 64), v1 = vfrag(vbuf + dh * 4096 + (32 * sub + 16) * 64);
        o[dh] = __builtin_amdgcn_mfma_f32_32x32x16_bf16(pf0, v0, o[dh], 0, 0, 0);
        o[dh] = __builtin_amdgcn_mfma_f32_32x32x16_bf16(pf1, v1, o[dh], 0, 0, 0);
    }
}

__device__ __forceinline__ void attnA_phase(LAS unsigned char* lds, const bf16_t* __restrict__ QKV, bf16_t* __restrict__ O, int tid, int lane, int wid) {
    const int r32 = lane & 31, hh = lane >> 5;
    int kaddr[4];
#pragma unroll
    for (int dk = 0; dk < 4; ++dk) { const int c = 2 * dk + hh; kaddr[dk] = c * 1024 + ((r32 ^ c) << 4); }
    const int vlane = (4 * hh + ((lane & 15) >> 2)) * 64 + ((lane >> 4) & 1) * 32 + (lane & 3) * 8;
    LAS unsigned* flags = (LAS unsigned*)(lds + 32768);
    const int lkey = tid >> 3, lc = tid & 7;
    const int kwoff = lc * 1024 + ((lkey ^ lc) << 4), vwoff = 16384 + (lc >> 2) * 4096 + lkey * 64 + (lc & 3) * 16;
    for (int u = blockIdx.x; u < BATCH * NH * 8; u += gridDim.x) {
        const int bh = u >> 3, qb = ((u & 7) + (u >> 8)) & 7, b = bh >> 4, h = bh & 15;
        const size_t rowbase = (size_t)b * SEQ; const int q0 = qb * 256, R0 = q0 + 32 * wid;
        bf16x8 qf[4];
        { const bf16_t* qp = QKV + (rowbase + R0 + r32) * 3072 + h * 64 + 8 * hh;
#pragma unroll
          for (int dk = 0; dk < 4; ++dk) qf[dk] = *(const bf16x8*)(qp + 16 * dk); }
        const bf16_t* kvg = QKV + (rowbase + lkey) * 3072 + 1024 + h * 64 + 8 * lc;
        const int NT = 4 * qb + 4;
        { const bf16_t* kg = kvg + (size_t)(64 * (NT - 1)) * 3072; const u32x4 kr = *(const u32x4*)kg, vr = *(const u32x4*)(kg + 1024);
          *(LAS u32x4*)(lds + kwoff) = kr; *(LAS u32x4*)(lds + vwoff) = vr; }
        __syncthreads();
        float carry = 1.0f; f32x16 o[2]; o[0] = f32x16{}; o[1] = f32x16{};
        int cur = 0;
        for (int kt = NT - 1; kt >= 0; --kt) {
            u32x4 kr, vr;
            if (kt > 0) { const bf16_t* kg = kvg + (size_t)(64 * (kt - 1)) * 3072; kr = *(const u32x4*)kg; vr = *(const u32x4*)(kg + 1024); }
            const int diff = R0 - 64 * kt;
            const LAS unsigned char* kbuf = lds + cur * 8192; const LAS unsigned char* vbuf = lds + 16384 + cur * 8192 + vlane;
            if (diff >= 64) { sb_subtile<false>(kbuf, vbuf, 1, qf, kaddr, carry, o, r32, hh); sb_subtile<false>(kbuf, vbuf, 0, qf, kaddr, carry, o, r32, hh); }
            else if (diff == 32) { sb_subtile<true>(kbuf, vbuf, 1, qf, kaddr, carry, o, r32, hh); sb_subtile<false>(kbuf, vbuf, 0, qf, kaddr, carry, o, r32, hh); }
            else if (diff == 0) { sb_subtile<true>(kbuf, vbuf, 0, qf, kaddr, carry, o, r32, hh); }
            if (kt > 0) { *(LAS u32x4*)(lds + (cur ^ 1) * 8192 + kwoff) = kr; *(LAS u32x4*)(lds + (cur ^ 1) * 8192 + vwoff) = vr; }
            if (lane == 0) flags[cur * 8 + wid] = __any(carry >= 1.17549435e-38f) ? 1u : 0u;
            __syncthreads();
            const u32x4 f0 = *(const LAS u32x4*)(flags + cur * 8), f1 = *(const LAS u32x4*)(flags + cur * 8 + 4);
            cur ^= 1;
            if (((f0.x | f0.y) | (f0.z | f0.w) | (f1.x | f1.y) | (f1.z | f1.w)) == 0u) break;
        }
        bf16_t* op = O + (rowbase + R0) * DM + h * 64 + r32;
#pragma unroll
        for (int r = 0; r < 16; ++r) { const int qq = crow(r, hh);
#pragma unroll
            for (int dh = 0; dh < 2; ++dh) op[(size_t)qq * DM + 32 * dh] = (bf16_t)(cvtpk(o[dh][r], 0.f) & 0xffffu); }
    }
}

template <int DL, bool FINAL> __device__ __forceinline__ void attnB_phase(LAS unsigned char* lds, const bf16_t* __restrict__ QKV, bf16_t* O, float* lse_out, const float* __restrict__ BT,
                                                                          const bf16_t* O1, const float* lse0, const float* lse1, int tid, int lane, int wid) {
    constexpr int NB = 16 / DL;
    const int r32 = lane & 31, hh = lane >> 5, half = wid >> 2, wq = wid & 3, ht = tid & 255;
    LAS unsigned char* kb = lds + half * 65536; LAS unsigned char* vb = kb + 32768;
    LAS float* bl = (LAS float*)(lds + 131072 + half * 768);
    LAS float* scr = (LAS float*)(lds + 131072 + 1536 + wid * 256);
    int kaddr[4];
#pragma unroll
    for (int dk = 0; dk < 4; ++dk) { const int c = 2 * dk + hh; kaddr[dk] = c * 4096 + ((r32 ^ c) << 4); }
    const int vlane = (4 * hh + ((lane & 15) >> 2)) * 64 + ((lane >> 4) & 1) * 32 + (lane & 3) * 8;
    const int key_in = ht >> 3, c8 = ht & 7;
    for (int p = blockIdx.x; p < BATCH * NH * 8; p += gridDim.x) {
        const int u = 2 * p + half, bh = u >> 4, cc = u & 15, b = bh >> 4, h = bh & 15, rr = cc / NB, n = cc % NB;
        __syncthreads();
#pragma unroll
        for (int batch = 0; batch < 2; ++batch) {
            if (batch == 0 && n == 0) continue;
            u32x4 kr[4], vr[4];
#pragma unroll
            for (int i = 0; i < 4; ++i) { const int m = 32 * (batch * 4 + i) + key_in; const int idx = (n - 1) * 128 + m;
                const bf16_t* kg = QKV + ((size_t)b * SEQ + (size_t)(idx * DL + rr)) * 3072 + 1024 + h * 64 + 8 * c8; kr[i] = *(const u32x4*)kg; vr[i] = *(const u32x4*)(kg + 1024); }
#pragma unroll
            for (int i = 0; i < 4; ++i) { const int m = 32 * (batch * 4 + i) + key_in;
                *(LAS u32x4*)(kb + c8 * 4096 + ((m ^ c8) << 4)) = kr[i]; *(LAS u32x4*)(vb + (c8 >> 2) * 16384 + m * 64 + (c8 & 3) * 16) = vr[i]; }
        }
        if (ht < 192) bl[ht] = BT[h * 192 + ht];
        bf16x8 qf[4];
        { const int i = 32 * wq + r32; const bf16_t* qp = QKV + ((size_t)b * SEQ + (size_t)((n * 128 + i) * DL + rr)) * 3072 + h * 64 + 8 * hh;
#pragma unroll
          for (int dk = 0; dk < 4; ++dk) qf[dk] = *(const bf16x8*)(qp + 16 * dk); }
        __syncthreads();
        const int jstart = (n == 0) ? (4 - wq) : 0;
        const LAS float* blp = bl + 160 + r32 - 4 * hh;
        f32x16 S[5];
        float mx = -INFINITY;
#pragma unroll
        for (int jj = 0; jj < 5; ++jj) {
            if (jj >= jstart) {
                f32x16 s = {};
#pragma unroll
                for (int dk = 0; dk < 4; ++dk) { const bf16x8 kf = *(const LAS bf16x8*)(kb + kaddr[dk] + (wq + jj) * 512); s = __builtin_amdgcn_mfma_f32_32x32x16_bf16(kf, qf[dk], s, 0, 0, 0); }
#pragma unroll
                for (int r = 0; r < 16; ++r) { const int kk = crow(r, hh); float v = s[r] + blp[-(32 * jj + (r & 3) + 8 * (r >> 2))];
                    if (jj == 0) v = (kk >= r32) ? v : -INFINITY;
                    if (jj == 4) v = (kk <= r32) ? v : -INFINITY;
                    s[r] = v; mx = fmaxf(mx, v); }
                S[jj] = s;
            } else {
#pragma unroll
                for (int r = 0; r < 16; ++r) S[jj][r] = -INFINITY;
            }
        }
        mx = fmaxf(mx, __shfl_xor(mx, 32));
        float l = 0.f; f32x16 o[2]; o[0] = f32x16{}; o[1] = f32x16{};
#pragma unroll
        for (int jj = 0; jj < 5; ++jj) {
            float pe[16];
#pragma unroll
            for (int r = 0; r < 16; ++r) { pe[r] = __builtin_amdgcn_exp2f(S[jj][r] - mx); l += pe[r]; }
            if (jj >= jstart) {
                const bf16x8 pf0 = pack8(pe), pf1 = pack8(pe + 8);
#pragma unroll
                for (int dh = 0; dh < 2; ++dh) {
                    const LAS unsigned char* vp = vb + dh * 16384 + (32 * (wq + jj)) * 64 + vlane;
                    const bf16x8 v0 = vfrag(vp), v1 = vfrag(vp + 16 * 64);
                    o[dh] = __builtin_amdgcn_mfma_f32_32x32x16_bf16(pf0, v0, o[dh], 0, 0, 0);
                    o[dh] = __builtin_amdgcn_mfma_f32_32x32x16_bf16(pf1, v1, o[dh], 0, 0, 0);
                }
            }
        }
        l += __shfl_xor(l, 32);
        const float lse2 = mx + __builtin_amdgcn_logf(l);
        if (hh == 0) { scr[r32] = __builtin_amdgcn_rcpf(l); scr[32 + r32] = lse2; }
        const size_t rowq0 = (size_t)b * SEQ + (size_t)((n * 128 + 32 * wq) * DL + rr);
        if (!FINAL) { if (hh == 0) lse_out[(rowq0 + (size_t)r32 * DL) * 16 + h] = lse2; }
        LDS_WAIT();
#pragma unroll
        for (int r = 0; r < 16; ++r) { const int qq = crow(r, hh); const size_t row = rowq0 + (size_t)qq * DL; const float linv = scr[qq];
            bf16_t* op = O + row * DM + h * 64 + r32;
            if (!FINAL) {
#pragma unroll
                for (int dh = 0; dh < 2; ++dh) op[32 * dh] = (bf16_t)(cvtpk(o[dh][r] * linv, 0.f) & 0xffffu);
            } else {
                const float l0 = lse0[row * 16 + h], l1 = lse1[row * 16 + h], l2 = scr[32 + qq];
                const float M = fmaxf(fmaxf(l0, l1), l2); const float e0 = __builtin_amdgcn_exp2f(l0 - M), e1 = __builtin_amdgcn_exp2f(l1 - M), e2 = __builtin_amdgcn_exp2f(l2 - M);
                const float inv = __builtin_amdgcn_rcpf(e0 + e1 + e2); const float w0 = e0 * inv, w1 = e1 * inv, w2 = e2 * inv * linv;
                const bf16_t* o1p = O1 + row * DM + h * 64 + r32;
#pragma unroll
                for (int dh = 0; dh < 2; ++dh) { const float a0 = __uint_as_float((unsigned)op[32 * dh] << 16), a1 = __uint_as_float((unsigned)o1p[32 * dh] << 16);
                    op[32 * dh] = (bf16_t)(cvtpk(w0 * a0 + w1 * a1 + w2 * o[dh][r], 0.f) & 0xffffu); }
            }
        }
    }
}

#define XB_TMO      128
#define XB_XCNT(j)  (256  + 64 * (j))
#define XB_XSUB(j)  (1280 + 64 * (j))
#define XB_XGEN(j)  (2304 + 64 * (j))
#define XB_TOP      3328
#define XB_TOPGEN   3392
#define XCD_BAR_WORDS 3456
#define XB_SPIN_CAP (1u << 18)

__device__ __forceinline__ unsigned xb_ld(unsigned* p)              { return __hip_atomic_load(p, __ATOMIC_RELAXED, __HIP_MEMORY_SCOPE_AGENT); }
__device__ __forceinline__ unsigned xb_add(unsigned* p, unsigned v) { return __hip_atomic_fetch_add(p, v, __ATOMIC_RELAXED, __HIP_MEMORY_SCOPE_AGENT); }
__device__ __forceinline__ unsigned xb_xcc_id() { return (unsigned)__builtin_amdgcn_s_getreg((3 << 11) | 20) & 0xFu; }
#define XB_SPIN(cond, bar) do { unsigned _sp = 0; while (cond) { __builtin_amdgcn_s_sleep(1); \
    if ((++_sp & 255u) == 0u) { if (xb_ld(&(bar)[XB_TMO])) break; if (_sp > XB_SPIN_CAP) { atomicAdd(&(bar)[XB_TMO], 1u); break; } } } } while (0)

struct XcdBarrier {
    unsigned* bar; unsigned x;
    volatile LAS unsigned* st;
};

__device__ __forceinline__ XcdBarrier xcd_barrier_post(unsigned* bar, volatile LAS unsigned* st) {
    XcdBarrier b; b.bar = bar; b.x = xb_xcc_id(); b.st = st;
    if (threadIdx.x == 0) (void)xb_add(&bar[XB_XCNT(b.x)], 1u);
    return b;
}
__device__ __forceinline__ void xcd_barrier_complete(unsigned* bar, unsigned x, unsigned& nloc, unsigned& nx) {
    const unsigned G = gridDim.x * gridDim.y * gridDim.z;
    unsigned sum, cnt, mine, sp = 0u;
    for (;;) {
        sum = 0u; cnt = 0u; mine = 0u;
#pragma unroll
        for (unsigned j = 0; j < 16; ++j) { const unsigned c = xb_ld(&bar[XB_XCNT(j)]); sum += c; cnt += (c > 0u) ? 1u : 0u; mine = (j == x) ? c : mine; }
        if (sum == G) break;
        __builtin_amdgcn_s_sleep(1);
        if ((++sp & 255u) == 0u) { if (xb_ld(&bar[XB_TMO])) break; if (sp > XB_SPIN_CAP) { atomicAdd(&bar[XB_TMO], 1u); break; } }
    }
    nloc = mine > 0u ? mine : 1u; nx = cnt > 0u ? cnt : 1u;
}

__device__ __forceinline__ void xcd_barrier(const XcdBarrier& b) {
    asm volatile("s_waitcnt vmcnt(0)" ::: "memory");
    __syncthreads();
    if (threadIdx.x == 0) {
        unsigned* bar = b.bar;
        __builtin_amdgcn_s_waitcnt(0);
        unsigned nloc = b.st[0], nx = b.st[1];
        if (nloc == 0u) { xcd_barrier_complete(bar, b.x, nloc, nx); b.st[0] = nloc; b.st[1] = nx; }
        const unsigned old = xb_add(&bar[XB_XSUB(b.x)], 1u);
        const unsigned gen = old / nloc;
        if (old + 1u == (gen + 1u) * nloc) {
            __builtin_amdgcn_fence(__ATOMIC_RELEASE, "agent");
            asm volatile("s_waitcnt vmcnt(0)" ::: "memory");
            const unsigned og = xb_add(&bar[XB_TOP], 1u);
            const unsigned tg = og / nx;
            if (og + 1u == (tg + 1u) * nx) xb_add(&bar[XB_TOPGEN], 1u);
            else XB_SPIN(xb_ld(&bar[XB_TOPGEN]) == tg, bar);
            __builtin_amdgcn_fence(__ATOMIC_ACQUIRE, "agent");
            xb_add(&bar[XB_XGEN(b.x)], 1u);
            asm volatile("s_waitcnt vmcnt(0)" ::: "memory");
        } else {
            XB_SPIN(xb_ld(&bar[XB_XGEN(b.x)]) == gen, bar);
            __builtin_amdgcn_fence(__ATOMIC_ACQUIRE, "agent");
            asm volatile("s_waitcnt vmcnt(0)" ::: "memory");
        }
    }
    __syncthreads();
}

constexpr int PROBE_BAR = 0;
constexpr int PROBE_DUP = -1;
enum { K_PRO = 0, K_GS, K_GW, K_NR, K_AA, K_AB0, K_AB1, K_AB2 };
__global__ void __launch_bounds__(512, 2) yoco_fwd(Params P) {
    extern __shared__ __attribute__((aligned(16))) unsigned char lds_raw[];
    LAS unsigned char* lds = (LAS unsigned char*)lds_raw;
    cg::grid_group grid = cg::this_grid();
    volatile LAS unsigned* xst = (volatile LAS unsigned*)(lds + LDS_BYTES - 16);
    if (threadIdx.x < 4) xst[threadIdx.x] = 0u;
    __syncthreads();
    XcdBarrier xb = xcd_barrier_post((unsigned*)P.ws, xst);
    grid.sync();
#define PH_BEGIN() int tid = threadIdx.x; asm volatile("" : "+v"(tid)); const int lane = tid & 63, wid = __builtin_amdgcn_readfirstlane(tid >> 6); \
        unsigned char* ws = P.ws; asm volatile("" : "+s"(ws)); (void)lane; (void)wid;
#define BARRIER() do { for (int k_ = 0; k_ < 1 + PROBE_BAR; ++k_) xcd_barrier(xb); } while (0)
#define REPS(ph) for (int rep_ = 0; rep_ < ((PROBE_DUP == (ph)) ? 2 : 1); ++rep_)
#define PH_GS(ph, AOFF, BOFF, N_, K_, OOFF) { PH_BEGIN(); REPS(ph) { pg8::Gemm g{(const bf16_t*)(ws + (AOFF)), (const bf16_t*)(ws + (BOFF)), MROWS, N_, K_}; pg8::StaticOrder S; S.init(MROWS, N_, (int)gridDim.x, (int)blockIdx.x); \
        pg8::EpiStore E{(bf16_t*)(ws + (OOFF)), N_}; pg8::gemm_phase<pg8::EpiStore, pg8::StaticOrder, true, true>(lds, g, S, E); } } BARRIER();
#define PH_GW(ph, BOFF) { PH_BEGIN(); REPS(ph) { pg8::Gemm g{(const bf16_t*)(ws + WS_XN), (const bf16_t*)(ws + (BOFF)), MROWS, 2 * DFF, DM}; pg8::StaticOrder S; S.init(MROWS, 2 * DFF, (int)gridDim.x, (int)blockIdx.x); \
        pg8::EpiSwiglu E{(bf16_t*)(ws + WS_ACT), DFF}; pg8::gemm_phase<pg8::EpiSwiglu, pg8::StaticOrder, true, true>(lds, g, S, E); } } BARRIER();
#define PH_NR(ph, GI, XIN, XNO) { PH_BEGIN(); REPS(ph) { norm_res_phase((const bf16_t*)(ws + WS_H), P.gains + (GI) * DM, XIN, P.out, XNO, lane, wid); } }
    { PH_BEGIN(); REPS(0) { prologue(P, lds, tid, lane, wid); } } BARRIER();
    PH_GS(1, WS_XN, WS_WQKVA, 3072, 1024, WS_QKV)
    { PH_BEGIN(); REPS(2) { attnA_phase(lds, (const bf16_t*)(ws + WS_QKV), (bf16_t*)(ws + WS_OB), tid, lane, wid); } } BARRIER();
    PH_GS(3, WS_OB, WS_WOA, 1024, 1024, WS_H)
    PH_NR(4, 1, P.x, (bf16_t*)(ws + WS_XN)) BARRIER();
    PH_GW(5, WS_WGU0)
    PH_GS(6, WS_ACT, WS_WD0, 1024, DFF, WS_H)
    PH_NR(7, 3, P.out, (bf16_t*)(ws + WS_XN)) BARRIER();
    PH_GS(8, WS_XN, WS_WB, 3072, 1024, WS_QKV)
    { PH_BEGIN(); REPS(9) { attnB_phase<1, false>(lds, (const bf16_t*)(ws + WS_QKV), (bf16_t*)(ws + WS_OB), (float*)(ws + WS_LSE0), (const float*)(ws + WS_BIAS), nullptr, nullptr, nullptr, tid, lane, wid); } } BARRIER();
    PH_GS(10, WS_XN, WS_WB + 6 * MiB, 3072, 1024, WS_QKV)
    { PH_BEGIN(); REPS(11) { attnB_phase<4, false>(lds, (const bf16_t*)(ws + WS_QKV), (bf16_t*)(ws + WS_H), (float*)(ws + WS_LSE1), (const float*)(ws + WS_BIAS) + 3072, nullptr, nullptr, nullptr, tid, lane, wid); } } BARRIER();
    PH_GS(12, WS_XN, WS_WB + 12 * MiB, 3072, 1024, WS_QKV)
    { PH_BEGIN(); attnB_phase<16, true>(lds, (const bf16_t*)(ws + WS_QKV), (bf16_t*)(ws + WS_OB), nullptr, (const float*)(ws + WS_BIAS) + 6144, (const bf16_t*)(ws + WS_H), (const float*)(ws + WS_LSE0), (const float*)(ws + WS_LSE1), tid, lane, wid); } BARRIER();
    PH_GS(14, WS_OB, WS_WOB, 1024, 1024, WS_H)
    PH_NR(15, 5, P.out, (bf16_t*)(ws + WS_XN)) BARRIER();
    PH_GW(16, WS_WGU1)
    PH_GS(17, WS_ACT, WS_WD1, 1024, DFF, WS_H)
    PH_NR(18, 7, P.out, (bf16_t*)nullptr)
}

extern "C" void kernel_launch(void* const* d_in, const int* in_sizes, int n_in, void* d_out, int out_size, void* d_ws, size_t ws_size, hipStream_t stream) {
    static int grid = 0;
    if (grid == 0) {
        if (n_in != 11 || out_size != MROWS * DM || ws_size < WS_END) { fprintf(stderr, "kernel_launch: unexpected shapes (n_in %d, out %d, ws %zu)\n", n_in, out_size, ws_size); grid = -1; return; }
        int dev = 0, cus = 0, per_cu = 0;
        (void)hipGetDevice(&dev); (void)hipDeviceGetAttribute(&cus, hipDeviceAttributeMultiprocessorCount, dev);
        if (hipFuncSetAttribute((const void*)yoco_fwd, hipFuncAttributeMaxDynamicSharedMemorySize, LDS_BYTES) != hipSuccess) { fprintf(stderr, "kernel_launch: hipFuncSetAttribute failed\n"); grid = -1; return; }
        if (hipOccupancyMaxActiveBlocksPerMultiprocessor(&per_cu, (const void*)yoco_fwd, 512, LDS_BYTES) != hipSuccess || per_cu < 1) { fprintf(stderr, "kernel_launch: occupancy query failed (%d)\n", per_cu); per_cu = 1; }
        (void)hipGetLastError();
        grid = cus * per_cu;
        if (grid <= 0) grid = 256;
    }
    if (grid < 0) return;
    if (hipMemsetAsync(d_ws, 0, 16384, stream) != hipSuccess) { fprintf(stderr, "kernel_launch: memset failed\n"); return; }
    Params p{};
    p.x = (const float*)d_in[0]; p.gains = (const float*)d_in[1]; p.w_qkv_a = (const float*)d_in[2]; p.w_o_a = (const float*)d_in[3]; p.g_kv = (const float*)d_in[4];
    p.w_kv_b = (const float*)d_in[5]; p.w_q_b = (const float*)d_in[6]; p.w_o_b = (const float*)d_in[7]; p.rel_bias = (const float*)d_in[8]; p.w_gu = (const float*)d_in[9]; p.w_down = (const float*)d_in[10];
    p.out = (float*)d_out; p.ws = (unsigned char*)d_ws;
    void* args[] = {&p};
    const hipError_t e = hipLaunchCooperativeKernel((const void*)yoco_fwd, dim3(grid), dim3(512), args, LDS_BYTES, stream);
    if (e != hipSuccess) fprintf(stderr, "kernel_launch: cooperative launch failed: %s (grid %d)\n", hipGetErrorString(e), grid);
}
```

```cpp
#include <hip/hip_runtime.h>
#include <hip/hip_cooperative_groups.h>
#include <cstdio>
#include <cstdint>
namespace cg = cooperative_groups;
namespace pg8 {
#define PG8_LAS __attribute__((address_space(3)))
typedef unsigned short bf16_t;
typedef short bf16x8 __attribute__((ext_vector_type(8)));
typedef float f32x4 __attribute__((ext_vector_type(4)));
typedef unsigned u32x4 __attribute__((ext_vector_type(4)));
constexpr int BM = 256, BK = 64, HALF = 128, HTB = HALF * BK * 2  , STAGE_BYTES = 8 * HTB, NXCD = 8, WGM = 8;

__host__ __device__ __forceinline__ int lds_byte(int r, int c) { const int st = (r >> 4) * 2 + (c >> 5), rr = r & 15, cc = c & 31, ob = rr * 64 + cc * 2; return st * 1024 + (ob ^ (((ob >> 9) & 1) << 5)); }
__host__ __device__ __forceinline__ void stage_rc(int b, int& R, int& C) { const int st = b / 1024, sb = b % 1024, swz = sb ^ (((sb >> 9) & 1) << 5); R = (st >> 1) * 16 + swz / 64; C = (st & 1) * 32 + (swz % 64) / 2; }
__host__ __device__ __forceinline__ int perm32(int rho) { const int n = rho >> 4, i = rho & 15; return 8 * (i >> 2) + 4 * n + (i & 3); }

struct Unit { int pm, pn; };
struct Gemm { const bf16_t* A; const bf16_t* Bt; int M, N, K; };

struct StaticOrder {
    int nM, nN, nwg, G, c;
    __host__ __device__ void init(int M, int N, int G_, int c_) { nM = M / BM; nN = N / BM; nwg = nM * nN; G = G_; c = c_; }
    __host__ __device__ bool next(int i, Unit& u) const {
        const long L = (long)i * G + c; if (L >= nwg) return false;
        int wgid = (int)L; { const int q = nwg / NXCD, r = nwg % NXCD, xcd = wgid % NXCD, off = wgid / NXCD; wgid = (xcd < r ? xcd * (q + 1) : r * (q + 1) + (xcd - r) * q) + off; }
        const int nig = WGM * nN, gid = wgid / nig, fm = gid * WGM, gsz = (nM - fm) < WGM ? (nM - fm) : WGM;
        u.pm = fm + ((wgid % nig) % gsz); u.pn = (wgid % nig) / gsz; return true;
    }
    __device__ __forceinline__ void a_ready(const Unit&) const {}
    __device__ __forceinline__ void done(const Unit&) const {}
};


typedef float f32x2_t __attribute__((ext_vector_type(2))); typedef __bf16 bf16x2_t __attribute__((ext_vector_type(2)));
__device__ __forceinline__ unsigned cvtpk(float lo, float hi) { f32x2_t v = {lo, hi}; bf16x2_t b = __builtin_convertvector(v, bf16x2_t); return __builtin_bit_cast(unsigned, b); }

struct EpiStore {
    static constexpr bool PERM = true, AFTER_DRAIN = false;
    bf16_t* O; int ldc;
    __device__ __forceinline__ void operator()(const f32x4 (&acc)[2][2][4][2], const Unit& u, int wr, int wc, int fr, int fq) const {
        const int row0 = u.pm * BM + wr * 64 + fr; const int col0 = u.pn * BM + wc * 32 + 8 * fq;
#pragma unroll
        for (int ai = 0; ai < 2; ++ai)
#pragma unroll
            for (int m = 0; m < 4; ++m) { bf16_t* rowp = O + (size_t)(row0 + ai * HALF + m * 16) * ldc + col0;
#pragma unroll
                for (int bj = 0; bj < 2; ++bj) { const f32x4 v0 = acc[ai][bj][m][0], v1 = acc[ai][bj][m][1];
                    u32x4 w; w.x = cvtpk(v0[0], v0[1]); w.y = cvtpk(v0[2], v0[3]); w.z = cvtpk(v1[0], v1[1]); w.w = cvtpk(v1[2], v1[3]);
                    *(u32x4*)(rowp + bj * HALF) = w; } }
    }
};
struct EpiSwiglu {
    static constexpr bool PERM = true, AFTER_DRAIN = false;
    bf16_t* O; int ldc;
    __device__ __forceinline__ float act(float g, float u) const { const float e = __builtin_amdgcn_exp2f(-1.4426950408889634f * g); return g * u * __builtin_amdgcn_rcpf(1.0f + e); }
    __device__ __forceinline__ void operator()(const f32x4 (&acc)[2][2][4][2], const Unit& u, int wr, int wc, int fr, int fq) const {
        const int row0 = u.pm * BM + wr * 64 + fr; const int col0 = u.pn * HALF + wc * 32 + 8 * fq;
#pragma unroll
        for (int ai = 0; ai < 2; ++ai)
#pragma unroll
            for (int m = 0; m < 4; ++m) { bf16_t* rowp = O + (size_t)(row0 + ai * HALF + m * 16) * ldc + col0;
                const f32x4 g0 = acc[ai][0][m][0], g1 = acc[ai][0][m][1], u0 = acc[ai][1][m][0], u1 = acc[ai][1][m][1];
                u32x4 w; w.x = cvtpk(act(g0[0], u0[0]), act(g0[1], u0[1])); w.y = cvtpk(act(g0[2], u0[2]), act(g0[3], u0[3]));
                w.z = cvtpk(act(g1[0], u1[0]), act(g1[1], u1[1])); w.w = cvtpk(act(g1[2], u1[2]), act(g1[3], u1[3]));
                *(u32x4*)rowp = w; }
    }
};

template <class Epi, class Sched, bool ALIGN_EPI = false, bool SP2 = false>
__device__ __forceinline__ void gemm_phase(PG8_LAS unsigned char* lds, const Gemm g, const Sched& S, const Epi& E) {
    const int tid = threadIdx.x, wid = __builtin_amdgcn_readfirstlane(tid >> 6), lane = tid & 63, wr = wid >> 2, wc = wid & 3, fr = lane & 15, fq = lane >> 4;
    const int K = g.K, nt = K / BK;
    unsigned voffA, voffB;
    { int R, C; stage_rc(tid * 16, R, C); const int Rb = Epi::PERM ? ((R & ~31) + perm32(R & 31)) : R;
        voffA = (unsigned)(R * K + C) * 2u; voffB = (unsigned)(Rb * K + C) * 2u; }
    const size_t rstep = (size_t)64 * K * 2;
    const size_t kstep = (size_t)(BK * 2);
    const size_t hstep = (size_t)HALF * K * 2;
    const size_t tstep = 2 * hstep;
    const unsigned ldsw = (unsigned)wid * 1024u;
    const int aoff = lds_byte(wr * 64 + fr, fq * 8), boff = lds_byte(wc * 32 + fr, fq * 8);
#define PG8_SA(b, h) (((b) * 2 + (h)) * HTB)
#define PG8_SB(b, h) ((4 + (b) * 2 + (h)) * HTB)
#define PG8_STAGE(bufoff, gbase, voff) do { _Pragma("unroll") for (int _i = 0; _i < 2; ++_i) \
        __builtin_amdgcn_global_load_lds((const unsigned*)((const char*)(gbase) + _i * rstep + (voff)), (PG8_LAS unsigned*)(lds + (bufoff) + ldsw + _i * 8192), 16, 0, 0); } while (0)
#define PG8_LDA(dst, b, h) do { _Pragma("unroll") for (int m = 0; m < 4; ++m) _Pragma("unroll") for (int k = 0; k < 2; ++k) dst[m][k] = *(const PG8_LAS bf16x8*)(lds + PG8_SA(b, h) + aoff + m * 2048 + k * 1024); } while (0)
#define PG8_LDB(dst, b, h) do { _Pragma("unroll") for (int n = 0; n < 2; ++n) _Pragma("unroll") for (int k = 0; k < 2; ++k) dst[n][k] = *(const PG8_LAS bf16x8*)(lds + PG8_SB(b, h) + boff + n * 2048 + k * 1024); } while (0)
#define PG8_MMA(ai, bj, At, Bt) do { __builtin_amdgcn_s_setprio(1); _Pragma("unroll") for (int m = 0; m < 4; ++m) _Pragma("unroll") for (int n = 0; n < 2; ++n) _Pragma("unroll") for (int k = 0; k < 2; ++k) \
        acc[ai][bj][m][n] = __builtin_amdgcn_mfma_f32_16x16x32_bf16(Bt[n][k], At[m][k], acc[ai][bj][m][n], 0, 0, 0); __builtin_amdgcn_s_setprio(0); } while (0)
#define PG8_WAIT_V(n) asm volatile("s_waitcnt vmcnt(" #n ")" ::: "memory")
#define PG8_WAIT_L(n) asm volatile("s_waitcnt lgkmcnt(" #n ")" ::: "memory")
#define PG8_BAR __builtin_amdgcn_s_barrier()
#define PG8_SCHED __builtin_amdgcn_sched_barrier(0)
    Unit cur, nxt; int ui = 0;
    if (!S.next(0, cur)) return;
    f32x4 acc[2][2][4][2];
#pragma unroll
    for (int a = 0; a < 2; ++a)
#pragma unroll
        for (int b = 0; b < 2; ++b)
#pragma unroll
            for (int m = 0; m < 4; ++m)
#pragma unroll
                for (int n = 0; n < 2; ++n) acc[a][b][m][n] = (f32x4){0.f, 0.f, 0.f, 0.f};
    bf16x8 At[4][2], B0[2][2], B1[2][2];
    const char* cA = (const char*)g.A + (size_t)cur.pm * tstep; const char* cB = (const char*)g.Bt + (size_t)cur.pn * tstep;
    S.a_ready(cur);
    if constexpr (SP2) {
        PG8_STAGE(PG8_SB(0, 0), cB, voffB); PG8_STAGE(PG8_SB(0, 1), cB + hstep, voffB); PG8_STAGE(PG8_SA(0, 0), cA, voffA); PG8_STAGE(PG8_SA(0, 1), cA + hstep, voffA);
        if (wr == 1) PG8_BAR;
        PG8_WAIT_V(2); PG8_BAR;
        PG8_STAGE(PG8_SB(1, 0), cB + kstep, voffB); PG8_STAGE(PG8_SA(1, 0), cA + kstep, voffA); PG8_STAGE(PG8_SB(1, 1), cB + hstep + kstep, voffB);
        PG8_WAIT_V(6); PG8_BAR;
    } else {
        PG8_STAGE(PG8_SB(0, 0), cB, voffB); PG8_STAGE(PG8_SA(0, 0), cA, voffA); PG8_STAGE(PG8_SB(0, 1), cB + hstep, voffB); PG8_STAGE(PG8_SA(0, 1), cA + hstep, voffA);
        if (wr == 1) PG8_BAR;
        PG8_WAIT_V(4); PG8_BAR;
        PG8_STAGE(PG8_SB(1, 0), cB + kstep, voffB); PG8_STAGE(PG8_SA(1, 0), cA + kstep, voffA); PG8_STAGE(PG8_SB(1, 1), cB + hstep + kstep, voffB);
        PG8_WAIT_V(6); PG8_BAR;
    }
    for (;;) {
        const bool has_next = S.next(ui + 1, nxt);
        const char* nA = has_next ? (const char*)g.A + (size_t)nxt.pm * tstep : cA; const char* nB = has_next ? (const char*)g.Bt + (size_t)nxt.pn * tstep : cB;
        for (int t = 0; t < nt; t += 2) {
            const bool last = (t == nt - 2);
            const char* a1 = cA + (size_t)(t + 1) * kstep;
            const char* a2 = last ? nA : cA + (size_t)(t + 2) * kstep; const char* b2 = last ? nB : cB + (size_t)(t + 2) * kstep;
            const char* a3 = a2 + kstep; const char* b3 = b2 + kstep;
            if (last && has_next) S.a_ready(nxt);
            if constexpr (SP2) {
            PG8_LDB(B0, 0, 0); PG8_LDB(B1, 0, 1); PG8_SCHED; PG8_LDA(At, 0, 0); PG8_STAGE(PG8_SA(1, 1), a1 + hstep, voffA);
            PG8_WAIT_V(8); PG8_WAIT_L(0); PG8_BAR; PG8_MMA(0, 0, At, B0); PG8_MMA(0, 1, At, B1); PG8_BAR; PG8_SCHED;
            PG8_LDA(At, 0, 1); PG8_STAGE(PG8_SB(0, 0), b2, voffB); PG8_STAGE(PG8_SB(0, 1), b2 + hstep, voffB); PG8_STAGE(PG8_SA(0, 0), a2, voffA);
            PG8_WAIT_V(8); PG8_WAIT_L(0); PG8_BAR; PG8_MMA(1, 0, At, B0); PG8_MMA(1, 1, At, B1); PG8_BAR; PG8_SCHED;
            PG8_LDB(B0, 1, 0); PG8_LDB(B1, 1, 1); PG8_SCHED; PG8_LDA(At, 1, 0); PG8_STAGE(PG8_SA(0, 1), a2 + hstep, voffA);
            PG8_WAIT_V(8); PG8_WAIT_L(0); PG8_BAR; PG8_MMA(0, 0, At, B0); PG8_MMA(0, 1, At, B1); PG8_BAR; PG8_SCHED;
            PG8_LDA(At, 1, 1); PG8_STAGE(PG8_SB(1, 0), b3, voffB); PG8_STAGE(PG8_SB(1, 1), b3 + hstep, voffB); PG8_STAGE(PG8_SA(1, 0), a3, voffA);
            PG8_WAIT_V(8); PG8_WAIT_L(0); PG8_BAR; PG8_MMA(1, 0, At, B0); PG8_MMA(1, 1, At, B1); PG8_BAR; PG8_SCHED;
            } else {
            PG8_LDB(B0, 0, 0); PG8_SCHED; PG8_LDA(At, 0, 0); PG8_STAGE(PG8_SA(1, 1), a1 + hstep, voffA);
            PG8_WAIT_L(8); PG8_BAR; PG8_WAIT_L(0); PG8_MMA(0, 0, At, B0); PG8_BAR; PG8_SCHED;
            PG8_LDB(B1, 0, 1); PG8_STAGE(PG8_SB(0, 0), b2, voffB);
            PG8_BAR; PG8_WAIT_L(0); PG8_MMA(0, 1, At, B1); PG8_BAR;
            PG8_LDA(At, 0, 1); PG8_STAGE(PG8_SA(0, 0), a2, voffA);
            PG8_BAR; PG8_WAIT_L(0); PG8_MMA(1, 0, At, B0); PG8_BAR; PG8_SCHED;
            PG8_STAGE(PG8_SB(0, 1), b2 + hstep, voffB);
            PG8_WAIT_V(6); PG8_BAR; PG8_MMA(1, 1, At, B1); PG8_BAR;
            PG8_LDB(B0, 1, 0); PG8_SCHED; PG8_LDA(At, 1, 0); PG8_STAGE(PG8_SA(0, 1), a2 + hstep, voffA);
            PG8_WAIT_L(8); PG8_BAR; PG8_WAIT_L(0); PG8_MMA(0, 0, At, B0); PG8_BAR; PG8_SCHED;
            PG8_LDB(B1, 1, 1); PG8_STAGE(PG8_SB(1, 0), b3, voffB);
            PG8_BAR; PG8_WAIT_L(0); PG8_MMA(0, 1, At, B1); PG8_BAR;
            PG8_LDA(At, 1, 1); PG8_STAGE(PG8_SA(1, 0), a3, voffA);
            PG8_BAR; PG8_WAIT_L(0); PG8_MMA(1, 0, At, B0); PG8_BAR; PG8_SCHED;
            PG8_STAGE(PG8_SB(1, 1), b3 + hstep, voffB);
            PG8_WAIT_V(6); PG8_BAR; PG8_MMA(1, 1, At, B1); PG8_BAR;
            }
        }
        if constexpr (ALIGN_EPI) { if (wr == 0) PG8_BAR; }
        if constexpr (!Epi::AFTER_DRAIN) { E(acc, cur, wr, wc, fr, fq); S.done(cur); }
        if (!has_next) break;
#pragma unroll
        for (int a = 0; a < 2; ++a)
#pragma unroll
            for (int b = 0; b < 2; ++b)
#pragma unroll
                for (int m = 0; m < 4; ++m)
#pragma unroll
                    for (int n = 0; n < 2; ++n) acc[a][b][m][n] = (f32x4){0.f, 0.f, 0.f, 0.f};
        cur = nxt; cA = nA; cB = nB; ++ui;
        if constexpr (ALIGN_EPI) { if (wr == 1) PG8_BAR; }
    }
    PG8_WAIT_V(0);
    if constexpr (!ALIGN_EPI) { if (wr == 0) PG8_BAR; }
    PG8_BAR;
    if constexpr (Epi::AFTER_DRAIN) { E.fused(acc, cur, wr, wc, fr, fq, lds, wid, lane); S.done(cur); }
#undef PG8_SA
#undef PG8_SB
#undef PG8_STAGE
#undef PG8_LDA
#undef PG8_LDB
#undef PG8_MMA
#undef PG8_WAIT_V
#undef PG8_WAIT_L
#undef PG8_BAR
#undef PG8_SCHED
}
}

#define LAS __attribute__((address_space(3)))
typedef pg8::bf16_t bf16_t; typedef pg8::bf16x8 bf16x8; typedef pg8::f32x4 f32x4; typedef pg8::u32x4 u32x4;
typedef float f32x16 __attribute__((ext_vector_type(16)));
typedef unsigned u32x2 __attribute__((ext_vector_type(2)));
typedef short v4i16_t __attribute__((ext_vector_type(4)));
using pg8::cvtpk;

constexpr int BATCH = 16, SEQ = 2048, DM = 1024, NH = 16, HD = 64, DFF = 2816, MROWS = BATCH * SEQ;
constexpr float RMS_EPS = 1e-6f;
constexpr float LOG2E = 1.4426950408889634f;
constexpr float QSCALE = 0.125f * LOG2E;
constexpr size_t MiB = 1u << 20;
constexpr size_t WS_WQKVA = 1 * MiB, WS_WOA = 7 * MiB, WS_WGU0 = 9 * MiB, WS_WD0 = 20 * MiB, WS_WB = 26 * MiB  , WS_WOB = 44 * MiB,
                 WS_WGU1 = 46 * MiB, WS_WD1 = 57 * MiB, WS_BIAS = 63 * MiB, WS_XN = 65 * MiB, WS_QKV = 129 * MiB, WS_ACT = 129 * MiB  ,
                 WS_OB = 321 * MiB, WS_H = 385 * MiB, WS_LSE0 = 449 * MiB, WS_LSE1 = 451 * MiB, WS_END = 453 * MiB;
constexpr int LDS_BYTES = 155648;

struct Params { const float *x, *gains, *w_qkv_a, *w_o_a, *g_kv, *w_kv_b, *w_q_b, *w_o_b, *rel_bias, *w_gu, *w_down; float* out; unsigned char* ws; };

#define LDS_WAIT() asm volatile("s_waitcnt lgkmcnt(0)" ::: "memory")
__device__ __forceinline__ float wave_sum(float v) {
#pragma unroll
    for (int o = 1; o < 64; o <<= 1) v += __shfl_xor(v, o);
    return v;
}
__device__ __forceinline__ int crow(int r, int hi) { return (r & 3) + 8 * (r >> 2) + 4 * hi; }
__device__ __forceinline__ float bf_lo(unsigned w) { return __uint_as_float(w << 16); }
__device__ __forceinline__ float bf_hi(unsigned w) { return __uint_as_float(w & 0xffff0000u); }

__device__ __forceinline__ void conv_item(const float* __restrict__ W, int ldw, int col, int K, const float* __restrict__ gain, float scale, bf16_t* WT, int drow, LAS float* scr, int kb, int lane) {
    const int k0 = 64 * kb;
#pragma unroll 8
    for (int i = 0; i < 32; ++i) { const int kk = 2 * i + (lane >> 5); const float v = W[(size_t)(k0 + kk) * ldw + col + (lane & 31)];
        const float gs = gain ? gain[k0 + kk] * scale : scale; scr[kk * 33 + (lane & 31)] = v * gs; }
    LDS_WAIT();
    const int c = lane & 7;
#pragma unroll
    for (int j = 0; j < 4; ++j) { const int n = (lane >> 3) + 8 * j; const LAS float* s = scr + (8 * c) * 33 + n;
        u32x4 o; o.x = cvtpk(s[0 * 33], s[1 * 33]); o.y = cvtpk(s[2 * 33], s[3 * 33]); o.z = cvtpk(s[4 * 33], s[5 * 33]); o.w = cvtpk(s[6 * 33], s[7 * 33]);
        *(u32x4*)(WT + (size_t)(drow + n) * K + k0 + 8 * c) = o; }
    LDS_WAIT();
}
template <int MODE> __device__ __forceinline__ void conv_seg(const float* src, int ld, int col0, int ncols, int K, const float* gain, float scale, bf16_t* dst, int drow0,
                                                             LAS float* scr, int gw, int NGW, int& off, int lane) {
    const int nblk = ncols >> 5, items = nblk * (K >> 6);
    int it0 = gw - (off % NGW); if (it0 < 0) it0 += NGW; off += items;
    for (int it = it0; it < items; it += NGW) {
        const int kb = it / nblk, nb = it - kb * nblk, c = 32 * nb; int drow;
        if (MODE == 1) { const int upf = c >= DFF ? 1 : 0, cc = c - upf * DFF; drow = 256 * (cc >> 7) + 128 * upf + (cc & 127); } else drow = drow0 + c;
        conv_item(src, ld, col0 + c, K, gain, scale, dst, drow, scr, kb, lane);
    }
}
__device__ __forceinline__ void norm_row_bf16(const float* xrow, bf16_t* orow, int lane) {
    const f32x4* xr = (const f32x4*)xrow + lane;
    f32x4 v[4]; float s = 0.f;
#pragma unroll
    for (int j = 0; j < 4; ++j) { v[j] = xr[64 * j]; s += (v[j].x * v[j].x + v[j].y * v[j].y) + (v[j].z * v[j].z + v[j].w * v[j].w); }
    const float r = 1.0f / sqrtf(wave_sum(s) * (1.f / DM) + RMS_EPS);
    u32x2* o8 = (u32x2*)orow + lane;
#pragma unroll
    for (int j = 0; j < 4; ++j) { u32x2 w; w.x = cvtpk(v[j].x * r, v[j].y * r); w.y = cvtpk(v[j].z * r, v[j].w * r); o8[64 * j] = w; }
}
__device__ __forceinline__ void prologue(const Params& P, LAS unsigned char* lds, int tid, int lane, int wave) {
    LAS float* scr = (LAS float*)(lds + wave * 16384);
    const int G = gridDim.x, gw = blockIdx.x * 8 + wave, NGW = G * 8;
    unsigned char* ws = P.ws; int off = 0;
    const float* g00 = P.gains + 0 * DM; const float* g02 = P.gains + 2 * DM; const float* g10 = P.gains + 4 * DM; const float* g12 = P.gains + 6 * DM;
    conv_seg<0>(P.w_qkv_a, 3072, 0, 1024, 1024, g00, QSCALE, (bf16_t*)(ws + WS_WQKVA), 0, scr, gw, NGW, off, lane);
    conv_seg<0>(P.w_qkv_a, 3072, 1024, 2048, 1024, g00, 1.0f, (bf16_t*)(ws + WS_WQKVA), 1024, scr, gw, NGW, off, lane);
    conv_seg<0>(P.w_o_a, 1024, 0, 1024, 1024, nullptr, 1.0f, (bf16_t*)(ws + WS_WOA), 0, scr, gw, NGW, off, lane);
    conv_seg<1>(P.w_gu, 2 * DFF, 0, 2 * DFF, 1024, g02, 1.0f, (bf16_t*)(ws + WS_WGU0), 0, scr, gw, NGW, off, lane);
    conv_seg<0>(P.w_down, 1024, 0, 1024, DFF, nullptr, 1.0f, (bf16_t*)(ws + WS_WD0), 0, scr, gw, NGW, off, lane);
    for (int g = 0; g < 3; ++g) {
        bf16_t* wb = (bf16_t*)(ws + WS_WB + (size_t)g * 6 * MiB);
        conv_seg<0>(P.w_q_b, 3072, 1024 * g, 1024, 1024, g10, QSCALE, wb, 0, scr, gw, NGW, off, lane);
        conv_seg<0>(P.w_kv_b, 6144, 2048 * g, 2048, 1024, P.g_kv, 1.0f, wb, 1024, scr, gw, NGW, off, lane);
    }
    conv_seg<0>(P.w_o_b, 1024, 0, 1024, 1024, nullptr, 1.0f, (bf16_t*)(ws + WS_WOB), 0, scr, gw, NGW, off, lane);
    conv_seg<1>(P.w_gu + (size_t)DM * 2 * DFF, 2 * DFF, 0, 2 * DFF, 1024, g12, 1.0f, (bf16_t*)(ws + WS_WGU1), 0, scr, gw, NGW, off, lane);
    conv_seg<0>(P.w_down + (size_t)DFF * DM, 1024, 0, 1024, DFF, nullptr, 1.0f, (bf16_t*)(ws + WS_WD1), 0, scr, gw, NGW, off, lane);
    bf16_t* XN = (bf16_t*)(ws + WS_XN);
    for (int m = gw; m < MROWS; m += NGW) norm_row_bf16(P.x + (size_t)m * DM, XN + (size_t)m * DM, lane);
    float* BT = (float*)(ws + WS_BIAS);
    for (int idx = blockIdx.x * 512 + tid; idx < 3 * 16 * 192; idx += G * 512) {
        const int g = idx / 3072, rem = idx - g * 3072, h = rem / 192, e = rem - h * 192, rel = e - 32; float v = 0.f;
        if (rel >= 0 && rel <= 128) { const int dl = (g == 0) ? 1 : ((g == 1) ? 4 : 16); const int n = rel * dl; int bk;
            if (n < 16) bk = n;
            else { bk = 16 + (n >= 22) + (n >= 30) + (n >= 40) + (n >= 54) + (n >= 73) + (n >= 99) + (n >= 134) + (n >= 182) + (n >= 246) + (n >= 332) + (n >= 450) + (n >= 609) + (n >= 825) + (n >= 1117) + (n >= 1513); }
            v = P.rel_bias[bk * 16 + h] * LOG2E; }
        BT[idx] = v;
    }
}

__device__ __forceinline__ void norm_res_phase(const bf16_t* H, const float* gain, const float* Xin, float* Xout, bf16_t* XN, int lane, int wave) {
    const int gw = blockIdx.x * 8 + wave, NGW = gridDim.x * 8;
    f32x4 gv[4];
#pragma unroll
    for (int j = 0; j < 4; ++j) gv[j] = *((const f32x4*)gain + lane + 64 * j);
    for (int m = gw; m < MROWS; m += NGW) {
        const u32x2* hp = (const u32x2*)(H + (size_t)m * DM) + lane;
        const f32x4* xp = (const f32x4*)(Xin + (size_t)m * DM) + lane;
        f32x4 hv[4], xv[4]; float ss = 0.f;
#pragma unroll
        for (int j = 0; j < 4; ++j) { const u32x2 w = hp[64 * j]; xv[j] = xp[64 * j]; hv[j] = (f32x4){bf_lo(w.x), bf_hi(w.x), bf_lo(w.y), bf_hi(w.y)};
            ss += (hv[j].x * hv[j].x + hv[j].y * hv[j].y) + (hv[j].z * hv[j].z + hv[j].w * hv[j].w); }
        const float r = 1.0f / sqrtf(wave_sum(ss) * (1.f / DM) + RMS_EPS);
        float s2 = 0.f; f32x4* op = (f32x4*)(Xout + (size_t)m * DM) + lane;
#pragma unroll
        for (int j = 0; j < 4; ++j) { xv[j] = xv[j] + hv[j] * r * gv[j]; op[64 * j] = xv[j];
            s2 += (xv[j].x * xv[j].x + xv[j].y * xv[j].y) + (xv[j].z * xv[j].z + xv[j].w * xv[j].w); }
        if (XN) { const float r2 = 1.0f / sqrtf(wave_sum(s2) * (1.f / DM) + RMS_EPS); u32x2* o8 = (u32x2*)(XN + (size_t)m * DM) + lane;
#pragma unroll
            for (int j = 0; j < 4; ++j) { u32x2 w; w.x = cvtpk(xv[j].x * r2, xv[j].y * r2); w.y = cvtpk(xv[j].z * r2, xv[j].w * r2); o8[64 * j] = w; } }
    }
}

__device__ __forceinline__ bf16x8 vfrag(const LAS unsigned char* p) {
    const v4i16_t lo = __builtin_amdgcn_ds_read_tr16_b64_v4i16((LAS v4i16_t*)p);
    const v4i16_t hi = __builtin_amdgcn_ds_read_tr16_b64_v4i16((LAS v4i16_t*)(p + 512));
    return (bf16x8){lo[0], lo[1], lo[2], lo[3], hi[0], hi[1], hi[2], hi[3]};
}
__device__ __forceinline__ bf16x8 pack8(const float* a) {
    u32x4 w; w.x = cvtpk(a[0], a[1]); w.y = cvtpk(a[2], a[3]); w.z = cvtpk(a[4], a[5]); w.w = cvtpk(a[6], a[7]); return __builtin_bit_cast(bf16x8, w);
}

template <bool MASK> __device__ __forceinline__ void sb_subtile(const LAS unsigned char* kbuf, const LAS unsigned char* vbuf  , int sub, const bf16x8 (&qf)[4], const int (&kaddr)[4],
                                                                float& carry, f32x16 (&o)[2], int r32, int hh) {
    f32x16 S = {};
#pragma unroll
    for (int dk = 0; dk < 4; ++dk) { const bf16x8 kf = *(const LAS bf16x8*)(kbuf + kaddr[dk] + sub * 512); S = __builtin_amdgcn_mfma_f32_32x32x16_bf16(kf, qf[dk], S, 0, 0, 0); }
    float p[16];
#pragma unroll
    for (int r = 0; r < 16; ++r) { const float u = __builtin_amdgcn_exp2f(S[r]); float wv = __builtin_amdgcn_rcpf(1.0f + u);
        if (MASK) wv = (crow(r, hh) < r32) ? wv : 1.0f; p[r] = wv; }
    float go[4], t[4];
#pragma unroll
    for (int i = 0; i < 4; ++i) { p[4 * i + 2] *= p[4 * i + 3]; p[4 * i + 1] *= p[4 * i + 2]; p[4 * i] *= p[4 * i + 1];
        const auto rr = __builtin_amdgcn_permlane32_swap(__float_as_uint(p[4 * i]), __float_as_uint(p[4 * i]), false, false);
        go[i] = __uint_as_float(rr[1]); t[i] = __uint_as_float(rr[0]) * __uint_as_float(rr[1]); }
    const float R2 = t[3], R1 = t[3] * t[2], R0 = R1 * t[1];
    float E[4];
    E[3] = carry * (hh ? 1.0f : go[3]); E[2] = carry * R2 * (hh ? 1.0f : go[2]); E[1] = carry * R1 * (hh ? 1.0f : go[1]); E[0] = carry * R0 * (hh ? 1.0f : go[0]);
    carry = carry * R0 * t[0];
    float A[16];
#pragma unroll
    for (int i = 0; i < 4; ++i) { const float I3 = E[i] * p[4 * i + 3], I2 = E[i] * p[4 * i + 2], I1 = E[i] * p[4 * i + 1], I0 = E[i] * p[4 * i];
        A[4 * i + 3] = E[i] - I3; A[4 * i + 2] = I3 - I2; A[4 * i + 1] = I2 - I1; A[4 * i] = I1 - I0; }
    const bf16x8 pf0 = pack8(A), pf1 = pack8(A + 8);
#pragma unroll
    for (int dh = 0; dh < 2; ++dh) {
        const bf16x8 v0 = vfrag(vbuf + dh * 4096 + (32 * sub) * 64), v1 = vfrag(vbuf + dh * 4096 + (32 * sub + 16) * 64);
        o[dh] = __builtin_amdgcn_mfma_f32_32x32x16_bf16(pf0, v0, o[dh], 0, 0, 0);
        o[dh] = __builtin_amdgcn_mfma_f32_32x32x16_bf16(pf1, v1, o[dh], 0, 0, 0);
    }
}

__device__ __forceinline__ void attnA_phase(LAS unsigned char* lds, const bf16_t* __restrict__ QKV, bf16_t* __restrict__ O, int tid, int lane, int wid) {
    const int r32 = lane & 31, hh = lane >> 5;
    int kaddr[4];
#pragma unroll
    for (int dk = 0; dk < 4; ++dk) { const int c = 2 * dk + hh; kaddr[dk] = c * 1024 + ((r32 ^ c) << 4); }
    const int vlane = (4 * hh + ((lane & 15) >> 2)) * 64 + ((lane >> 4) & 1) * 32 + (lane & 3) * 8;
    LAS unsigned* flags = (LAS unsigned*)(lds + 32768);
    const int lkey = tid >> 3, lc = tid & 7;
    const int kwoff = lc * 1024 + ((lkey ^ lc) << 4), vwoff = 16384 + (lc >> 2) * 4096 + lkey * 64 + (lc & 3) * 16;
    for (int u = blockIdx.x; u < BATCH * NH * 8; u += gridDim.x) {
        const int bh = u >> 3, qb = ((u & 7) + (u >> 8)) & 7, b = bh >> 4, h = bh & 15;
        const size_t rowbase = (size_t)b * SEQ; const int q0 = qb * 256, R0 = q0 + 32 * wid;
        bf16x8 qf[4];
        { const bf16_t* qp = QKV + (rowbase + R0 + r32) * 3072 + h * 64 + 8 * hh;
#pragma unroll
          for (int dk = 0; dk < 4; ++dk) qf[dk] = *(const bf16x8*)(qp + 16 * dk); }
        const bf16_t* kvg = QKV + (rowbase + lkey) * 3072 + 1024 + h * 64 + 8 * lc;
        const int NT = 4 * qb + 4;
        { const bf16_t* kg = kvg + (size_t)(64 * (NT - 1)) * 3072; const u32x4 kr = *(const u32x4*)kg, vr = *(const u32x4*)(kg + 1024);
          *(LAS u32x4*)(lds + kwoff) = kr; *(LAS u32x4*)(lds + vwoff) = vr; }
        __syncthreads();
        float carry = 1.0f; f32x16 o[2]; o[0] = f32x16{}; o[1] = f32x16{};
        int cur = 0;
        for (int kt = NT - 1; kt >= 0; --kt) {
            u32x4 kr, vr;
            if (kt > 0) { const bf16_t* kg = kvg + (size_t)(64 * (kt - 1)) * 3072; kr = *(const u32x4*)kg; vr = *(const u32x4*)(kg + 1024); }
            const int diff = R0 - 64 * kt;
            const LAS unsigned char* kbuf = lds + cur * 8192; const LAS unsigned char* vbuf = lds + 16384 + cur * 8192 + vlane;
            if (diff >= 64) { sb_subtile<false>(kbuf, vbuf, 1, qf, kaddr, carry, o, r32, hh); sb_subtile<false>(kbuf, vbuf, 0, qf, kaddr, carry, o, r32, hh); }
            else if (diff == 32) { sb_subtile<true>(kbuf, vbuf, 1, qf, kaddr, carry, o, r32, hh); sb_subtile<false>(kbuf, vbuf, 0, qf, kaddr, carry, o, r32, hh); }
            else if (diff == 0) { sb_subtile<true>(kbuf, vbuf, 0, qf, kaddr, carry, o, r32, hh); }
            if (kt > 0) { *(LAS u32x4*)(lds + (cur ^ 1) * 8192 + kwoff) = kr; *(LAS u32x4*)(lds + (cur ^ 1) * 8192 + vwoff) = vr; }
            if (lane == 0) flags[cur * 8 + wid] = __any(carry >= 1.17549435e-38f) ? 1u : 0u;
            __syncthreads();
            const u32x4 f0 = *(const LAS u32x4*)(flags + cur * 8), f1 = *(const LAS u32x4*)(flags + cur * 8 + 4);
            cur ^= 1;
            if (((f0.x | f0.y) | (f0.z | f0.w) | (f1.x | f1.y) | (f1.z | f1.w)) == 0u) break;
        }
        { LAS bf16_t* stg = (LAS bf16_t*)(lds + 36864 + wid * 4096);
#pragma unroll
          for (int r = 0; r < 16; ++r) { const int qq = crow(r, hh);
#pragma unroll
              for (int dh = 0; dh < 2; ++dh) stg[qq * 64 + 32 * dh + r32] = (bf16_t)(cvtpk(o[dh][r], 0.f) & 0xffffu); }
          LDS_WAIT();
          bf16_t* op = O + (rowbase + R0) * DM + h * 64;
#pragma unroll
          for (int i = 0; i < 4; ++i) { const int row = (lane >> 3) + 8 * i, ch = lane & 7; const u32x4 v = *(const LAS u32x4*)(stg + row * 64 + ch * 8); *(u32x4*)(op + (size_t)row * DM + ch * 8) = v; }
          LDS_WAIT(); }
    }
}

template <int DL, bool FINAL> __device__ __forceinline__ void attnB_phase(LAS unsigned char* lds, const bf16_t* __restrict__ QKV, bf16_t* O, float* lse_out, const float* __restrict__ BT,
                                                                          const bf16_t* O1, const float* lse0, const float* lse1, int tid, int lane, int wid) {
    constexpr int NB = 16 / DL;
    const int r32 = lane & 31, hh = lane >> 5, half = wid >> 2, wq = wid & 3, ht = tid & 255;
    LAS unsigned char* hb = lds + half * 65536;
    LAS float* bl = (LAS float*)(lds + 131072 + half * 768);
    LAS float* scr = (LAS float*)(lds + 131072 + 1536 + wid * 512);
    LAS bf16_t* stg = (LAS bf16_t*)(lds + 131072 + 1536 + 4096 + wid * 2048);
    int kaddr[4];
#pragma unroll
    for (int dk = 0; dk < 4; ++dk) { const int c = 2 * dk + hh; kaddr[dk] = c * 2048 + ((r32 ^ c) << 4); }
    const int vlane = 16384 + (4 * hh + ((lane & 15) >> 2)) * 64 + ((lane >> 4) & 1) * 32 + (lane & 3) * 8;
    const int key_in = ht >> 3, c8 = ht & 7;
    const int kwo = c8 * 2048 + ((key_in ^ c8) << 4), vwo = 16384 + (c8 >> 2) * 8192 + key_in * 64 + (c8 & 3) * 16;
#define BLK_ISSUE(nblk, rres) do { _Pragma("unroll") for (int i_ = 0; i_ < 4; ++i_) { const bf16_t* kg_ = kvbase + (size_t)(((nblk) * 128 + 32 * i_ + key_in) * DL + (rres)) * 3072; \
        kr[i_] = *(const u32x4*)kg_; vr[i_] = *(const u32x4*)(kg_ + 1024); } } while (0)
#define BLK_WRITE(slot) do { _Pragma("unroll") for (int i_ = 0; i_ < 4; ++i_) { *(LAS u32x4*)(hb + (slot) * 32768 + kwo + 512 * i_) = kr[i_]; *(LAS u32x4*)(hb + (slot) * 32768 + vwo + 2048 * i_) = vr[i_]; } } while (0)
    for (int hidx = blockIdx.x; hidx < BATCH * NH; hidx += gridDim.x) {
        const int ub = (2 * hidx + half) * 8, bh = ub >> 4, b = bh >> 4, h = bh & 15;
        const bf16_t* kvbase = QKV + (size_t)b * SEQ * 3072 + 1024 + h * 64 + 8 * c8;
        const bf16_t* qbase = QKV + (size_t)b * SEQ * 3072 + h * 64 + 8 * hh;
        u32x4 kr[4], vr[4]; bf16x8 qf[4];
        __syncthreads();
        { const int cc = ub & 15, rr = cc / NB, n = cc % NB;
          BLK_ISSUE(n, rr); BLK_WRITE(n & 1);
          if (n > 0) { BLK_ISSUE(n - 1, rr); BLK_WRITE((n - 1) & 1); }
          if (ht < 192) bl[ht] = BT[h * 192 + ht];
          const bf16_t* qp = qbase + (size_t)((n * 128 + 32 * wq + r32) * DL + rr) * 3072;
#pragma unroll
          for (int dk = 0; dk < 4; ++dk) qf[dk] = *(const bf16x8*)(qp + 16 * dk); }
        __syncthreads();
        for (int i = 0; i < 8; ++i) {
            const int cc = (ub + i) & 15, rr = cc / NB, n = cc % NB;
            bf16x8 qn[4]; int n2 = 0;
            if (i < 7) { const int cc2 = (ub + i + 1) & 15, rr2 = cc2 / NB; n2 = cc2 % NB; BLK_ISSUE(n2, rr2);
                const bf16_t* qp = qbase + (size_t)((n2 * 128 + 32 * wq + r32) * DL + rr2) * 3072;
#pragma unroll
                for (int dk = 0; dk < 4; ++dk) qn[dk] = *(const bf16x8*)(qp + 16 * dk); }
            const int jstart = (n == 0) ? (4 - wq) : 0;
            const int par = (n - 1) & 1;
            const LAS float* blp = bl + 160 + r32 - 4 * hh;
            float mx = -INFINITY, l = 0.f; f32x16 o[2]; o[0] = f32x16{}; o[1] = f32x16{};
#pragma unroll
            for (int jj = 0; jj < 5; ++jj) {
                if (jj >= jstart) {
                    const int j = wq + jj; const LAS unsigned char* kb = hb + (par ^ (j >> 2)) * 32768 + (j & 3) * 512;
                    f32x16 s = {};
#pragma unroll
                    for (int dk = 0; dk < 4; ++dk) { const bf16x8 kf = *(const LAS bf16x8*)(kb + kaddr[dk]); s = __builtin_amdgcn_mfma_f32_32x32x16_bf16(kf, qf[dk], s, 0, 0, 0); }
                    float rm = -INFINITY;
#pragma unroll
                    for (int r = 0; r < 16; ++r) { const int kk = crow(r, hh); float v = s[r] + blp[-(32 * jj + (r & 3) + 8 * (r >> 2))];
                        if (jj == 0) v = (kk >= r32) ? v : -INFINITY;
                        if (jj == 4) v = (kk <= r32) ? v : -INFINITY;
                        s[r] = v; rm = fmaxf(rm, v); }
                    rm = fmaxf(rm, __shfl_xor(rm, 32));
                    const bool up = rm > mx + 8.0f;
                    if (__any(up)) {
                        const float mnew = up ? rm : mx; const float f = __builtin_amdgcn_exp2f(mx - mnew); l *= f; mx = mnew;
                        if (hh == 0) scr[r32] = f;
                        LDS_WAIT();
#pragma unroll
                        for (int r = 0; r < 16; ++r) { const float fr = scr[crow(r, hh)]; o[0][r] *= fr; o[1][r] *= fr; }
                        LDS_WAIT();
                    }
                    float pe[16];
#pragma unroll
                    for (int r = 0; r < 16; ++r) { pe[r] = __builtin_amdgcn_exp2f(s[r] - mx); l += pe[r]; }
                    const bf16x8 pf0 = pack8(pe), pf1 = pack8(pe + 8);
                    const LAS unsigned char* vb = hb + (par ^ (j >> 2)) * 32768 + (j & 3) * 2048 + vlane;
#pragma unroll
                    for (int dh = 0; dh < 2; ++dh) {
                        const bf16x8 v0 = vfrag(vb + dh * 8192), v1 = vfrag(vb + dh * 8192 + 16 * 64);
                        o[dh] = __builtin_amdgcn_mfma_f32_32x32x16_bf16(pf0, v0, o[dh], 0, 0, 0);
                        o[dh] = __builtin_amdgcn_mfma_f32_32x32x16_bf16(pf1, v1, o[dh], 0, 0, 0);
                    }
                }
            }
            l += __shfl_xor(l, 32);
            const float lse2 = mx + __builtin_amdgcn_logf(l);
            const size_t rowq0 = (size_t)b * SEQ + (size_t)((n * 128 + 32 * wq) * DL + rr);
            if (hh == 0) { scr[r32] = __builtin_amdgcn_rcpf(l);
                if (!FINAL) lse_out[(rowq0 + (size_t)r32 * DL) * 16 + h] = lse2;
                else { const size_t rg = (rowq0 + (size_t)r32 * DL) * 16 + h; const float l0 = lse0[rg], l1 = lse1[rg];
                    const float M = fmaxf(fmaxf(l0, l1), lse2); const float e0 = __builtin_amdgcn_exp2f(l0 - M), e1 = __builtin_amdgcn_exp2f(l1 - M), e2 = __builtin_amdgcn_exp2f(lse2 - M);
                    const float inv = __builtin_amdgcn_rcpf(e0 + e1 + e2); scr[32 + r32] = e0 * inv; scr[64 + r32] = e1 * inv; scr[96 + r32] = e2 * inv; } }
            LDS_WAIT();
            float linv[16];
#pragma unroll
            for (int r = 0; r < 16; ++r) linv[r] = scr[crow(r, hh)];
#pragma unroll
            for (int dh = 0; dh < 2; ++dh) {
#pragma unroll
                for (int r = 0; r < 16; ++r) stg[crow(r, hh) * 32 + r32] = (bf16_t)(cvtpk(o[dh][r] * linv[r], 0.f) & 0xffffu);
                LDS_WAIT();
#pragma unroll
                for (int i = 0; i < 2; ++i) { const int row = (lane >> 2) + 16 * i, ch = lane & 3; u32x4 v = *(const LAS u32x4*)(stg + row * 32 + ch * 8);
                    bf16_t* op = O + (rowq0 + (size_t)row * DL) * DM + h * 64 + 32 * dh + ch * 8;
                    if (FINAL) { const u32x4 a0 = *(const u32x4*)op, a1 = *(const u32x4*)(O1 + (rowq0 + (size_t)row * DL) * DM + h * 64 + 32 * dh + ch * 8);
                        const float w0 = scr[32 + row], w1 = scr[64 + row], w2 = scr[96 + row];
#define CMB(c) cvtpk(w0 * bf_lo(a0.c) + w1 * bf_lo(a1.c) + w2 * bf_lo(v.c), w0 * bf_hi(a0.c) + w1 * bf_hi(a1.c) + w2 * bf_hi(v.c))
                        u32x4 w; w.x = CMB(x); w.y = CMB(y); w.z = CMB(z); w.w = CMB(w); v = w;
#undef CMB
                    }
                    *(u32x4*)op = v; }
                LDS_WAIT();
            }
            __syncthreads();
            if (i < 7) { BLK_WRITE(n2 & 1);
#pragma unroll
                for (int dk = 0; dk < 4; ++dk) qf[dk] = qn[dk]; }
            __syncthreads();
        }
    }
#undef BLK_ISSUE
#undef BLK_WRITE
}

#define XB_TMO      128
#define XB_XCNT(j)  (256  + 64 * (j))
#define XB_XSUB(j)  (1280 + 64 * (j))
#define XB_XGEN(j)  (2304 + 64 * (j))
#define XB_TOP      3328
#define XB_TOPGEN   3392
#define XCD_BAR_WORDS 3456
#define XB_SPIN_CAP (1u << 18)

__device__ __forceinline__ unsigned xb_ld(unsigned* p)              { return __hip_atomic_load(p, __ATOMIC_RELAXED, __HIP_MEMORY_SCOPE_AGENT); }
__device__ __forceinline__ unsigned xb_add(unsigned* p, unsigned v) { return __hip_atomic_fetch_add(p, v, __ATOMIC_RELAXED, __HIP_MEMORY_SCOPE_AGENT); }
__device__ __forceinline__ unsigned xb_xcc_id() { return (unsigned)__builtin_amdgcn_s_getreg((3 << 11) | 20) & 0xFu; }
#define XB_SPIN(cond, bar) do { unsigned _sp = 0; while (cond) { __builtin_amdgcn_s_sleep(1); \
    if ((++_sp & 255u) == 0u) { if (xb_ld(&(bar)[XB_TMO])) break; if (_sp > XB_SPIN_CAP) { atomicAdd(&(bar)[XB_TMO], 1u); break; } } } } while (0)

struct XcdBarrier {
    unsigned* bar; unsigned x;
    volatile LAS unsigned* st;
};

__device__ __forceinline__ XcdBarrier xcd_barrier_post(unsigned* bar, volatile LAS unsigned* st) {
    XcdBarrier b; b.bar = bar; b.x = xb_xcc_id(); b.st = st;
    if (threadIdx.x == 0) (void)xb_add(&bar[XB_XCNT(b.x)], 1u);
    return b;
}
__device__ __forceinline__ void xcd_barrier_complete(unsigned* bar, unsigned x, unsigned& nloc, unsigned& nx) {
    const unsigned G = gridDim.x * gridDim.y * gridDim.z;
    unsigned sum, cnt, mine, sp = 0u;
    for (;;) {
        sum = 0u; cnt = 0u; mine = 0u;
#pragma unroll
        for (unsigned j = 0; j < 16; ++j) { const unsigned c = xb_ld(&bar[XB_XCNT(j)]); sum += c; cnt += (c > 0u) ? 1u : 0u; mine = (j == x) ? c : mine; }
        if (sum == G) break;
        __builtin_amdgcn_s_sleep(1);
        if ((++sp & 255u) == 0u) { if (xb_ld(&bar[XB_TMO])) break; if (sp > XB_SPIN_CAP) { atomicAdd(&bar[XB_TMO], 1u); break; } }
    }
    nloc = mine > 0u ? mine : 1u; nx = cnt > 0u ? cnt : 1u;
}

__device__ __forceinline__ void xcd_barrier(const XcdBarrier& b) {
    asm volatile("s_waitcnt vmcnt(0)" ::: "memory");
    __syncthreads();
    if (threadIdx.x == 0) {
        unsigned* bar = b.bar; asm volatile("" : "+s"(bar)); unsigned bx = b.x; asm volatile("" : "+s"(bx));
        __builtin_amdgcn_s_waitcnt(0);
        unsigned nloc = b.st[0], nx = b.st[1];
        if (nloc == 0u) { xcd_barrier_complete(bar, bx, nloc, nx); b.st[0] = nloc; b.st[1] = nx; }
        const unsigned old = xb_add(&bar[XB_XSUB(bx)], 1u);
        const unsigned gen = old / nloc;
        if (old + 1u == (gen + 1u) * nloc) {
            __builtin_amdgcn_fence(__ATOMIC_RELEASE, "agent");
            asm volatile("s_waitcnt vmcnt(0)" ::: "memory");
            const unsigned og = xb_add(&bar[XB_TOP], 1u);
            const unsigned tg = og / nx;
            if (og + 1u == (tg + 1u) * nx) xb_add(&bar[XB_TOPGEN], 1u);
            else XB_SPIN(xb_ld(&bar[XB_TOPGEN]) == tg, bar);
            __builtin_amdgcn_fence(__ATOMIC_ACQUIRE, "agent");
            xb_add(&bar[XB_XGEN(bx)], 1u);
            asm volatile("s_waitcnt vmcnt(0)" ::: "memory");
        } else {
            XB_SPIN(xb_ld(&bar[XB_XGEN(bx)]) == gen, bar);
            __builtin_amdgcn_fence(__ATOMIC_ACQUIRE, "agent");
            asm volatile("s_waitcnt vmcnt(0)" ::: "memory");
        }
    }
    __syncthreads();
}

constexpr int PROBE_BAR = 0;
constexpr int PROBE_DUP = -1;
enum { K_PRO = 0, K_GS, K_GW, K_NR, K_AA, K_AB0, K_AB1, K_AB2 };
__global__ void __launch_bounds__(512, 2) yoco_fwd(Params P) {
    extern __shared__ __attribute__((aligned(16))) unsigned char lds_raw[];
    LAS unsigned char* lds = (LAS unsigned char*)lds_raw;
    cg::grid_group grid = cg::this_grid();
    volatile LAS unsigned* xst = (volatile LAS unsigned*)(lds + LDS_BYTES - 16);
    if (threadIdx.x < 4) xst[threadIdx.x] = 0u;
    __syncthreads();
    XcdBarrier xb = xcd_barrier_post((unsigned*)P.ws, xst);
    grid.sync();
#define PH_BEGIN() int tid = threadIdx.x; asm volatile("" : "+v"(tid)); const int lane = tid & 63, wid = __builtin_amdgcn_readfirstlane(tid >> 6); \
        unsigned char* ws = P.ws; asm volatile("" : "+s"(ws)); (void)lane; (void)wid;
#define BARRIER() do { for (int k_ = 0; k_ < 1 + PROBE_BAR; ++k_) xcd_barrier(xb); } while (0)
#define REPS(ph) for (int rep_ = 0; rep_ < ((PROBE_DUP == (ph)) ? 2 : 1); ++rep_)
#define PH_GS(ph, AOFF, BOFF, N_, K_, OOFF) { PH_BEGIN(); REPS(ph) { pg8::Gemm g{(const bf16_t*)(ws + (AOFF)), (const bf16_t*)(ws + (BOFF)), MROWS, N_, K_}; pg8::StaticOrder S; S.init(MROWS, N_, (int)gridDim.x, (int)blockIdx.x); \
        pg8::EpiStore E{(bf16_t*)(ws + (OOFF)), N_}; pg8::gemm_phase<pg8::EpiStore, pg8::StaticOrder, true, true>(lds, g, S, E); } } BARRIER();
#define PH_GW(ph, BOFF) { PH_BEGIN(); REPS(ph) { pg8::Gemm g{(const bf16_t*)(ws + WS_XN), (const bf16_t*)(ws + (BOFF)), MROWS, 2 * DFF, DM}; pg8::StaticOrder S; S.init(MROWS, 2 * DFF, (int)gridDim.x, (int)blockIdx.x); \
        pg8::EpiSwiglu E{(bf16_t*)(ws + WS_ACT), DFF}; pg8::gemm_phase<pg8::EpiSwiglu, pg8::StaticOrder, true, true>(lds, g, S, E); } } BARRIER();
#define PH_NR(ph, GI, XIN, XNO) { PH_BEGIN(); REPS(ph) { norm_res_phase((const bf16_t*)(ws + WS_H), P.gains + (GI) * DM, XIN, P.out, XNO, lane, wid); } }
    { PH_BEGIN(); REPS(0) { prologue(P, lds, tid, lane, wid); } } BARRIER();
    PH_GS(1, WS_XN, WS_WQKVA, 3072, 1024, WS_QKV)
    { PH_BEGIN(); REPS(2) { attnA_phase(lds, (const bf16_t*)(ws + WS_QKV), (bf16_t*)(ws + WS_OB), tid, lane, wid); } } BARRIER();
    PH_GS(3, WS_OB, WS_WOA, 1024, 1024, WS_H)
    PH_NR(4, 1, P.x, (bf16_t*)(ws + WS_XN)) BARRIER();
    PH_GW(5, WS_WGU0)
    PH_GS(6, WS_ACT, WS_WD0, 1024, DFF, WS_H)
    PH_NR(7, 3, P.out, (bf16_t*)(ws + WS_XN)) BARRIER();
    PH_GS(8, WS_XN, WS_WB, 3072, 1024, WS_QKV)
    { PH_BEGIN(); REPS(9) { attnB_phase<1, false>(lds, (const bf16_t*)(ws + WS_QKV), (bf16_t*)(ws + WS_OB), (float*)(ws + WS_LSE0), (const float*)(ws + WS_BIAS), nullptr, nullptr, nullptr, tid, lane, wid); } } BARRIER();
    PH_GS(10, WS_XN, WS_WB + 6 * MiB, 3072, 1024, WS_QKV)
    { PH_BEGIN(); REPS(11) { attnB_phase<4, false>(lds, (const bf16_t*)(ws + WS_QKV), (bf16_t*)(ws + WS_H), (float*)(ws + WS_LSE1), (const float*)(ws + WS_BIAS) + 3072, nullptr, nullptr, nullptr, tid, lane, wid); } } BARRIER();
    PH_GS(12, WS_XN, WS_WB + 12 * MiB, 3072, 1024, WS_QKV)
    { PH_BEGIN(); attnB_phase<16, true>(lds, (const bf16_t*)(ws + WS_QKV), (bf16_t*)(ws + WS_OB), nullptr, (const float*)(ws + WS_BIAS) + 6144, (const bf16_t*)(ws + WS_H), (const float*)(ws + WS_LSE0), (const float*)(ws + WS_LSE1), tid, lane, wid); } BARRIER();
    PH_GS(14, WS_OB, WS_WOB, 1024, 1024, WS_H)
    PH_NR(15, 5, P.out, (bf16_t*)(ws + WS_XN)) BARRIER();
    PH_GW(16, WS_WGU1)
    PH_GS(17, WS_ACT, WS_WD1, 1024, DFF, WS_H)
    PH_NR(18, 7, P.out, (bf16_t*)nullptr)
}

extern "C" void kernel_launch(void* const* d_in, const int* in_sizes, int n_in, void* d_out, int out_size, void* d_ws, size_t ws_size, hipStream_t stream) {
    static int grid = 0;
    if (grid == 0) {
        if (n_in != 11 || out_size != MROWS * DM || ws_size < WS_END) { fprintf(stderr, "kernel_launch: unexpected shapes (n_in %d, out %d, ws %zu)\n", n_in, out_size, ws_size); grid = -1; return; }
        int dev = 0, cus = 0, per_cu = 0;
        (void)hipGetDevice(&dev); (void)hipDeviceGetAttribute(&cus, hipDeviceAttributeMultiprocessorCount, dev);
        if (hipFuncSetAttribute((const void*)yoco_fwd, hipFuncAttributeMaxDynamicSharedMemorySize, LDS_BYTES) != hipSuccess) { fprintf(stderr, "kernel_launch: hipFuncSetAttribute failed\n"); grid = -1; return; }
        if (hipOccupancyMaxActiveBlocksPerMultiprocessor(&per_cu, (const void*)yoco_fwd, 512, LDS_BYTES) != hipSuccess || per_cu < 1) { fprintf(stderr, "kernel_launch: occupancy query failed (%d)\n", per_cu); per_cu = 1; }
        (void)hipGetLastError();
        grid = cus * per_cu;
        if (grid <= 0) grid = 256;
    }
    if (grid < 0) return;
    if (hipMemsetAsync(d_ws, 0, 16384, stream) != hipSuccess) { fprintf(stderr, "kernel_launch: memset failed\n"); return; }
    Params p{};
    p.x = (const float*)d_in[0]; p.gains = (const float*)d_in[1]; p.w_qkv_a = (const float*)d_in[2]; p.w_o_a = (const float*)d_in[3]; p.g_kv = (const float*)d_in[4];
    p.w_kv_b = (const float*)d_in[5]; p.w_q_b = (const float*)d_in[6]; p.w_o_b = (const float*)d_in[7]; p.rel_bias = (const float*)d_in[8]; p.w_gu = (const float*)d_in[9]; p.w_down = (const float*)d_in[10];
    p.out = (float*)d_out; p.ws = (unsigned char*)d_ws;
    void* args[] = {&p};
    const hipError_t e = hipLaunchCooperativeKernel((const void*)yoco_fwd, dim3(grid), dim3(512), args, LDS_BYTES, stream);
    if (e != hipSuccess) fprintf(stderr, "kernel_launch: cooperative launch failed: %s (grid %d)\n", hipGetErrorString(e), grid);
}
```

```cpp
#include <hip/hip_runtime.h>
#include <hip/hip_cooperative_groups.h>
#include <cstdio>
#include <cstdint>
namespace cg = cooperative_groups;
namespace pg8 {
#define PG8_LAS __attribute__((address_space(3)))
typedef unsigned short bf16_t;
typedef short bf16x8 __attribute__((ext_vector_type(8)));
typedef float f32x4 __attribute__((ext_vector_type(4)));
typedef unsigned u32x4 __attribute__((ext_vector_type(4)));
constexpr int BM = 256, BK = 64, HALF = 128, HTB = HALF * BK * 2  , STAGE_BYTES = 8 * HTB, NXCD = 8, WGM = 8;

__host__ __device__ __forceinline__ int lds_byte(int r, int c) { const int st = (r >> 4) * 2 + (c >> 5), rr = r & 15, cc = c & 31, ob = rr * 64 + cc * 2; return st * 1024 + (ob ^ (((ob >> 9) & 1) << 5)); }
__host__ __device__ __forceinline__ void stage_rc(int b, int& R, int& C) { const int st = b / 1024, sb = b % 1024, swz = sb ^ (((sb >> 9) & 1) << 5); R = (st >> 1) * 16 + swz / 64; C = (st & 1) * 32 + (swz % 64) / 2; }
__host__ __device__ __forceinline__ int perm32(int rho) { const int n = rho >> 4, i = rho & 15; return 8 * (i >> 2) + 4 * n + (i & 3); }

struct Unit { int pm, pn; };
struct Gemm { const bf16_t* A; const bf16_t* Bt; int M, N, K; };

struct StaticOrder {
    int nM, nN, nwg, G, c;
    __host__ __device__ void init(int M, int N, int G_, int c_) { nM = M / BM; nN = N / BM; nwg = nM * nN; G = G_; c = c_; }
    __host__ __device__ bool next(int i, Unit& u) const {
        const long L = (long)i * G + c; if (L >= nwg) return false;
        int wgid = (int)L; { const int q = nwg / NXCD, r = nwg % NXCD, xcd = wgid % NXCD, off = wgid / NXCD; wgid = (xcd < r ? xcd * (q + 1) : r * (q + 1) + (xcd - r) * q) + off; }
        const int nig = WGM * nN, gid = wgid / nig, fm = gid * WGM, gsz = (nM - fm) < WGM ? (nM - fm) : WGM;
        u.pm = fm + ((wgid % nig) % gsz); u.pn = (wgid % nig) / gsz; return true;
    }
    __device__ __forceinline__ void a_ready(const Unit&) const {}
    __device__ __forceinline__ void done(const Unit&) const {}
};


typedef float f32x2_t __attribute__((ext_vector_type(2))); typedef __bf16 bf16x2_t __attribute__((ext_vector_type(2)));
__device__ __forceinline__ unsigned cvtpk(float lo, float hi) { f32x2_t v = {lo, hi}; bf16x2_t b = __builtin_convertvector(v, bf16x2_t); return __builtin_bit_cast(unsigned, b); }

struct EpiStore {
    static constexpr bool PERM = true, AFTER_DRAIN = false, FUSED = false;
    bf16_t* O; int ldc; const float* rs;
    __device__ __forceinline__ void operator()(const f32x4 (&acc)[2][2][4][2], const Unit& u, int wr, int wc, int fr, int fq) const {
        const int row0 = u.pm * BM + wr * 64 + fr; const int col0 = u.pn * BM + wc * 32 + 8 * fq;
#pragma unroll
        for (int ai = 0; ai < 2; ++ai)
#pragma unroll
            for (int m = 0; m < 4; ++m) { bf16_t* rowp = O + (size_t)(row0 + ai * HALF + m * 16) * ldc + col0; const float sc = rs ? rs[row0 + ai * HALF + m * 16] : 1.0f;
#pragma unroll
                for (int bj = 0; bj < 2; ++bj) { const f32x4 v0 = acc[ai][bj][m][0] * sc, v1 = acc[ai][bj][m][1] * sc;
                    u32x4 w; w.x = cvtpk(v0[0], v0[1]); w.y = cvtpk(v0[2], v0[3]); w.z = cvtpk(v1[0], v1[1]); w.w = cvtpk(v1[2], v1[3]);
                    *(u32x4*)(rowp + bj * HALF) = w; } }
    }
};
struct EpiSwiglu {
    static constexpr bool PERM = true, AFTER_DRAIN = false, FUSED = false;
    bf16_t* O; int ldc; const float* rs;
    __device__ __forceinline__ float act(float g, float u) const { const float e = __builtin_amdgcn_exp2f(-1.4426950408889634f * g); return g * u * __builtin_amdgcn_rcpf(1.0f + e); }
    __device__ __forceinline__ void operator()(const f32x4 (&acc)[2][2][4][2], const Unit& u, int wr, int wc, int fr, int fq) const {
        const int row0 = u.pm * BM + wr * 64 + fr; const int col0 = u.pn * HALF + wc * 32 + 8 * fq;
#pragma unroll
        for (int ai = 0; ai < 2; ++ai)
#pragma unroll
            for (int m = 0; m < 4; ++m) { bf16_t* rowp = O + (size_t)(row0 + ai * HALF + m * 16) * ldc + col0; const float sc = rs[row0 + ai * HALF + m * 16];
                const f32x4 g0 = acc[ai][0][m][0] * sc, g1 = acc[ai][0][m][1] * sc, u0 = acc[ai][1][m][0] * sc, u1 = acc[ai][1][m][1] * sc;
                u32x4 w; w.x = cvtpk(act(g0[0], u0[0]), act(g0[1], u0[1])); w.y = cvtpk(act(g0[2], u0[2]), act(g0[3], u0[3]));
                w.z = cvtpk(act(g1[0], u1[0]), act(g1[1], u1[1])); w.w = cvtpk(act(g1[2], u1[2]), act(g1[3], u1[3]));
                *(u32x4*)rowp = w; }
    }
};


template <class Epi, class Sched, bool ALIGN_EPI = false, bool SP2 = false>
__device__ __forceinline__ void gemm_phase(PG8_LAS unsigned char* lds, const Gemm g, const Sched& S, const Epi& E) {
    const int tid = threadIdx.x, wid = __builtin_amdgcn_readfirstlane(tid >> 6), lane = tid & 63, wr = wid >> 2, wc = wid & 3, fr = lane & 15, fq = lane >> 4;
    const int K = g.K, nt = K / BK;
    unsigned voffA, voffB;
    { int R, C; stage_rc(tid * 16, R, C); const int Rb = Epi::PERM ? ((R & ~31) + perm32(R & 31)) : R;
        voffA = (unsigned)(R * K + C) * 2u; voffB = (unsigned)(Rb * K + C) * 2u; }
    const size_t rstep = (size_t)64 * K * 2;
    const size_t kstep = (size_t)(BK * 2);
    const size_t hstep = (size_t)HALF * K * 2;
    const size_t tstep = 2 * hstep;
    const unsigned ldsw = (unsigned)wid * 1024u;
    const int aoff = lds_byte(wr * 64 + fr, fq * 8), boff = lds_byte(wc * 32 + fr, fq * 8);
#define PG8_SA(b, h) (((b) * 2 + (h)) * HTB)
#define PG8_SB(b, h) ((4 + (b) * 2 + (h)) * HTB)
#define PG8_STAGE(bufoff, gbase, voff) do { _Pragma("unroll") for (int _i = 0; _i < 2; ++_i) \
        __builtin_amdgcn_global_load_lds((const unsigned*)((const char*)(gbase) + _i * rstep + (voff)), (PG8_LAS unsigned*)(lds + (bufoff) + ldsw + _i * 8192), 16, 0, 0); } while (0)
#define PG8_LDA(dst, b, h) do { _Pragma("unroll") for (int m = 0; m < 4; ++m) _Pragma("unroll") for (int k = 0; k < 2; ++k) dst[m][k] = *(const PG8_LAS bf16x8*)(lds + PG8_SA(b, h) + aoff + m * 2048 + k * 1024); } while (0)
#define PG8_LDB(dst, b, h) do { _Pragma("unroll") for (int n = 0; n < 2; ++n) _Pragma("unroll") for (int k = 0; k < 2; ++k) dst[n][k] = *(const PG8_LAS bf16x8*)(lds + PG8_SB(b, h) + boff + n * 2048 + k * 1024); } while (0)
#define PG8_MMA(ai, bj, At, Bt) do { __builtin_amdgcn_s_setprio(1); _Pragma("unroll") for (int m = 0; m < 4; ++m) _Pragma("unroll") for (int n = 0; n < 2; ++n) _Pragma("unroll") for (int k = 0; k < 2; ++k) \
        acc[ai][bj][m][n] = __builtin_amdgcn_mfma_f32_16x16x32_bf16(Bt[n][k], At[m][k], acc[ai][bj][m][n], 0, 0, 0); __builtin_amdgcn_s_setprio(0); } while (0)
#define PG8_WAIT_V(n) asm volatile("s_waitcnt vmcnt(" #n ")" ::: "memory")
#define PG8_WAIT_L(n) asm volatile("s_waitcnt lgkmcnt(" #n ")" ::: "memory")
#define PG8_BAR __builtin_amdgcn_s_barrier()
#define PG8_SCHED __builtin_amdgcn_sched_barrier(0)
    Unit cur, nxt; int ui = 0;
    if (!S.next(0, cur)) return;
    f32x4 acc[2][2][4][2];
#pragma unroll
    for (int a = 0; a < 2; ++a)
#pragma unroll
        for (int b = 0; b < 2; ++b)
#pragma unroll
            for (int m = 0; m < 4; ++m)
#pragma unroll
                for (int n = 0; n < 2; ++n) acc[a][b][m][n] = (f32x4){0.f, 0.f, 0.f, 0.f};
    bf16x8 At[4][2], B0[2][2], B1[2][2];
    const char* cA = (const char*)g.A + (size_t)cur.pm * tstep; const char* cB = (const char*)g.Bt + (size_t)cur.pn * tstep;
    S.a_ready(cur);
    if constexpr (SP2) {
        PG8_STAGE(PG8_SB(0, 0), cB, voffB); PG8_STAGE(PG8_SB(0, 1), cB + hstep, voffB); PG8_STAGE(PG8_SA(0, 0), cA, voffA); PG8_STAGE(PG8_SA(0, 1), cA + hstep, voffA);
        if (wr == 1) PG8_BAR;
        PG8_WAIT_V(2); PG8_BAR;
        PG8_STAGE(PG8_SB(1, 0), cB + kstep, voffB); PG8_STAGE(PG8_SA(1, 0), cA + kstep, voffA); PG8_STAGE(PG8_SB(1, 1), cB + hstep + kstep, voffB);
        PG8_WAIT_V(6); PG8_BAR;
    } else {
        PG8_STAGE(PG8_SB(0, 0), cB, voffB); PG8_STAGE(PG8_SA(0, 0), cA, voffA); PG8_STAGE(PG8_SB(0, 1), cB + hstep, voffB); PG8_STAGE(PG8_SA(0, 1), cA + hstep, voffA);
        if (wr == 1) PG8_BAR;
        PG8_WAIT_V(4); PG8_BAR;
        PG8_STAGE(PG8_SB(1, 0), cB + kstep, voffB); PG8_STAGE(PG8_SA(1, 0), cA + kstep, voffA); PG8_STAGE(PG8_SB(1, 1), cB + hstep + kstep, voffB);
        PG8_WAIT_V(6); PG8_BAR;
    }
    for (;;) {
        const bool has_next = S.next(ui + 1, nxt);
        const char* nA = has_next ? (const char*)g.A + (size_t)nxt.pm * tstep : cA; const char* nB = has_next ? (const char*)g.Bt + (size_t)nxt.pn * tstep : cB;
        for (int t = 0; t < nt; t += 2) {
            const bool last = (t == nt - 2);
            const char* a1 = cA + (size_t)(t + 1) * kstep;
            const char* a2 = last ? nA : cA + (size_t)(t + 2) * kstep; const char* b2 = last ? nB : cB + (size_t)(t + 2) * kstep;
            const char* a3 = a2 + kstep; const char* b3 = b2 + kstep;
            if (last && has_next) S.a_ready(nxt);
            if constexpr (SP2) {
            PG8_LDB(B0, 0, 0); PG8_LDB(B1, 0, 1); PG8_SCHED; PG8_LDA(At, 0, 0); PG8_STAGE(PG8_SA(1, 1), a1 + hstep, voffA);
            PG8_WAIT_V(8); PG8_WAIT_L(0); PG8_BAR; PG8_MMA(0, 0, At, B0); PG8_MMA(0, 1, At, B1); PG8_BAR; PG8_SCHED;
            PG8_LDA(At, 0, 1); PG8_STAGE(PG8_SB(0, 0), b2, voffB); PG8_STAGE(PG8_SB(0, 1), b2 + hstep, voffB); PG8_STAGE(PG8_SA(0, 0), a2, voffA);
            PG8_WAIT_V(8); PG8_WAIT_L(0); PG8_BAR; PG8_MMA(1, 0, At, B0); PG8_MMA(1, 1, At, B1); PG8_BAR; PG8_SCHED;
            PG8_LDB(B0, 1, 0); PG8_LDB(B1, 1, 1); PG8_SCHED; PG8_LDA(At, 1, 0); PG8_STAGE(PG8_SA(0, 1), a2 + hstep, voffA);
            PG8_WAIT_V(8); PG8_WAIT_L(0); PG8_BAR; PG8_MMA(0, 0, At, B0); PG8_MMA(0, 1, At, B1); PG8_BAR; PG8_SCHED;
            PG8_LDA(At, 1, 1); PG8_STAGE(PG8_SB(1, 0), b3, voffB); PG8_STAGE(PG8_SB(1, 1), b3 + hstep, voffB); PG8_STAGE(PG8_SA(1, 0), a3, voffA);
            PG8_WAIT_V(8); PG8_WAIT_L(0); PG8_BAR; PG8_MMA(1, 0, At, B0); PG8_MMA(1, 1, At, B1); PG8_BAR; PG8_SCHED;
            } else {
            PG8_LDB(B0, 0, 0); PG8_SCHED; PG8_LDA(At, 0, 0); PG8_STAGE(PG8_SA(1, 1), a1 + hstep, voffA);
            PG8_WAIT_L(8); PG8_BAR; PG8_WAIT_L(0); PG8_MMA(0, 0, At, B0); PG8_BAR; PG8_SCHED;
            PG8_LDB(B1, 0, 1); PG8_STAGE(PG8_SB(0, 0), b2, voffB);
            PG8_BAR; PG8_WAIT_L(0); PG8_MMA(0, 1, At, B1); PG8_BAR;
            PG8_LDA(At, 0, 1); PG8_STAGE(PG8_SA(0, 0), a2, voffA);
            PG8_BAR; PG8_WAIT_L(0); PG8_MMA(1, 0, At, B0); PG8_BAR; PG8_SCHED;
            PG8_STAGE(PG8_SB(0, 1), b2 + hstep, voffB);
            PG8_WAIT_V(6); PG8_BAR; PG8_MMA(1, 1, At, B1); PG8_BAR;
            PG8_LDB(B0, 1, 0); PG8_SCHED; PG8_LDA(At, 1, 0); PG8_STAGE(PG8_SA(0, 1), a2 + hstep, voffA);
            PG8_WAIT_L(8); PG8_BAR; PG8_WAIT_L(0); PG8_MMA(0, 0, At, B0); PG8_BAR; PG8_SCHED;
            PG8_LDB(B1, 1, 1); PG8_STAGE(PG8_SB(1, 0), b3, voffB);
            PG8_BAR; PG8_WAIT_L(0); PG8_MMA(0, 1, At, B1); PG8_BAR;
            PG8_LDA(At, 1, 1); PG8_STAGE(PG8_SA(1, 0), a3, voffA);
            PG8_BAR; PG8_WAIT_L(0); PG8_MMA(1, 0, At, B0); PG8_BAR; PG8_SCHED;
            PG8_STAGE(PG8_SB(1, 1), b3 + hstep, voffB);
            PG8_WAIT_V(6); PG8_BAR; PG8_MMA(1, 1, At, B1); PG8_BAR;
            }
        }
        if constexpr (ALIGN_EPI) { if (wr == 0) PG8_BAR; }
        if constexpr (Epi::FUSED) { E.fused(acc, cur, wr, wc, fr, fq, lds + STAGE_BYTES, wid, lane); } else
        if constexpr (!Epi::AFTER_DRAIN) { E(acc, cur, wr, wc, fr, fq); S.done(cur); }
        if (!has_next) break;
#pragma unroll
        for (int a = 0; a < 2; ++a)
#pragma unroll
            for (int b = 0; b < 2; ++b)
#pragma unroll
                for (int m = 0; m < 4; ++m)
#pragma unroll
                    for (int n = 0; n < 2; ++n) acc[a][b][m][n] = (f32x4){0.f, 0.f, 0.f, 0.f};
        cur = nxt; cA = nA; cB = nB; ++ui;
        if constexpr (ALIGN_EPI) { if (wr == 1) PG8_BAR; }
    }
    PG8_WAIT_V(0);
    if constexpr (!ALIGN_EPI) { if (wr == 0) PG8_BAR; }
    PG8_BAR;
    if constexpr (Epi::AFTER_DRAIN) { E.fused(acc, cur, wr, wc, fr, fq, lds, wid, lane); S.done(cur); }
#undef PG8_SA
#undef PG8_SB
#undef PG8_STAGE
#undef PG8_LDA
#undef PG8_LDB
#undef PG8_MMA
#undef PG8_WAIT_V
#undef PG8_WAIT_L
#undef PG8_BAR
#undef PG8_SCHED
}
}

#define LAS __attribute__((address_space(3)))
typedef pg8::bf16_t bf16_t; typedef pg8::bf16x8 bf16x8; typedef pg8::f32x4 f32x4; typedef pg8::u32x4 u32x4;
typedef float f32x16 __attribute__((ext_vector_type(16)));
typedef unsigned u32x2 __attribute__((ext_vector_type(2)));
typedef short v4i16_t __attribute__((ext_vector_type(4)));
using pg8::cvtpk;

constexpr int BATCH = 16, SEQ = 2048, DM = 1024, NH = 16, HD = 64, DFF = 2816, MROWS = BATCH * SEQ;
constexpr float RMS_EPS = 1e-6f;
constexpr float LOG2E = 1.4426950408889634f;
constexpr float QSCALE = 0.125f * LOG2E;
constexpr size_t MiB = 1u << 20;
constexpr size_t WS_CNT = 16384  , WS_SLOT = 63 * MiB + 65536  ;
constexpr size_t WS_WQKVA = 1 * MiB, WS_WOA = 7 * MiB, WS_WGU0 = 9 * MiB, WS_WD0 = 20 * MiB, WS_WB = 26 * MiB  , WS_WOB = 44 * MiB,
                 WS_WGU1 = 46 * MiB, WS_WD1 = 57 * MiB, WS_BIAS = 63 * MiB, WS_XN = 65 * MiB, WS_QKV = 129 * MiB, WS_ACT = 129 * MiB  ,
                 WS_OB = 321 * MiB, WS_H = 385 * MiB, WS_LSE0 = 449 * MiB, WS_LSE1 = 451 * MiB, WS_RS = 453 * MiB  , WS_END = 454 * MiB;
constexpr int LDS_BYTES = 155648;

struct Params { const float *x, *gains, *w_qkv_a, *w_o_a, *g_kv, *w_kv_b, *w_q_b, *w_o_b, *rel_bias, *w_gu, *w_down; float* out; unsigned char* ws; };

#define LDS_WAIT() asm volatile("s_waitcnt lgkmcnt(0)" ::: "memory")
__device__ __forceinline__ float wave_sum(float v) {
#pragma unroll
    for (int o = 1; o < 64; o <<= 1) v += __shfl_xor(v, o);
    return v;
}
__device__ __forceinline__ int crow(int r, int hi) { return (r & 3) + 8 * (r >> 2) + 4 * hi; }
__device__ __forceinline__ float bf_lo(unsigned w) { return __uint_as_float(w << 16); }
__device__ __forceinline__ float bf_hi(unsigned w) { return __uint_as_float(w & 0xffff0000u); }

__device__ __forceinline__ void conv_item(const float* __restrict__ W, int ldw, int col, int K, const float* __restrict__ gain, float scale, bf16_t* WT, int drow, LAS float* scr, int kb, int lane) {
    const int k0 = 64 * kb, ks = lane >> 3, n4 = lane & 7;
    f32x4 v[8]; float gs[8];
#pragma unroll
    for (int i = 0; i < 8; ++i) { const int kk = 8 * i + ks; v[i] = *(const f32x4*)(W + (size_t)(k0 + kk) * ldw + col + 4 * n4); gs[i] = gain ? gain[k0 + kk] * scale : scale; }
#pragma unroll
    for (int i = 0; i < 8; ++i) { const int kk = 8 * i + ks; LAS float* d = scr + kk * 33 + 4 * n4; d[0] = v[i].x * gs[i]; d[1] = v[i].y * gs[i]; d[2] = v[i].z * gs[i]; d[3] = v[i].w * gs[i]; }
    LDS_WAIT();
    const int c = lane & 7;
#pragma unroll
    for (int j = 0; j < 4; ++j) { const int n = (lane >> 3) + 8 * j; const LAS float* s = scr + (8 * c) * 33 + n;
        u32x4 o; o.x = cvtpk(s[0 * 33], s[1 * 33]); o.y = cvtpk(s[2 * 33], s[3 * 33]); o.z = cvtpk(s[4 * 33], s[5 * 33]); o.w = cvtpk(s[6 * 33], s[7 * 33]);
        *(u32x4*)(WT + (size_t)(drow + n) * K + k0 + 8 * c) = o; }
    LDS_WAIT();
}
template <int MODE> __device__ __forceinline__ void conv_seg(const float* src, int ld, int col0, int ncols, int K, const float* gain, float scale, bf16_t* dst, int drow0,
                                                             LAS float* scr, int gw, int NGW, int& off, int lane) {
    const int nblk = ncols >> 5, items = nblk * (K >> 6);
    int it0 = gw - (off % NGW); if (it0 < 0) it0 += NGW; off += items;
    for (int it = it0; it < items; it += NGW) {
        const int kb = it / nblk, nb = it - kb * nblk, c = 32 * nb; int drow;
        if (MODE == 1) { const int upf = c >= DFF ? 1 : 0, cc = c - upf * DFF; drow = 256 * (cc >> 7) + 128 * upf + (cc & 127); } else drow = drow0 + c;
        conv_item(src, ld, col0 + c, K, gain, scale, dst, drow, scr, kb, lane);
    }
}
__device__ __forceinline__ void norm_row_bf16(const float* xrow, bf16_t* orow, float* rs, int lane) {
    const f32x4* xr = (const f32x4*)xrow + lane;
    f32x4 v[4]; float s = 0.f;
#pragma unroll
    for (int j = 0; j < 4; ++j) { v[j] = xr[64 * j]; s += (v[j].x * v[j].x + v[j].y * v[j].y) + (v[j].z * v[j].z + v[j].w * v[j].w); }
    const float r = 1.0f / sqrtf(wave_sum(s) * (1.f / DM) + RMS_EPS);
    if (lane == 0) *rs = r;
    u32x2* o8 = (u32x2*)orow + lane;
#pragma unroll
    for (int j = 0; j < 4; ++j) { u32x2 w; w.x = cvtpk(v[j].x, v[j].y); w.y = cvtpk(v[j].z, v[j].w); o8[64 * j] = w; }
}
__device__ __forceinline__ void prologue(const Params& P, LAS unsigned char* lds, int tid, int lane, int wave) {
    LAS float* scr = (LAS float*)(lds + wave * 16384);
    const int G = gridDim.x, gw = blockIdx.x * 8 + wave, NGW = G * 8;
    unsigned char* ws = P.ws; int off = 0;
    const float* g00 = P.gains + 0 * DM; const float* g02 = P.gains + 2 * DM; const float* g10 = P.gains + 4 * DM; const float* g12 = P.gains + 6 * DM;
    conv_seg<0>(P.w_qkv_a, 3072, 0, 1024, 1024, g00, QSCALE, (bf16_t*)(ws + WS_WQKVA), 0, scr, gw, NGW, off, lane);
    conv_seg<0>(P.w_qkv_a, 3072, 1024, 2048, 1024, g00, 1.0f, (bf16_t*)(ws + WS_WQKVA), 1024, scr, gw, NGW, off, lane);
    conv_seg<0>(P.w_o_a, 1024, 0, 1024, 1024, nullptr, 1.0f, (bf16_t*)(ws + WS_WOA), 0, scr, gw, NGW, off, lane);
    conv_seg<1>(P.w_gu, 2 * DFF, 0, 2 * DFF, 1024, g02, 1.0f, (bf16_t*)(ws + WS_WGU0), 0, scr, gw, NGW, off, lane);
    conv_seg<0>(P.w_down, 1024, 0, 1024, DFF, nullptr, 1.0f, (bf16_t*)(ws + WS_WD0), 0, scr, gw, NGW, off, lane);
    for (int g = 0; g < 3; ++g) {
        bf16_t* wb = (bf16_t*)(ws + WS_WB + (size_t)g * 6 * MiB);
        conv_seg<0>(P.w_q_b, 3072, 1024 * g, 1024, 1024, g10, QSCALE, wb, 0, scr, gw, NGW, off, lane);
        conv_seg<0>(P.w_kv_b, 6144, 2048 * g, 2048, 1024, P.g_kv, 1.0f, wb, 1024, scr, gw, NGW, off, lane);
    }
    conv_seg<0>(P.w_o_b, 1024, 0, 1024, 1024, nullptr, 1.0f, (bf16_t*)(ws + WS_WOB), 0, scr, gw, NGW, off, lane);
    conv_seg<1>(P.w_gu + (size_t)DM * 2 * DFF, 2 * DFF, 0, 2 * DFF, 1024, g12, 1.0f, (bf16_t*)(ws + WS_WGU1), 0, scr, gw, NGW, off, lane);
    conv_seg<0>(P.w_down + (size_t)DFF * DM, 1024, 0, 1024, DFF, nullptr, 1.0f, (bf16_t*)(ws + WS_WD1), 0, scr, gw, NGW, off, lane);
    bf16_t* XN = (bf16_t*)(ws + WS_XN);
    for (int m = gw; m < MROWS; m += NGW) norm_row_bf16(P.x + (size_t)m * DM, XN + (size_t)m * DM, (float*)(ws + WS_RS) + m, lane);
    float* BT = (float*)(ws + WS_BIAS);
    for (int idx = blockIdx.x * 512 + tid; idx < 3 * 16 * 192; idx += G * 512) {
        const int g = idx / 3072, rem = idx - g * 3072, h = rem / 192, e = rem - h * 192, rel = e - 32; float v = 0.f;
        if (rel >= 0 && rel <= 128) { const int dl = (g == 0) ? 1 : ((g == 1) ? 4 : 16); const int n = rel * dl; int bk;
            if (n < 16) bk = n;
            else { bk = 16 + (n >= 22) + (n >= 30) + (n >= 40) + (n >= 54) + (n >= 73) + (n >= 99) + (n >= 134) + (n >= 182) + (n >= 246) + (n >= 332) + (n >= 450) + (n >= 609) + (n >= 825) + (n >= 1117) + (n >= 1513); }
            v = P.rel_bias[bk * 16 + h] * LOG2E; }
        BT[idx] = v;
    }
}

template <bool XIN32, bool OUT32> __device__ __forceinline__ void norm_res_phase(const bf16_t* H, const float* gain, const float* Xin32, bf16_t* XB, float* RS, float* Out32, int lane, int wave) {
    const int gw = blockIdx.x * 8 + wave, NGW = gridDim.x * 8;
    f32x4 gv[4];
#pragma unroll
    for (int j = 0; j < 4; ++j) gv[j] = *((const f32x4*)gain + lane + 64 * j);
    for (int m = gw; m < MROWS; m += NGW) {
        const u32x2* hp = (const u32x2*)(H + (size_t)m * DM) + lane;
        f32x4 hv[4], xv[4]; float ss = 0.f;
#pragma unroll
        for (int j = 0; j < 4; ++j) { const u32x2 w = hp[64 * j]; hv[j] = (f32x4){bf_lo(w.x), bf_hi(w.x), bf_lo(w.y), bf_hi(w.y)};
            if (XIN32) xv[j] = *((const f32x4*)(Xin32 + (size_t)m * DM) + lane + 64 * j);
            else { const u32x2 xw = *((const u32x2*)(XB + (size_t)m * DM) + lane + 64 * j); xv[j] = (f32x4){bf_lo(xw.x), bf_hi(xw.x), bf_lo(xw.y), bf_hi(xw.y)}; }
            ss += (hv[j].x * hv[j].x + hv[j].y * hv[j].y) + (hv[j].z * hv[j].z + hv[j].w * hv[j].w); }
        const float r = 1.0f / sqrtf(wave_sum(ss) * (1.f / DM) + RMS_EPS);
        float s2 = 0.f;
#pragma unroll
        for (int j = 0; j < 4; ++j) { xv[j] = xv[j] + hv[j] * r * gv[j];
            s2 += (xv[j].x * xv[j].x + xv[j].y * xv[j].y) + (xv[j].z * xv[j].z + xv[j].w * xv[j].w); }
        if (OUT32) { f32x4* op = (f32x4*)(Out32 + (size_t)m * DM) + lane;
#pragma unroll
            for (int j = 0; j < 4; ++j) op[64 * j] = xv[j]; }
        else { const float r2 = 1.0f / sqrtf(wave_sum(s2) * (1.f / DM) + RMS_EPS); if (lane == 0) RS[m] = r2; u32x2* o8 = (u32x2*)(XB + (size_t)m * DM) + lane;
#pragma unroll
            for (int j = 0; j < 4; ++j) { u32x2 w; w.x = cvtpk(xv[j].x, xv[j].y); w.y = cvtpk(xv[j].z, xv[j].w); o8[64 * j] = w; } }
    }
}

__device__ __forceinline__ bf16x8 vfrag(const LAS unsigned char* p) {
    const v4i16_t lo = __builtin_amdgcn_ds_read_tr16_b64_v4i16((LAS v4i16_t*)p);
    const v4i16_t hi = __builtin_amdgcn_ds_read_tr16_b64_v4i16((LAS v4i16_t*)(p + 512));
    return (bf16x8){lo[0], lo[1], lo[2], lo[3], hi[0], hi[1], hi[2], hi[3]};
}
__device__ __forceinline__ bf16x8 pack8(const float* a) {
    u32x4 w; w.x = cvtpk(a[0], a[1]); w.y = cvtpk(a[2], a[3]); w.z = cvtpk(a[4], a[5]); w.w = cvtpk(a[6], a[7]); return __builtin_bit_cast(bf16x8, w);
}

template <bool MASK> __device__ __forceinline__ void sb_subtile(const LAS unsigned char* kbuf, const LAS unsigned char* vbuf  , int sub, const bf16x8 (&qf)[4], const int (&kaddr)[4],
                                                                float& carry, f32x16 (&o)[2], int r32, int hh) {
    f32x16 S = {};
#pragma unroll
    for (int dk = 0; dk < 4; ++dk) { const bf16x8 kf = *(const LAS bf16x8*)(kbuf + kaddr[dk] + sub * 512); S = __builtin_amdgcn_mfma_f32_32x32x16_bf16(kf, qf[dk], S, 0, 0, 0); }
    float p[16];
#pragma unroll
    for (int r = 0; r < 16; ++r) { const float u = __builtin_amdgcn_exp2f(S[r]); float wv = __builtin_amdgcn_rcpf(1.0f + u);
        if (MASK) wv = (crow(r, hh) < r32) ? wv : 1.0f; p[r] = wv; }
    float go[4], t[4];
#pragma unroll
    for (int i = 0; i < 4; ++i) { p[4 * i + 2] *= p[4 * i + 3]; p[4 * i + 1] *= p[4 * i + 2]; p[4 * i] *= p[4 * i + 1];
        const auto rr = __builtin_amdgcn_permlane32_swap(__float_as_uint(p[4 * i]), __float_as_uint(p[4 * i]), false, false);
        go[i] = __uint_as_float(rr[1]); t[i] = __uint_as_float(rr[0]) * __uint_as_float(rr[1]); }
    const float R2 = t[3], R1 = t[3] * t[2], R0 = R1 * t[1];
    float E[4];
    E[3] = carry * (hh ? 1.0f : go[3]); E[2] = carry * R2 * (hh ? 1.0f : go[2]); E[1] = carry * R1 * (hh ? 1.0f : go[1]); E[0] = carry * R0 * (hh ? 1.0f : go[0]);
    carry = carry * R0 * t[0];
    float A[16];
#pragma unroll
    for (int i = 0; i < 4; ++i) { const float I3 = E[i] * p[4 * i + 3], I2 = E[i] * p[4 * i + 2], I1 = E[i] * p[4 * i + 1], I0 = E[i] * p[4 * i];
        A[4 * i + 3] = E[i] - I3; A[4 * i + 2] = I3 - I2; A[4 * i + 1] = I2 - I1; A[4 * i] = I1 - I0; }
    const bf16x8 pf0 = pack8(A), pf1 = pack8(A + 8);
#pragma unroll
    for (int dh = 0; dh < 2; ++dh) {
        const bf16x8 v0 = vfrag(vbuf + dh * 4096 + (32 * sub) * 64), v1 = vfrag(vbuf + dh * 4096 + (32 * sub + 16) * 64);
        o[dh] = __builtin_amdgcn_mfma_f32_32x32x16_bf16(pf0, v0, o[dh], 0, 0, 0);
        o[dh] = __builtin_amdgcn_mfma_f32_32x32x16_bf16(pf1, v1, o[dh], 0, 0, 0);
    }
}

__device__ __forceinline__ void attnA_phase(LAS unsigned char* lds, const bf16_t* __restrict__ QKV, bf16_t* __restrict__ O, int tid, int lane, int wid) {
    const int r32 = lane & 31, hh = lane >> 5;
    int kaddr[4];
#pragma unroll
    for (int dk = 0; dk < 4; ++dk) { const int c = 2 * dk + hh; kaddr[dk] = c * 1024 + ((r32 ^ c) << 4); }
    const int vlane = (4 * hh + ((lane & 15) >> 2)) * 64 + ((lane >> 4) & 1) * 32 + (lane & 3) * 8;
    LAS unsigned* flags = (LAS unsigned*)(lds + 32768);
    const int lkey = tid >> 3, lc = tid & 7;
    const int kwoff = lc * 1024 + ((lkey ^ lc) << 4), vwoff = 16384 + (lc >> 2) * 4096 + lkey * 64 + (lc & 3) * 16;
    for (int u = blockIdx.x; u < BATCH * NH * 8; u += gridDim.x) {
        const int bh = u >> 3, qb = ((u & 7) + (u >> 8)) & 7, b = bh >> 4, h = bh & 15;
        const size_t rowbase = (size_t)b * SEQ; const int q0 = qb * 256, R0 = q0 + 32 * wid;
        bf16x8 qf[4];
        { const bf16_t* qp = QKV + (rowbase + R0 + r32) * 3072 + h * 64 + 8 * hh;
#pragma unroll
          for (int dk = 0; dk < 4; ++dk) qf[dk] = *(const bf16x8*)(qp + 16 * dk); }
        const bf16_t* kvg = QKV + (rowbase + lkey) * 3072 + 1024 + h * 64 + 8 * lc;
        const int NT = 4 * qb + 4;
        { const bf16_t* kg = kvg + (size_t)(64 * (NT - 1)) * 3072; const u32x4 kr = *(const u32x4*)kg, vr = *(const u32x4*)(kg + 1024);
          *(LAS u32x4*)(lds + kwoff) = kr; *(LAS u32x4*)(lds + vwoff) = vr; }
        __syncthreads();
        float carry = 1.0f; f32x16 o[2]; o[0] = f32x16{}; o[1] = f32x16{};
        int cur = 0;
        for (int kt = NT - 1; kt >= 0; --kt) {
            u32x4 kr, vr;
            if (kt > 0) { const bf16_t* kg = kvg + (size_t)(64 * (kt - 1)) * 3072; kr = *(const u32x4*)kg; vr = *(const u32x4*)(kg + 1024); }
            const int diff = R0 - 64 * kt;
            const LAS unsigned char* kbuf = lds + cur * 8192; const LAS unsigned char* vbuf = lds + 16384 + cur * 8192 + vlane;
            if (diff >= 64) { sb_subtile<false>(kbuf, vbuf, 1, qf, kaddr, carry, o, r32, hh); sb_subtile<false>(kbuf, vbuf, 0, qf, kaddr, carry, o, r32, hh); }
            else if (diff == 32) { sb_subtile<true>(kbuf, vbuf, 1, qf, kaddr, carry, o, r32, hh); sb_subtile<false>(kbuf, vbuf, 0, qf, kaddr, carry, o, r32, hh); }
            else if (diff == 0) { sb_subtile<true>(kbuf, vbuf, 0, qf, kaddr, carry, o, r32, hh); }
            if (kt > 0) { *(LAS u32x4*)(lds + (cur ^ 1) * 8192 + kwoff) = kr; *(LAS u32x4*)(lds + (cur ^ 1) * 8192 + vwoff) = vr; }
            if (lane == 0) flags[cur * 8 + wid] = __any(carry >= 1.17549435e-38f) ? 1u : 0u;
            __syncthreads();
            const u32x4 f0 = *(const LAS u32x4*)(flags + cur * 8), f1 = *(const LAS u32x4*)(flags + cur * 8 + 4);
            cur ^= 1;
            if (((f0.x | f0.y) | (f0.z | f0.w) | (f1.x | f1.y) | (f1.z | f1.w)) == 0u) break;
        }
        { LAS bf16_t* stg = (LAS bf16_t*)(lds + 36864 + wid * 4096);
#pragma unroll
          for (int r = 0; r < 16; ++r) { const int qq = crow(r, hh);
#pragma unroll
              for (int dh = 0; dh < 2; ++dh) stg[qq * 64 + 32 * dh + r32] = (bf16_t)(cvtpk(o[dh][r], 0.f) & 0xffffu); }
          LDS_WAIT();
          bf16_t* op = O + (rowbase + R0) * DM + h * 64;
#pragma unroll
          for (int i = 0; i < 4; ++i) { const int row = (lane >> 3) + 8 * i, ch = lane & 7; const u32x4 v = *(const LAS u32x4*)(stg + row * 64 + ch * 8); *(u32x4*)(op + (size_t)row * DM + ch * 8) = v; }
          LDS_WAIT(); }
    }
}

template <int DL, bool FINAL> __device__ __forceinline__ void attnB_phase(LAS unsigned char* lds, const bf16_t* __restrict__ QKV, bf16_t* O, float* lse_out, const float* __restrict__ BT,
                                                                          const bf16_t* O1, const float* lse0, const float* lse1, int tid, int lane, int wid) {
    constexpr int NB = 16 / DL;
    const int r32 = lane & 31, hh = lane >> 5, half = wid >> 2, wq = wid & 3, ht = tid & 255;
    LAS unsigned char* hb = lds + half * 65536;
    LAS float* bl = (LAS float*)(lds + 131072 + half * 768);
    LAS float* scr = (LAS float*)(lds + 131072 + 1536 + wid * 512);
    LAS bf16_t* stg = (LAS bf16_t*)(lds + 131072 + 1536 + 4096 + wid * 2048);
    int kaddr[4];
#pragma unroll
    for (int dk = 0; dk < 4; ++dk) { const int c = 2 * dk + hh; kaddr[dk] = c * 2048 + ((r32 ^ c) << 4); }
    const int vlane = 16384 + (4 * hh + ((lane & 15) >> 2)) * 64 + ((lane >> 4) & 1) * 32 + (lane & 3) * 8;
    const int key_in = ht >> 3, c8 = ht & 7;
    const int kwo = c8 * 2048 + ((key_in ^ c8) << 4), vwo = 16384 + (c8 >> 2) * 8192 + key_in * 64 + (c8 & 3) * 16;
#define BLK_ISSUE(nblk, rres) do { _Pragma("unroll") for (int i_ = 0; i_ < 4; ++i_) { const bf16_t* kg_ = kvbase + (size_t)(((nblk) * 128 + 32 * i_ + key_in) * DL + (rres)) * 3072; \
        kr[i_] = *(const u32x4*)kg_; vr[i_] = *(const u32x4*)(kg_ + 1024); } } while (0)
#define BLK_WRITE(slot) do { _Pragma("unroll") for (int i_ = 0; i_ < 4; ++i_) { *(LAS u32x4*)(hb + (slot) * 32768 + kwo + 512 * i_) = kr[i_]; *(LAS u32x4*)(hb + (slot) * 32768 + vwo + 2048 * i_) = vr[i_]; } } while (0)
    for (int hidx = blockIdx.x; hidx < BATCH * NH; hidx += gridDim.x) {
        const int ub = (2 * hidx + half) * 8, bh = ub >> 4, b = bh >> 4, h = bh & 15;
        const bf16_t* kvbase = QKV + (size_t)b * SEQ * 3072 + 1024 + h * 64 + 8 * c8;
        const bf16_t* qbase = QKV + (size_t)b * SEQ * 3072 + h * 64 + 8 * hh;
        u32x4 kr[4], vr[4]; bf16x8 qf[4];
        __syncthreads();
        { const int cc = ub & 15, rr = cc / NB, n = cc % NB;
          BLK_ISSUE(n, rr); BLK_WRITE(n & 1);
          if (n > 0) { BLK_ISSUE(n - 1, rr); BLK_WRITE((n - 1) & 1); }
          if (ht < 192) bl[ht] = BT[h * 192 + ht];
          const bf16_t* qp = qbase + (size_t)((n * 128 + 32 * wq + r32) * DL + rr) * 3072;
#pragma unroll
          for (int dk = 0; dk < 4; ++dk) qf[dk] = *(const bf16x8*)(qp + 16 * dk); }
        __syncthreads();
        for (int i = 0; i < 8; ++i) {
            const int cc = (ub + i) & 15, rr = cc / NB, n = cc % NB;
            bf16x8 qn[4]; int n2 = 0;
            if (i < 7) { const int cc2 = (ub + i + 1) & 15, rr2 = cc2 / NB; n2 = cc2 % NB; BLK_ISSUE(n2, rr2);
                const bf16_t* qp = qbase + (size_t)((n2 * 128 + 32 * wq + r32) * DL + rr2) * 3072;
#pragma unroll
                for (int dk = 0; dk < 4; ++dk) qn[dk] = *(const bf16x8*)(qp + 16 * dk); }
            const int jstart = (n == 0) ? (4 - wq) : 0;
            const int par = (n - 1) & 1;
            const LAS float* blp = bl + 160 + r32 - 4 * hh;
            float mx = -INFINITY, l = 0.f; f32x16 o[2]; o[0] = f32x16{}; o[1] = f32x16{};
#pragma unroll
            for (int jj = 0; jj < 5; ++jj) {
                if (jj >= jstart) {
                    const int j = wq + jj; const LAS unsigned char* kb = hb + (par ^ (j >> 2)) * 32768 + (j & 3) * 512;
                    f32x16 s = {};
#pragma unroll
                    for (int dk = 0; dk < 4; ++dk) { const bf16x8 kf = *(const LAS bf16x8*)(kb + kaddr[dk]); s = __builtin_amdgcn_mfma_f32_32x32x16_bf16(kf, qf[dk], s, 0, 0, 0); }
                    float rm = -INFINITY;
#pragma unroll
                    for (int r = 0; r < 16; ++r) { const int kk = crow(r, hh); float v = s[r] + blp[-(32 * jj + (r & 3) + 8 * (r >> 2))];
                        if (jj == 0) v = (kk >= r32) ? v : -INFINITY;
                        if (jj == 4) v = (kk <= r32) ? v : -INFINITY;
                        s[r] = v; rm = fmaxf(rm, v); }
                    rm = fmaxf(rm, __shfl_xor(rm, 32));
                    const bool up = rm > mx + 8.0f;
                    if (__any(up)) {
                        const float mnew = up ? rm : mx; const float f = __builtin_amdgcn_exp2f(mx - mnew); l *= f; mx = mnew;
                        if (hh == 0) scr[r32] = f;
                        LDS_WAIT();
#pragma unroll
                        for (int r = 0; r < 16; ++r) { const float fr = scr[crow(r, hh)]; o[0][r] *= fr; o[1][r] *= fr; }
                        LDS_WAIT();
                    }
                    float pe[16];
#pragma unroll
                    for (int r = 0; r < 16; ++r) { pe[r] = __builtin_amdgcn_exp2f(s[r] - mx); l += pe[r]; }
                    const bf16x8 pf0 = pack8(pe), pf1 = pack8(pe + 8);
                    const LAS unsigned char* vb = hb + (par ^ (j >> 2)) * 32768 + (j & 3) * 2048 + vlane;
#pragma unroll
                    for (int dh = 0; dh < 2; ++dh) {
                        const bf16x8 v0 = vfrag(vb + dh * 8192), v1 = vfrag(vb + dh * 8192 + 16 * 64);
                        o[dh] = __builtin_amdgcn_mfma_f32_32x32x16_bf16(pf0, v0, o[dh], 0, 0, 0);
                        o[dh] = __builtin_amdgcn_mfma_f32_32x32x16_bf16(pf1, v1, o[dh], 0, 0, 0);
                    }
                }
            }
            l += __shfl_xor(l, 32);
            const float lse2 = mx + __builtin_amdgcn_logf(l);
            const size_t rowq0 = (size_t)b * SEQ + (size_t)((n * 128 + 32 * wq) * DL + rr);
            if (hh == 0) { scr[r32] = __builtin_amdgcn_rcpf(l);
                if (!FINAL) lse_out[(rowq0 + (size_t)r32 * DL) * 16 + h] = lse2;
                else { const size_t rg = (rowq0 + (size_t)r32 * DL) * 16 + h; const float l0 = lse0[rg], l1 = lse1[rg];
                    const float M = fmaxf(fmaxf(l0, l1), lse2); const float e0 = __builtin_amdgcn_exp2f(l0 - M), e1 = __builtin_amdgcn_exp2f(l1 - M), e2 = __builtin_amdgcn_exp2f(lse2 - M);
                    const float inv = __builtin_amdgcn_rcpf(e0 + e1 + e2); scr[32 + r32] = e0 * inv; scr[64 + r32] = e1 * inv; scr[96 + r32] = e2 * inv; } }
            LDS_WAIT();
            float linv[16];
#pragma unroll
            for (int r = 0; r < 16; ++r) linv[r] = scr[crow(r, hh)];
#pragma unroll
            for (int dh = 0; dh < 2; ++dh) {
#pragma unroll
                for (int r = 0; r < 16; ++r) stg[crow(r, hh) * 32 + r32] = (bf16_t)(cvtpk(o[dh][r] * linv[r], 0.f) & 0xffffu);
                LDS_WAIT();
#pragma unroll
                for (int i = 0; i < 2; ++i) { const int row = (lane >> 2) + 16 * i, ch = lane & 3; u32x4 v = *(const LAS u32x4*)(stg + row * 32 + ch * 8);
                    bf16_t* op = O + (rowq0 + (size_t)row * DL) * DM + h * 64 + 32 * dh + ch * 8;
                    if (FINAL) { const u32x4 a0 = *(const u32x4*)op, a1 = *(const u32x4*)(O1 + (rowq0 + (size_t)row * DL) * DM + h * 64 + 32 * dh + ch * 8);
                        const float w0 = scr[32 + row], w1 = scr[64 + row], w2 = scr[96 + row];
#define CMB(c) cvtpk(w0 * bf_lo(a0.c) + w1 * bf_lo(a1.c) + w2 * bf_lo(v.c), w0 * bf_hi(a0.c) + w1 * bf_hi(a1.c) + w2 * bf_hi(v.c))
                        u32x4 w; w.x = CMB(x); w.y = CMB(y); w.z = CMB(z); w.w = CMB(w); v = w;
#undef CMB
                    }
                    *(u32x4*)op = v; }
                LDS_WAIT();
            }
            __syncthreads();
            if (i < 7) { BLK_WRITE(n2 & 1);
#pragma unroll
                for (int dk = 0; dk < 4; ++dk) qf[dk] = qn[dk]; }
            __syncthreads();
        }
    }
#undef BLK_ISSUE
#undef BLK_WRITE
}

#define XB_TMO      128
#define XB_XCNT(j)  (256  + 64 * (j))
#define XB_XSUB(j)  (1280 + 64 * (j))
#define XB_XGEN(j)  (2304 + 64 * (j))
#define XB_TOP      3328
#define XB_TOPGEN   3392
#define XCD_BAR_WORDS 3456
#define XB_SPIN_CAP (1u << 18)

__device__ __forceinline__ unsigned xb_ld(unsigned* p)              { return __hip_atomic_load(p, __ATOMIC_RELAXED, __HIP_MEMORY_SCOPE_AGENT); }
__device__ __forceinline__ unsigned xb_add(unsigned* p, unsigned v) { return __hip_atomic_fetch_add(p, v, __ATOMIC_RELAXED, __HIP_MEMORY_SCOPE_AGENT); }
__device__ __forceinline__ unsigned xb_xcc_id() { return (unsigned)__builtin_amdgcn_s_getreg((3 << 11) | 20) & 0xFu; }
#define XB_SPIN(cond, bar) do { unsigned _sp = 0; while (cond) { __builtin_amdgcn_s_sleep(1); \
    if ((++_sp & 255u) == 0u) { if (xb_ld(&(bar)[XB_TMO])) break; if (_sp > XB_SPIN_CAP) { atomicAdd(&(bar)[XB_TMO], 1u); break; } } } } while (0)

struct XcdBarrier {
    unsigned* bar; unsigned x;
    volatile LAS unsigned* st;
};

__device__ __forceinline__ XcdBarrier xcd_barrier_post(unsigned* bar, volatile LAS unsigned* st) {
    XcdBarrier b; b.bar = bar; b.x = xb_xcc_id(); b.st = st;
    if (threadIdx.x == 0) (void)xb_add(&bar[XB_XCNT(b.x)], 1u);
    return b;
}
__device__ __forceinline__ void xcd_barrier_complete(unsigned* bar, unsigned x, unsigned& nloc, unsigned& nx) {
    const unsigned G = gridDim.x * gridDim.y * gridDim.z;
    unsigned sum, cnt, mine, sp = 0u;
    for (;;) {
        sum = 0u; cnt = 0u; mine = 0u;
#pragma unroll
        for (unsigned j = 0; j < 16; ++j) { const unsigned c = xb_ld(&bar[XB_XCNT(j)]); sum += c; cnt += (c > 0u) ? 1u : 0u; mine = (j == x) ? c : mine; }
        if (sum == G) break;
        __builtin_amdgcn_s_sleep(1);
        if ((++sp & 255u) == 0u) { if (xb_ld(&bar[XB_TMO])) break; if (sp > XB_SPIN_CAP) { atomicAdd(&bar[XB_TMO], 1u); break; } }
    }
    nloc = mine > 0u ? mine : 1u; nx = cnt > 0u ? cnt : 1u;
}

__device__ __forceinline__ void xcd_barrier(const XcdBarrier& b) {
    asm volatile("s_waitcnt vmcnt(0)" ::: "memory");
    __syncthreads();
    if (threadIdx.x == 0) {
        unsigned* bar = b.bar; asm volatile("" : "+s"(bar)); unsigned bx = b.x; asm volatile("" : "+s"(bx));
        __builtin_amdgcn_s_waitcnt(0);
        unsigned nloc = b.st[0], nx = b.st[1];
        if (nloc == 0u) { xcd_barrier_complete(bar, bx, nloc, nx); b.st[0] = nloc; b.st[1] = nx; }
        const unsigned old = xb_add(&bar[XB_XSUB(bx)], 1u);
        const unsigned gen = old / nloc;
        if (old + 1u == (gen + 1u) * nloc) {
            __builtin_amdgcn_fence(__ATOMIC_RELEASE, "agent");
            asm volatile("s_waitcnt vmcnt(0)" ::: "memory");
            const unsigned og = xb_add(&bar[XB_TOP], 1u);
            const unsigned tg = og / nx;
            if (og + 1u == (tg + 1u) * nx) xb_add(&bar[XB_TOPGEN], 1u);
            else XB_SPIN(xb_ld(&bar[XB_TOPGEN]) == tg, bar);
            __builtin_amdgcn_fence(__ATOMIC_ACQUIRE, "agent");
            xb_add(&bar[XB_XGEN(bx)], 1u);
            asm volatile("s_waitcnt vmcnt(0)" ::: "memory");
        } else {
            XB_SPIN(xb_ld(&bar[XB_XGEN(bx)]) == gen, bar);
            __builtin_amdgcn_fence(__ATOMIC_ACQUIRE, "agent");
            asm volatile("s_waitcnt vmcnt(0)" ::: "memory");
        }
    }
    __syncthreads();
}

constexpr int PROBE_BAR = 0;
constexpr int PROBE_DUP = -1;
enum { K_PRO = 0, K_GS, K_GW, K_NR, K_AA, K_AB0, K_AB1, K_AB2 };
__global__ void __launch_bounds__(512, 2) yoco_fwd(Params P) {
    extern __shared__ __attribute__((aligned(16))) unsigned char lds_raw[];
    LAS unsigned char* lds = (LAS unsigned char*)lds_raw;
    cg::grid_group grid = cg::this_grid();
    volatile LAS unsigned* xst = (volatile LAS unsigned*)(lds + LDS_BYTES - 16);
    if (threadIdx.x < 4) xst[threadIdx.x] = 0u;
    __syncthreads();
    XcdBarrier xb = xcd_barrier_post((unsigned*)P.ws, xst);
    grid.sync();
#define PH_BEGIN() int tid = threadIdx.x; asm volatile("" : "+v"(tid)); const int lane = tid & 63, wid = __builtin_amdgcn_readfirstlane(tid >> 6); \
        unsigned char* ws = P.ws; asm volatile("" : "+s"(ws)); (void)lane; (void)wid;
#define BARRIER() do { for (int k_ = 0; k_ < 1 + PROBE_BAR; ++k_) xcd_barrier(xb); } while (0)
#define REPS(ph) for (int rep_ = 0; rep_ < ((PROBE_DUP == (ph)) ? 2 : 1); ++rep_)
#define PH_GS(ph, AOFF, BOFF, N_, K_, OOFF, RSP) { PH_BEGIN(); REPS(ph) { pg8::Gemm g{(const bf16_t*)(ws + (AOFF)), (const bf16_t*)(ws + (BOFF)), MROWS, N_, K_}; pg8::StaticOrder S; S.init(MROWS, N_, (int)gridDim.x, (int)blockIdx.x); \
        pg8::EpiStore E{(bf16_t*)(ws + (OOFF)), N_, RSP}; pg8::gemm_phase<pg8::EpiStore, pg8::StaticOrder, true, true>(lds, g, S, E); } } BARRIER();
#define PH_GW(ph, BOFF) { PH_BEGIN(); REPS(ph) { pg8::Gemm g{(const bf16_t*)(ws + WS_XN), (const bf16_t*)(ws + (BOFF)), MROWS, 2 * DFF, DM}; pg8::StaticOrder S; S.init(MROWS, 2 * DFF, (int)gridDim.x, (int)blockIdx.x); \
        pg8::EpiSwiglu E{(bf16_t*)(ws + WS_ACT), DFF, (const float*)(ws + WS_RS)}; pg8::gemm_phase<pg8::EpiSwiglu, pg8::StaticOrder, true, true>(lds, g, S, E); } } BARRIER();
#define PH_NR(XIN32, OUT32, GI) { PH_BEGIN(); norm_res_phase<XIN32, OUT32>((const bf16_t*)(ws + WS_H), P.gains + (GI) * DM, P.x, (bf16_t*)(ws + WS_XN), (float*)(ws + WS_RS), P.out, lane, wid); }
#define RSV ((const float*)(ws + WS_RS))
#define RS0 ((const float*)nullptr)
    { PH_BEGIN(); REPS(0) { prologue(P, lds, tid, lane, wid); } } BARRIER();
    PH_GS(1, WS_XN, WS_WQKVA, 3072, 1024, WS_QKV, RSV)
    { PH_BEGIN(); REPS(2) { attnA_phase(lds, (const bf16_t*)(ws + WS_QKV), (bf16_t*)(ws + WS_OB), tid, lane, wid); } } BARRIER();
    PH_GS(3, WS_OB, WS_WOA, 1024, 1024, WS_H, RS0)
    PH_NR(true, false, 1) BARRIER();
    PH_GW(5, WS_WGU0)
    PH_GS(6, WS_ACT, WS_WD0, 1024, DFF, WS_H, RS0)
    PH_NR(false, false, 3) BARRIER();
    PH_GS(8, WS_XN, WS_WB, 3072, 1024, WS_QKV, RSV)
    { PH_BEGIN(); REPS(9) { attnB_phase<1, false>(lds, (const bf16_t*)(ws + WS_QKV), (bf16_t*)(ws + WS_OB), (float*)(ws + WS_LSE0), (const float*)(ws + WS_BIAS), nullptr, nullptr, nullptr, tid, lane, wid); } } BARRIER();
    PH_GS(10, WS_XN, WS_WB + 6 * MiB, 3072, 1024, WS_QKV, RSV)
    { PH_BEGIN(); REPS(11) { attnB_phase<4, false>(lds, (const bf16_t*)(ws + WS_QKV), (bf16_t*)(ws + WS_H), (float*)(ws + WS_LSE1), (const float*)(ws + WS_BIAS) + 3072, nullptr, nullptr, nullptr, tid, lane, wid); } } BARRIER();
    PH_GS(12, WS_XN, WS_WB + 12 * MiB, 3072, 1024, WS_QKV, RSV)
    { PH_BEGIN(); attnB_phase<16, true>(lds, (const bf16_t*)(ws + WS_QKV), (bf16_t*)(ws + WS_OB), nullptr, (const float*)(ws + WS_BIAS) + 6144, (const bf16_t*)(ws + WS_H), (const float*)(ws + WS_LSE0), (const float*)(ws + WS_LSE1), tid, lane, wid); } BARRIER();
    PH_GS(14, WS_OB, WS_WOB, 1024, 1024, WS_H, RS0)
    PH_NR(false, false, 5) BARRIER();
    PH_GW(16, WS_WGU1)
    PH_GS(17, WS_ACT, WS_WD1, 1024, DFF, WS_H, RS0)
    PH_NR(false, true, 7)
}

extern "C" void kernel_launch(void* const* d_in, const int* in_sizes, int n_in, void* d_out, int out_size, void* d_ws, size_t ws_size, hipStream_t stream) {
    static int grid = 0;
    if (grid == 0) {
        if (n_in != 11 || out_size != MROWS * DM || ws_size < WS_END) { fprintf(stderr, "kernel_launch: unexpected shapes (n_in %d, out %d, ws %zu)\n", n_in, out_size, ws_size); grid = -1; return; }
        int dev = 0, cus = 0, per_cu = 0;
        (void)hipGetDevice(&dev); (void)hipDeviceGetAttribute(&cus, hipDeviceAttributeMultiprocessorCount, dev);
        if (hipFuncSetAttribute((const void*)yoco_fwd, hipFuncAttributeMaxDynamicSharedMemorySize, LDS_BYTES) != hipSuccess) { fprintf(stderr, "kernel_launch: hipFuncSetAttribute failed\n"); grid = -1; return; }
        if (hipOccupancyMaxActiveBlocksPerMultiprocessor(&per_cu, (const void*)yoco_fwd, 512, LDS_BYTES) != hipSuccess || per_cu < 1) { fprintf(stderr, "kernel_launch: occupancy query failed (%d)\n", per_cu); per_cu = 1; }
        (void)hipGetLastError();
        grid = cus * per_cu;
        if (grid <= 0) grid = 256;
    }
    if (grid < 0) return;
    if (hipMemsetAsync(d_ws, 0, 131072, stream) != hipSuccess) { fprintf(stderr, "kernel_launch: memset failed\n"); return; }
    Params p{};
    p.x = (const float*)d_in[0]; p.gains = (const float*)d_in[1]; p.w_qkv_a = (const float*)d_in[2]; p.w_o_a = (const float*)d_in[3]; p.g_kv = (const float*)d_in[4];
    p.w_kv_b = (const float*)d_in[5]; p.w_q_b = (const float*)d_in[6]; p.w_o_b = (const float*)d_in[7]; p.rel_bias = (const float*)d_in[8]; p.w_gu = (const float*)d_in[9]; p.w_down = (const float*)d_in[10];
    p.out = (float*)d_out; p.ws = (unsigned char*)d_ws;
    void* args[] = {&p};
    const hipError_t e = hipLaunchCooperativeKernel((const void*)yoco_fwd, dim3(grid), dim3(512), args, LDS_BYTES, stream);
    if (e != hipSuccess) fprintf(stderr, "kernel_launch: cooperative launch failed: %s (grid %d)\n", hipGetErrorString(e), grid);
}
```

```cpp
#include <hip/hip_runtime.h>
#include <hip/hip_cooperative_groups.h>
#include <cstdio>
#include <cstdint>
namespace cg = cooperative_groups;
namespace pg8 {
#define PG8_LAS __attribute__((address_space(3)))
typedef unsigned short bf16_t;
typedef short bf16x8 __attribute__((ext_vector_type(8)));
typedef float f32x4 __attribute__((ext_vector_type(4)));
typedef unsigned u32x4 __attribute__((ext_vector_type(4)));
constexpr int BM = 256, BK = 64, HALF = 128, HTB = HALF * BK * 2  , STAGE_BYTES = 8 * HTB, NXCD = 8, WGM = 8;

__host__ __device__ __forceinline__ int lds_byte(int r, int c) { const int st = (r >> 4) * 2 + (c >> 5), rr = r & 15, cc = c & 31, ob = rr * 64 + cc * 2; return st * 1024 + (ob ^ (((ob >> 9) & 1) << 5)); }
__host__ __device__ __forceinline__ void stage_rc(int b, int& R, int& C) { const int st = b / 1024, sb = b % 1024, swz = sb ^ (((sb >> 9) & 1) << 5); R = (st >> 1) * 16 + swz / 64; C = (st & 1) * 32 + (swz % 64) / 2; }
__host__ __device__ __forceinline__ int perm32(int rho) { const int n = rho >> 4, i = rho & 15; return 8 * (i >> 2) + 4 * n + (i & 3); }

struct Unit { int pm, pn; };
struct Gemm { const bf16_t* A; const bf16_t* Bt; int M, N, K; };

struct StaticOrder {
    int nM, nN, nwg, G, c;
    __host__ __device__ void init(int M, int N, int G_, int c_) { nM = M / BM; nN = N / BM; nwg = nM * nN; G = G_; c = c_; }
    __host__ __device__ bool next(int i, Unit& u) const {
        const long L = (long)i * G + c; if (L >= nwg) return false;
        int wgid = (int)L; { const int q = nwg / NXCD, r = nwg % NXCD, xcd = wgid % NXCD, off = wgid / NXCD; wgid = (xcd < r ? xcd * (q + 1) : r * (q + 1) + (xcd - r) * q) + off; }
        const int nig = WGM * nN, gid = wgid / nig, fm = gid * WGM, gsz = (nM - fm) < WGM ? (nM - fm) : WGM;
        u.pm = fm + ((wgid % nig) % gsz); u.pn = (wgid % nig) / gsz; return true;
    }
    __device__ __forceinline__ void a_ready(const Unit&) const {}
    __device__ __forceinline__ void done(const Unit&) const {}
};


typedef float f32x2_t __attribute__((ext_vector_type(2))); typedef __bf16 bf16x2_t __attribute__((ext_vector_type(2)));
__device__ __forceinline__ unsigned cvtpk(float lo, float hi) { f32x2_t v = {lo, hi}; bf16x2_t b = __builtin_convertvector(v, bf16x2_t); return __builtin_bit_cast(unsigned, b); }

struct EpiStore {
    static constexpr bool PERM = true, AFTER_DRAIN = false, FUSED = false;
    bf16_t* O; int ldc; const float* rs;
    __device__ __forceinline__ void operator()(const f32x4 (&acc)[2][2][4][2], const Unit& u, int wr, int wc, int fr, int fq) const {
        const int row0 = u.pm * BM + wr * 64 + fr; const int col0 = u.pn * BM + wc * 32 + 8 * fq;
#pragma unroll
        for (int ai = 0; ai < 2; ++ai)
#pragma unroll
            for (int m = 0; m < 4; ++m) { bf16_t* rowp = O + (size_t)(row0 + ai * HALF + m * 16) * ldc + col0; const float sc = rs ? rs[row0 + ai * HALF + m * 16] : 1.0f;
#pragma unroll
                for (int bj = 0; bj < 2; ++bj) { const f32x4 v0 = acc[ai][bj][m][0] * sc, v1 = acc[ai][bj][m][1] * sc;
                    u32x4 w; w.x = cvtpk(v0[0], v0[1]); w.y = cvtpk(v0[2], v0[3]); w.z = cvtpk(v1[0], v1[1]); w.w = cvtpk(v1[2], v1[3]);
                    *(u32x4*)(rowp + bj * HALF) = w; } }
    }
};
struct EpiSwiglu {
    static constexpr bool PERM = true, AFTER_DRAIN = false, FUSED = false;
    bf16_t* O; int ldc; const float* rs;
    __device__ __forceinline__ float act(float g, float u) const { const float e = __builtin_amdgcn_exp2f(-1.4426950408889634f * g); return g * u * __builtin_amdgcn_rcpf(1.0f + e); }
    __device__ __forceinline__ void operator()(const f32x4 (&acc)[2][2][4][2], const Unit& u, int wr, int wc, int fr, int fq) const {
        const int row0 = u.pm * BM + wr * 64 + fr; const int col0 = u.pn * HALF + wc * 32 + 8 * fq;
#pragma unroll
        for (int ai = 0; ai < 2; ++ai)
#pragma unroll
            for (int m = 0; m < 4; ++m) { bf16_t* rowp = O + (size_t)(row0 + ai * HALF + m * 16) * ldc + col0; const float sc = rs[row0 + ai * HALF + m * 16];
                const f32x4 g0 = acc[ai][0][m][0] * sc, g1 = acc[ai][0][m][1] * sc, u0 = acc[ai][1][m][0] * sc, u1 = acc[ai][1][m][1] * sc;
                u32x4 w; w.x = cvtpk(act(g0[0], u0[0]), act(g0[1], u0[1])); w.y = cvtpk(act(g0[2], u0[2]), act(g0[3], u0[3]));
                w.z = cvtpk(act(g1[0], u1[0]), act(g1[1], u1[1])); w.w = cvtpk(act(g1[2], u1[2]), act(g1[3], u1[3]));
                *(u32x4*)rowp = w; }
    }
};


template <class Epi, class Sched, bool ALIGN_EPI = false, bool SP2 = false>
__device__ __forceinline__ void gemm_phase(PG8_LAS unsigned char* lds, const Gemm g, const Sched& S, const Epi& E) {
    const int tid = threadIdx.x, wid = __builtin_amdgcn_readfirstlane(tid >> 6), lane = tid & 63, wr = wid >> 2, wc = wid & 3, fr = lane & 15, fq = lane >> 4;
    const int K = g.K, nt = K / BK;
    unsigned voffA, voffB;
    { int R, C; stage_rc(tid * 16, R, C); const int Rb = Epi::PERM ? ((R & ~31) + perm32(R & 31)) : R;
        voffA = (unsigned)(R * K + C) * 2u; voffB = (unsigned)(Rb * K + C) * 2u; }
    const size_t rstep = (size_t)64 * K * 2;
    const size_t kstep = (size_t)(BK * 2);
    const size_t hstep = (size_t)HALF * K * 2;
    const size_t tstep = 2 * hstep;
    const unsigned ldsw = (unsigned)wid * 1024u;
    const int aoff = lds_byte(wr * 64 + fr, fq * 8), boff = lds_byte(wc * 32 + fr, fq * 8);
#define PG8_SA(b, h) (((b) * 2 + (h)) * HTB)
#define PG8_SB(b, h) ((4 + (b) * 2 + (h)) * HTB)
#define PG8_STAGE(bufoff, gbase, voff) do { _Pragma("unroll") for (int _i = 0; _i < 2; ++_i) \
        __builtin_amdgcn_global_load_lds((const unsigned*)((const char*)(gbase) + _i * rstep + (voff)), (PG8_LAS unsigned*)(lds + (bufoff) + ldsw + _i * 8192), 16, 0, 0); } while (0)
#define PG8_LDA(dst, b, h) do { _Pragma("unroll") for (int m = 0; m < 4; ++m) _Pragma("unroll") for (int k = 0; k < 2; ++k) dst[m][k] = *(const PG8_LAS bf16x8*)(lds + PG8_SA(b, h) + aoff + m * 2048 + k * 1024); } while (0)
#define PG8_LDB(dst, b, h) do { _Pragma("unroll") for (int n = 0; n < 2; ++n) _Pragma("unroll") for (int k = 0; k < 2; ++k) dst[n][k] = *(const PG8_LAS bf16x8*)(lds + PG8_SB(b, h) + boff + n * 2048 + k * 1024); } while (0)
#define PG8_MMA(ai, bj, At, Bt) do { __builtin_amdgcn_s_setprio(1); _Pragma("unroll") for (int m = 0; m < 4; ++m) _Pragma("unroll") for (int n = 0; n < 2; ++n) _Pragma("unroll") for (int k = 0; k < 2; ++k) \
        acc[ai][bj][m][n] = __builtin_amdgcn_mfma_f32_16x16x32_bf16(Bt[n][k], At[m][k], acc[ai][bj][m][n], 0, 0, 0); __builtin_amdgcn_s_setprio(0); } while (0)
#define PG8_WAIT_V(n) asm volatile("s_waitcnt vmcnt(" #n ")" ::: "memory")
#define PG8_WAIT_L(n) asm volatile("s_waitcnt lgkmcnt(" #n ")" ::: "memory")
#define PG8_BAR __builtin_amdgcn_s_barrier()
#define PG8_SCHED __builtin_amdgcn_sched_barrier(0)
    Unit cur, nxt; int ui = 0;
    if (!S.next(0, cur)) return;
    f32x4 acc[2][2][4][2];
#pragma unroll
    for (int a = 0; a < 2; ++a)
#pragma unroll
        for (int b = 0; b < 2; ++b)
#pragma unroll
            for (int m = 0; m < 4; ++m)
#pragma unroll
                for (int n = 0; n < 2; ++n) acc[a][b][m][n] = (f32x4){0.f, 0.f, 0.f, 0.f};
    bf16x8 At[4][2], B0[2][2], B1[2][2];
    const char* cA = (const char*)g.A + (size_t)cur.pm * tstep; const char* cB = (const char*)g.Bt + (size_t)cur.pn * tstep;
    S.a_ready(cur);
    if constexpr (SP2) {
        PG8_STAGE(PG8_SB(0, 0), cB, voffB); PG8_STAGE(PG8_SB(0, 1), cB + hstep, voffB); PG8_STAGE(PG8_SA(0, 0), cA, voffA); PG8_STAGE(PG8_SA(0, 1), cA + hstep, voffA);
        if (wr == 1) PG8_BAR;
        PG8_WAIT_V(2); PG8_BAR;
        PG8_STAGE(PG8_SB(1, 0), cB + kstep, voffB); PG8_STAGE(PG8_SA(1, 0), cA + kstep, voffA); PG8_STAGE(PG8_SB(1, 1), cB + hstep + kstep, voffB);
        PG8_WAIT_V(6); PG8_BAR;
    } else {
        PG8_STAGE(PG8_SB(0, 0), cB, voffB); PG8_STAGE(PG8_SA(0, 0), cA, voffA); PG8_STAGE(PG8_SB(0, 1), cB + hstep, voffB); PG8_STAGE(PG8_SA(0, 1), cA + hstep, voffA);
        if (wr == 1) PG8_BAR;
        PG8_WAIT_V(4); PG8_BAR;
        PG8_STAGE(PG8_SB(1, 0), cB + kstep, voffB); PG8_STAGE(PG8_SA(1, 0), cA + kstep, voffA); PG8_STAGE(PG8_SB(1, 1), cB + hstep + kstep, voffB);
        PG8_WAIT_V(6); PG8_BAR;
    }
    for (;;) {
        const bool has_next = S.next(ui + 1, nxt);
        const char* nA = has_next ? (const char*)g.A + (size_t)nxt.pm * tstep : cA; const char* nB = has_next ? (const char*)g.Bt + (size_t)nxt.pn * tstep : cB;
        for (int t = 0; t < nt; t += 2) {
            const bool last = (t == nt - 2);
            const char* a1 = cA + (size_t)(t + 1) * kstep;
            const char* a2 = last ? nA : cA + (size_t)(t + 2) * kstep; const char* b2 = last ? nB : cB + (size_t)(t + 2) * kstep;
            const char* a3 = a2 + kstep; const char* b3 = b2 + kstep;
            if (last && has_next) S.a_ready(nxt);
            if constexpr (SP2) {
            PG8_LDB(B0, 0, 0); PG8_LDB(B1, 0, 1); PG8_SCHED; PG8_LDA(At, 0, 0); PG8_STAGE(PG8_SA(1, 1), a1 + hstep, voffA);
            PG8_WAIT_V(8); PG8_WAIT_L(0); PG8_BAR; PG8_MMA(0, 0, At, B0); PG8_MMA(0, 1, At, B1); PG8_BAR; PG8_SCHED;
            PG8_LDA(At, 0, 1); PG8_STAGE(PG8_SB(0, 0), b2, voffB); PG8_STAGE(PG8_SB(0, 1), b2 + hstep, voffB); PG8_STAGE(PG8_SA(0, 0), a2, voffA);
            PG8_WAIT_V(8); PG8_WAIT_L(0); PG8_BAR; PG8_MMA(1, 0, At, B0); PG8_MMA(1, 1, At, B1); PG8_BAR; PG8_SCHED;
            PG8_LDB(B0, 1, 0); PG8_LDB(B1, 1, 1); PG8_SCHED; PG8_LDA(At, 1, 0); PG8_STAGE(PG8_SA(0, 1), a2 + hstep, voffA);
            PG8_WAIT_V(8); PG8_WAIT_L(0); PG8_BAR; PG8_MMA(0, 0, At, B0); PG8_MMA(0, 1, At, B1); PG8_BAR; PG8_SCHED;
            PG8_LDA(At, 1, 1); PG8_STAGE(PG8_SB(1, 0), b3, voffB); PG8_STAGE(PG8_SB(1, 1), b3 + hstep, voffB); PG8_STAGE(PG8_SA(1, 0), a3, voffA);
            PG8_WAIT_V(8); PG8_WAIT_L(0); PG8_BAR; PG8_MMA(1, 0, At, B0); PG8_MMA(1, 1, At, B1); PG8_BAR; PG8_SCHED;
            } else {
            PG8_LDB(B0, 0, 0); PG8_SCHED; PG8_LDA(At, 0, 0); PG8_STAGE(PG8_SA(1, 1), a1 + hstep, voffA);
            PG8_WAIT_L(8); PG8_BAR; PG8_WAIT_L(0); PG8_MMA(0, 0, At, B0); PG8_BAR; PG8_SCHED;
            PG8_LDB(B1, 0, 1); PG8_STAGE(PG8_SB(0, 0), b2, voffB);
            PG8_BAR; PG8_WAIT_L(0); PG8_MMA(0, 1, At, B1); PG8_BAR;
            PG8_LDA(At, 0, 1); PG8_STAGE(PG8_SA(0, 0), a2, voffA);
            PG8_BAR; PG8_WAIT_L(0); PG8_MMA(1, 0, At, B0); PG8_BAR; PG8_SCHED;
            PG8_STAGE(PG8_SB(0, 1), b2 + hstep, voffB);
            PG8_WAIT_V(6); PG8_BAR; PG8_MMA(1, 1, At, B1); PG8_BAR;
            PG8_LDB(B0, 1, 0); PG8_SCHED; PG8_LDA(At, 1, 0); PG8_STAGE(PG8_SA(0, 1), a2 + hstep, voffA);
            PG8_WAIT_L(8); PG8_BAR; PG8_WAIT_L(0); PG8_MMA(0, 0, At, B0); PG8_BAR; PG8_SCHED;
            PG8_LDB(B1, 1, 1); PG8_STAGE(PG8_SB(1, 0), b3, voffB);
            PG8_BAR; PG8_WAIT_L(0); PG8_MMA(0, 1, At, B1); PG8_BAR;
            PG8_LDA(At, 1, 1); PG8_STAGE(PG8_SA(1, 0), a3, voffA);
            PG8_BAR; PG8_WAIT_L(0); PG8_MMA(1, 0, At, B0); PG8_BAR; PG8_SCHED;
            PG8_STAGE(PG8_SB(1, 1), b3 + hstep, voffB);
            PG8_WAIT_V(6); PG8_BAR; PG8_MMA(1, 1, At, B1); PG8_BAR;
            }
        }
        if constexpr (ALIGN_EPI) { if (wr == 0) PG8_BAR; }
        if constexpr (Epi::FUSED) { E.fused(acc, cur, wr, wc, fr, fq, lds + STAGE_BYTES, wid, lane); } else
        if constexpr (!Epi::AFTER_DRAIN) { E(acc, cur, wr, wc, fr, fq); S.done(cur); }
        if (!has_next) break;
#pragma unroll
        for (int a = 0; a < 2; ++a)
#pragma unroll
            for (int b = 0; b < 2; ++b)
#pragma unroll
                for (int m = 0; m < 4; ++m)
#pragma unroll
                    for (int n = 0; n < 2; ++n) acc[a][b][m][n] = (f32x4){0.f, 0.f, 0.f, 0.f};
        cur = nxt; cA = nA; cB = nB; ++ui;
        if constexpr (ALIGN_EPI) { if (wr == 1) PG8_BAR; }
    }
    PG8_WAIT_V(0);
    if constexpr (!ALIGN_EPI) { if (wr == 0) PG8_BAR; }
    PG8_BAR;
    if constexpr (Epi::AFTER_DRAIN) { E.fused(acc, cur, wr, wc, fr, fq, lds, wid, lane); S.done(cur); }
#undef PG8_SA
#undef PG8_SB
#undef PG8_STAGE
#undef PG8_LDA
#undef PG8_LDB
#undef PG8_MMA
#undef PG8_WAIT_V
#undef PG8_WAIT_L
#undef PG8_BAR
#undef PG8_SCHED
}
}

#define LAS __attribute__((address_space(3)))
typedef pg8::bf16_t bf16_t; typedef pg8::bf16x8 bf16x8; typedef pg8::f32x4 f32x4; typedef pg8::u32x4 u32x4;
typedef float f32x16 __attribute__((ext_vector_type(16)));
typedef unsigned u32x2 __attribute__((ext_vector_type(2)));
typedef short v4i16_t __attribute__((ext_vector_type(4)));
using pg8::cvtpk;

constexpr int BATCH = 16, SEQ = 2048, DM = 1024, NH = 16, HD = 64, DFF = 2816, MROWS = BATCH * SEQ;
constexpr float RMS_EPS = 1e-6f;
constexpr float LOG2E = 1.4426950408889634f;
constexpr float QSCALE = 0.125f * LOG2E;
constexpr size_t MiB = 1u << 20;
constexpr size_t WS_CNT = 16384  , WS_SLOT = 63 * MiB + 65536  ;
constexpr size_t WS_WQKVA = 1 * MiB, WS_WOA = 7 * MiB, WS_WGU0 = 9 * MiB, WS_WD0 = 20 * MiB, WS_WB = 26 * MiB  , WS_WOB = 44 * MiB,
                 WS_WGU1 = 46 * MiB, WS_WD1 = 57 * MiB, WS_BIAS = 63 * MiB, WS_XN = 65 * MiB, WS_QKV = 129 * MiB, WS_ACT = 129 * MiB  ,
                 WS_OB = 321 * MiB, WS_H = 385 * MiB, WS_LSE0 = 449 * MiB, WS_LSE1 = 451 * MiB, WS_RS = 453 * MiB  , WS_END = 454 * MiB;
constexpr int LDS_BYTES = 155648;

struct Params { const float *x, *gains, *w_qkv_a, *w_o_a, *g_kv, *w_kv_b, *w_q_b, *w_o_b, *rel_bias, *w_gu, *w_down; float* out; unsigned char* ws; };

#define LDS_WAIT() asm volatile("s_waitcnt lgkmcnt(0)" ::: "memory")
__device__ __forceinline__ float wave_sum(float v) {
#pragma unroll
    for (int o = 1; o < 64; o <<= 1) v += __shfl_xor(v, o);
    return v;
}
__device__ __forceinline__ int crow(int r, int hi) { return (r & 3) + 8 * (r >> 2) + 4 * hi; }
__device__ __forceinline__ float bf_lo(unsigned w) { return __uint_as_float(w << 16); }
__device__ __forceinline__ float bf_hi(unsigned w) { return __uint_as_float(w & 0xffff0000u); }

__device__ __forceinline__ void conv_item(const float* __restrict__ W, int ldw, int col, int K, const float* __restrict__ gain, float scale, bf16_t* WT, int drow, LAS float* scr, int kb, int lane) {
    const int k0 = 64 * kb, ks = lane >> 3, n4 = lane & 7;
    f32x4 v[8]; float gs[8];
#pragma unroll
    for (int i = 0; i < 8; ++i) { const int kk = 8 * i + ks; v[i] = *(const f32x4*)(W + (size_t)(k0 + kk) * ldw + col + 4 * n4); gs[i] = gain ? gain[k0 + kk] * scale : scale; }
#pragma unroll
    for (int i = 0; i < 8; ++i) { const int kk = 8 * i + ks; LAS float* d = scr + kk * 33 + 4 * n4; d[0] = v[i].x * gs[i]; d[1] = v[i].y * gs[i]; d[2] = v[i].z * gs[i]; d[3] = v[i].w * gs[i]; }
    LDS_WAIT();
    const int c = lane & 7;
#pragma unroll
    for (int j = 0; j < 4; ++j) { const int n = (lane >> 3) + 8 * j; const LAS float* s = scr + (8 * c) * 33 + n;
        u32x4 o; o.x = cvtpk(s[0 * 33], s[1 * 33]); o.y = cvtpk(s[2 * 33], s[3 * 33]); o.z = cvtpk(s[4 * 33], s[5 * 33]); o.w = cvtpk(s[6 * 33], s[7 * 33]);
        *(u32x4*)(WT + (size_t)(drow + n) * K + k0 + 8 * c) = o; }
    LDS_WAIT();
}
template <int MODE> __device__ __forceinline__ void conv_seg(const float* src, int ld, int col0, int ncols, int K, const float* gain, float scale, bf16_t* dst, int drow0,
                                                             LAS float* scr, int gw, int NGW, int& off, int lane) {
    const int nblk = ncols >> 5, items = nblk * (K >> 6);
    int it0 = gw - (off % NGW); if (it0 < 0) it0 += NGW; off += items;
    for (int it = it0; it < items; it += NGW) {
        const int kb = it / nblk, nb = it - kb * nblk, c = 32 * nb; int drow;
        if (MODE == 1) { const int upf = c >= DFF ? 1 : 0, cc = c - upf * DFF; drow = 256 * (cc >> 7) + 128 * upf + (cc & 127); } else drow = drow0 + c;
        conv_item(src, ld, col0 + c, K, gain, scale, dst, drow, scr, kb, lane);
    }
}
__device__ __forceinline__ void norm_row_bf16(const float* xrow, bf16_t* orow, float* rs, int lane) {
    const f32x4* xr = (const f32x4*)xrow + lane;
    f32x4 v[4]; float s = 0.f;
#pragma unroll
    for (int j = 0; j < 4; ++j) { v[j] = xr[64 * j]; s += (v[j].x * v[j].x + v[j].y * v[j].y) + (v[j].z * v[j].z + v[j].w * v[j].w); }
    const float r = 1.0f / sqrtf(wave_sum(s) * (1.f / DM) + RMS_EPS);
    if (lane == 0) *rs = r;
    u32x2* o8 = (u32x2*)orow + lane;
#pragma unroll
    for (int j = 0; j < 4; ++j) { u32x2 w; w.x = cvtpk(v[j].x, v[j].y); w.y = cvtpk(v[j].z, v[j].w); o8[64 * j] = w; }
}
__device__ __forceinline__ void prologue(const Params& P, LAS unsigned char* lds, int tid, int lane, int wave) {
    LAS float* scr = (LAS float*)(lds + wave * 16384);
    const int G = gridDim.x, gw = blockIdx.x * 8 + wave, NGW = G * 8;
    unsigned char* ws = P.ws; int off = 0;
    const float* g00 = P.gains + 0 * DM; const float* g02 = P.gains + 2 * DM; const float* g10 = P.gains + 4 * DM; const float* g12 = P.gains + 6 * DM;
    conv_seg<0>(P.w_qkv_a, 3072, 0, 1024, 1024, g00, QSCALE, (bf16_t*)(ws + WS_WQKVA), 0, scr, gw, NGW, off, lane);
    conv_seg<0>(P.w_qkv_a, 3072, 1024, 2048, 1024, g00, 1.0f, (bf16_t*)(ws + WS_WQKVA), 1024, scr, gw, NGW, off, lane);
    conv_seg<0>(P.w_o_a, 1024, 0, 1024, 1024, nullptr, 1.0f, (bf16_t*)(ws + WS_WOA), 0, scr, gw, NGW, off, lane);
    conv_seg<1>(P.w_gu, 2 * DFF, 0, 2 * DFF, 1024, g02, 1.0f, (bf16_t*)(ws + WS_WGU0), 0, scr, gw, NGW, off, lane);
    conv_seg<0>(P.w_down, 1024, 0, 1024, DFF, nullptr, 1.0f, (bf16_t*)(ws + WS_WD0), 0, scr, gw, NGW, off, lane);
    for (int g = 0; g < 3; ++g) {
        bf16_t* wb = (bf16_t*)(ws + WS_WB + (size_t)g * 6 * MiB);
        conv_seg<0>(P.w_q_b, 3072, 1024 * g, 1024, 1024, g10, QSCALE, wb, 0, scr, gw, NGW, off, lane);
        conv_seg<0>(P.w_kv_b, 6144, 2048 * g, 2048, 1024, P.g_kv, 1.0f, wb, 1024, scr, gw, NGW, off, lane);
    }
    conv_seg<0>(P.w_o_b, 1024, 0, 1024, 1024, nullptr, 1.0f, (bf16_t*)(ws + WS_WOB), 0, scr, gw, NGW, off, lane);
    conv_seg<1>(P.w_gu + (size_t)DM * 2 * DFF, 2 * DFF, 0, 2 * DFF, 1024, g12, 1.0f, (bf16_t*)(ws + WS_WGU1), 0, scr, gw, NGW, off, lane);
    conv_seg<0>(P.w_down + (size_t)DFF * DM, 1024, 0, 1024, DFF, nullptr, 1.0f, (bf16_t*)(ws + WS_WD1), 0, scr, gw, NGW, off, lane);
    bf16_t* XN = (bf16_t*)(ws + WS_XN);
    for (int m = gw; m < MROWS; m += NGW) norm_row_bf16(P.x + (size_t)m * DM, XN + (size_t)m * DM, (float*)(ws + WS_RS) + m, lane);
    float* BT = (float*)(ws + WS_BIAS);
    for (int idx = blockIdx.x * 512 + tid; idx < 3 * 16 * 192; idx += G * 512) {
        const int g = idx / 3072, rem = idx - g * 3072, h = rem / 192, e = rem - h * 192, rel = e - 32; float v = 0.f;
        if (rel >= 0 && rel <= 128) { const int dl = (g == 0) ? 1 : ((g == 1) ? 4 : 16); const int n = rel * dl; int bk;
            if (n < 16) bk = n;
            else { bk = 16 + (n >= 22) + (n >= 30) + (n >= 40) + (n >= 54) + (n >= 73) + (n >= 99) + (n >= 134) + (n >= 182) + (n >= 246) + (n >= 332) + (n >= 450) + (n >= 609) + (n >= 825) + (n >= 1117) + (n >= 1513); }
            v = P.rel_bias[bk * 16 + h] * LOG2E; }
        BT[idx] = v;
    }
}

template <bool XIN32, bool OUT32> __device__ __forceinline__ void norm_res_phase(const bf16_t* H, const float* gain, const float* Xin32, bf16_t* XB, float* RS, float* Out32, int lane, int wave) {
    const int gw = blockIdx.x * 8 + wave, NGW = gridDim.x * 8;
    f32x4 gv[4];
#pragma unroll
    for (int j = 0; j < 4; ++j) gv[j] = *((const f32x4*)gain + lane + 64 * j);
    for (int m = gw; m < MROWS; m += NGW) {
        const u32x2* hp = (const u32x2*)(H + (size_t)m * DM) + lane;
        f32x4 hv[4], xv[4]; float ss = 0.f;
#pragma unroll
        for (int j = 0; j < 4; ++j) { const u32x2 w = hp[64 * j]; hv[j] = (f32x4){bf_lo(w.x), bf_hi(w.x), bf_lo(w.y), bf_hi(w.y)};
            if (XIN32) xv[j] = *((const f32x4*)(Xin32 + (size_t)m * DM) + lane + 64 * j);
            else { const u32x2 xw = *((const u32x2*)(XB + (size_t)m * DM) + lane + 64 * j); xv[j] = (f32x4){bf_lo(xw.x), bf_hi(xw.x), bf_lo(xw.y), bf_hi(xw.y)}; }
            ss += (hv[j].x * hv[j].x + hv[j].y * hv[j].y) + (hv[j].z * hv[j].z + hv[j].w * hv[j].w); }
        const float r = 1.0f / sqrtf(wave_sum(ss) * (1.f / DM) + RMS_EPS);
        float s2 = 0.f;
#pragma unroll
        for (int j = 0; j < 4; ++j) { xv[j] = xv[j] + hv[j] * r * gv[j];
            s2 += (xv[j].x * xv[j].x + xv[j].y * xv[j].y) + (xv[j].z * xv[j].z + xv[j].w * xv[j].w); }
        if (OUT32) { f32x4* op = (f32x4*)(Out32 + (size_t)m * DM) + lane;
#pragma unroll
            for (int j = 0; j < 4; ++j) op[64 * j] = xv[j]; }
        else { const float r2 = 1.0f / sqrtf(wave_sum(s2) * (1.f / DM) + RMS_EPS); if (lane == 0) RS[m] = r2; u32x2* o8 = (u32x2*)(XB + (size_t)m * DM) + lane;
#pragma unroll
            for (int j = 0; j < 4; ++j) { u32x2 w; w.x = cvtpk(xv[j].x, xv[j].y); w.y = cvtpk(xv[j].z, xv[j].w); o8[64 * j] = w; } }
    }
}

__device__ __forceinline__ bf16x8 vfrag(const LAS unsigned char* p) {
    const v4i16_t lo = __builtin_amdgcn_ds_read_tr16_b64_v4i16((LAS v4i16_t*)p);
    const v4i16_t hi = __builtin_amdgcn_ds_read_tr16_b64_v4i16((LAS v4i16_t*)(p + 512));
    return (bf16x8){lo[0], lo[1], lo[2], lo[3], hi[0], hi[1], hi[2], hi[3]};
}
__device__ __forceinline__ bf16x8 pack8(const float* a) {
    u32x4 w; w.x = cvtpk(a[0], a[1]); w.y = cvtpk(a[2], a[3]); w.z = cvtpk(a[4], a[5]); w.w = cvtpk(a[6], a[7]); return __builtin_bit_cast(bf16x8, w);
}

template <bool MASK> __device__ __forceinline__ void sb_subtile(const LAS unsigned char* kbuf, const LAS unsigned char* vbuf  , int sub, const bf16x8 (&qf)[4], const int (&kaddr)[4],
                                                                float& carry, f32x16 (&o)[2], int r32, int hh) {
    f32x16 S = {};
#pragma unroll
    for (int dk = 0; dk < 4; ++dk) { const bf16x8 kf = *(const LAS bf16x8*)(kbuf + kaddr[dk] + sub * 512); S = __builtin_amdgcn_mfma_f32_32x32x16_bf16(kf, qf[dk], S, 0, 0, 0); }
    float p[16];
#pragma unroll
    for (int r = 0; r < 16; ++r) { const float u = __builtin_amdgcn_exp2f(S[r]); float wv = __builtin_amdgcn_rcpf(1.0f + u);
        if (MASK) wv = (crow(r, hh) < r32) ? wv : 1.0f; p[r] = wv; }
    float go[4], t[4];
#pragma unroll
    for (int i = 0; i < 4; ++i) { p[4 * i + 2] *= p[4 * i + 3]; p[4 * i + 1] *= p[4 * i + 2]; p[4 * i] *= p[4 * i + 1];
        const auto rr = __builtin_amdgcn_permlane32_swap(__float_as_uint(p[4 * i]), __float_as_uint(p[4 * i]), false, false);
        go[i] = __uint_as_float(rr[1]); t[i] = __uint_as_float(rr[0]) * __uint_as_float(rr[1]); }
    const float R2 = t[3], R1 = t[3] * t[2], R0 = R1 * t[1];
    float E[4];
    E[3] = carry * (hh ? 1.0f : go[3]); E[2] = carry * R2 * (hh ? 1.0f : go[2]); E[1] = carry * R1 * (hh ? 1.0f : go[1]); E[0] = carry * R0 * (hh ? 1.0f : go[0]);
    carry = carry * R0 * t[0];
    float A[16];
#pragma unroll
    for (int i = 0; i < 4; ++i) { const float I3 = E[i] * p[4 * i + 3], I2 = E[i] * p[4 * i + 2], I1 = E[i] * p[4 * i + 1], I0 = E[i] * p[4 * i];
        A[4 * i + 3] = E[i] - I3; A[4 * i + 2] = I3 - I2; A[4 * i + 1] = I2 - I1; A[4 * i] = I1 - I0; }
    const bf16x8 pf0 = pack8(A), pf1 = pack8(A + 8);
#pragma unroll
    for (int dh = 0; dh < 2; ++dh) {
        const bf16x8 v0 = vfrag(vbuf + dh * 4096 + (32 * sub) * 64), v1 = vfrag(vbuf + dh * 4096 + (32 * sub + 16) * 64);
        o[dh] = __builtin_amdgcn_mfma_f32_32x32x16_bf16(pf0, v0, o[dh], 0, 0, 0);
        o[dh] = __builtin_amdgcn_mfma_f32_32x32x16_bf16(pf1, v1, o[dh], 0, 0, 0);
    }
}

__device__ __forceinline__ void attnA_phase(LAS unsigned char* lds, const bf16_t* __restrict__ QKV, bf16_t* __restrict__ O, int tid, int lane, int wid) {
    const int r32 = lane & 31, hh = lane >> 5;
    int kaddr[4];
#pragma unroll
    for (int dk = 0; dk < 4; ++dk) { const int c = 2 * dk + hh; kaddr[dk] = c * 1024 + ((r32 ^ c) << 4); }
    const int vlane = (4 * hh + ((lane & 15) >> 2)) * 64 + ((lane >> 4) & 1) * 32 + (lane & 3) * 8;
    LAS unsigned* flags = (LAS unsigned*)(lds + 32768);
    const int lkey = tid >> 3, lc = tid & 7;
    const int kwoff = lc * 1024 + ((lkey ^ lc) << 4), vwoff = 16384 + (lc >> 2) * 4096 + lkey * 64 + (lc & 3) * 16;
    for (int u = blockIdx.x; u < BATCH * NH * 8; u += gridDim.x) {
        const int bh = u >> 3, qb = ((u & 7) + (u >> 8)) & 7, b = bh >> 4, h = bh & 15;
        const size_t rowbase = (size_t)b * SEQ; const int q0 = qb * 256, R0 = q0 + 32 * wid;
        bf16x8 qf[4];
        { const bf16_t* qp = QKV + (rowbase + R0 + r32) * 3072 + h * 64 + 8 * hh;
#pragma unroll
          for (int dk = 0; dk < 4; ++dk) qf[dk] = *(const bf16x8*)(qp + 16 * dk); }
        const bf16_t* kvg = QKV + (rowbase + lkey) * 3072 + 1024 + h * 64 + 8 * lc;
        const int NT = 4 * qb + 4;
        { const bf16_t* kg = kvg + (size_t)(64 * (NT - 1)) * 3072; const u32x4 kr = *(const u32x4*)kg, vr = *(const u32x4*)(kg + 1024);
          *(LAS u32x4*)(lds + kwoff) = kr; *(LAS u32x4*)(lds + vwoff) = vr; }
        __syncthreads();
        float carry = 1.0f; f32x16 o[2]; o[0] = f32x16{}; o[1] = f32x16{};
        int cur = 0;
        for (int kt = NT - 1; kt >= 0; --kt) {
            u32x4 kr, vr;
            if (kt > 0) { const bf16_t* kg = kvg + (size_t)(64 * (kt - 1)) * 3072; kr = *(const u32x4*)kg; vr = *(const u32x4*)(kg + 1024); }
            const int diff = R0 - 64 * kt;
            const LAS unsigned char* kbuf = lds + cur * 8192; const LAS unsigned char* vbuf = lds + 16384 + cur * 8192 + vlane;
            bool walive = __any(carry >= 1.17549435e-38f);
            if (walive) {
            if (diff >= 64) { sb_subtile<false>(kbuf, vbuf, 1, qf, kaddr, carry, o, r32, hh); sb_subtile<false>(kbuf, vbuf, 0, qf, kaddr, carry, o, r32, hh); }
            else if (diff == 32) { sb_subtile<true>(kbuf, vbuf, 1, qf, kaddr, carry, o, r32, hh); sb_subtile<false>(kbuf, vbuf, 0, qf, kaddr, carry, o, r32, hh); }
            else if (diff == 0) { sb_subtile<true>(kbuf, vbuf, 0, qf, kaddr, carry, o, r32, hh); }
            walive = __any(carry >= 1.17549435e-38f); }
            if (kt > 0) { *(LAS u32x4*)(lds + (cur ^ 1) * 8192 + kwoff) = kr; *(LAS u32x4*)(lds + (cur ^ 1) * 8192 + vwoff) = vr; }
            if (lane == 0) flags[cur * 8 + wid] = walive ? 1u : 0u;
            __syncthreads();
            const u32x4 f0 = *(const LAS u32x4*)(flags + cur * 8), f1 = *(const LAS u32x4*)(flags + cur * 8 + 4);
            cur ^= 1;
            if (((f0.x | f0.y) | (f0.z | f0.w) | (f1.x | f1.y) | (f1.z | f1.w)) == 0u) break;
        }
        { LAS bf16_t* stg = (LAS bf16_t*)(lds + 36864 + wid * 4096);
#pragma unroll
          for (int r = 0; r < 16; ++r) { const int qq = crow(r, hh);
#pragma unroll
              for (int dh = 0; dh < 2; ++dh) stg[qq * 64 + 32 * dh + r32] = (bf16_t)(cvtpk(o[dh][r], 0.f) & 0xffffu); }
          LDS_WAIT();
          bf16_t* op = O + (rowbase + R0) * DM + h * 64;
#pragma unroll
          for (int i = 0; i < 4; ++i) { const int row = (lane >> 3) + 8 * i, ch = lane & 7; const u32x4 v = *(const LAS u32x4*)(stg + row * 64 + ch * 8); *(u32x4*)(op + (size_t)row * DM + ch * 8) = v; }
          LDS_WAIT(); }
    }
}

template <int DL, bool FINAL> __device__ __forceinline__ void attnB_phase(LAS unsigned char* lds, const bf16_t* __restrict__ QKV, bf16_t* O, float* lse_out, const float* __restrict__ BT,
                                                                          const bf16_t* O1, const float* lse0, const float* lse1, int tid, int lane, int wid) {
    constexpr int NB = 16 / DL;
    const int r32 = lane & 31, hh = lane >> 5, half = wid >> 2, wq = wid & 3, ht = tid & 255;
    LAS unsigned char* hb = lds + half * 65536;
    LAS float* bl = (LAS float*)(lds + 131072 + half * 768);
    LAS float* scr = (LAS float*)(lds + 131072 + 1536 + wid * 512);
    LAS bf16_t* stg = (LAS bf16_t*)(lds + 131072 + 1536 + 4096 + wid * 2048);
    int kaddr[4];
#pragma unroll
    for (int dk = 0; dk < 4; ++dk) { const int c = 2 * dk + hh; kaddr[dk] = c * 2048 + ((r32 ^ c) << 4); }
    const int vlane = 16384 + (4 * hh + ((lane & 15) >> 2)) * 64 + ((lane >> 4) & 1) * 32 + (lane & 3) * 8;
    const int key_in = ht >> 3, c8 = ht & 7;
    const int kwo = c8 * 2048 + ((key_in ^ c8) << 4), vwo = 16384 + (c8 >> 2) * 8192 + key_in * 64 + (c8 & 3) * 16;
#define BLK_ISSUE(nblk, rres) do { _Pragma("unroll") for (int i_ = 0; i_ < 4; ++i_) { const bf16_t* kg_ = kvbase + (size_t)(((nblk) * 128 + 32 * i_ + key_in) * DL + (rres)) * 3072; \
        kr[i_] = *(const u32x4*)kg_; vr[i_] = *(const u32x4*)(kg_ + 1024); } } while (0)
#define BLK_WRITE(slot) do { _Pragma("unroll") for (int i_ = 0; i_ < 4; ++i_) { *(LAS u32x4*)(hb + (slot) * 32768 + kwo + 512 * i_) = kr[i_]; *(LAS u32x4*)(hb + (slot) * 32768 + vwo + 2048 * i_) = vr[i_]; } } while (0)
    for (int hidx = blockIdx.x; hidx < BATCH * NH; hidx += gridDim.x) {
        const int ub = (2 * hidx + half) * 8, bh = ub >> 4, b = bh >> 4, h = bh & 15;
        const bf16_t* kvbase = QKV + (size_t)b * SEQ * 3072 + 1024 + h * 64 + 8 * c8;
        const bf16_t* qbase = QKV + (size_t)b * SEQ * 3072 + h * 64 + 8 * hh;
        u32x4 kr[4], vr[4]; bf16x8 qf[4];
        __syncthreads();
        { const int cc = ub & 15, rr = cc / NB, n = cc % NB;
          BLK_ISSUE(n, rr); BLK_WRITE(n & 1);
          if (n > 0) { BLK_ISSUE(n - 1, rr); BLK_WRITE((n - 1) & 1); }
          if (ht < 192) bl[ht] = BT[h * 192 + ht];
          const bf16_t* qp = qbase + (size_t)((n * 128 + 32 * wq + r32) * DL + rr) * 3072;
#pragma unroll
          for (int dk = 0; dk < 4; ++dk) qf[dk] = *(const bf16x8*)(qp + 16 * dk); }
        __syncthreads();
        for (int i = 0; i < 8; ++i) {
            const int cc = (ub + i) & 15, rr = cc / NB, n = cc % NB;
            bf16x8 qn[4]; int n2 = 0;
            if (i < 7) { const int cc2 = (ub + i + 1) & 15, rr2 = cc2 / NB; n2 = cc2 % NB; BLK_ISSUE(n2, rr2);
                const bf16_t* qp = qbase + (size_t)((n2 * 128 + 32 * wq + r32) * DL + rr2) * 3072;
#pragma unroll
                for (int dk = 0; dk < 4; ++dk) qn[dk] = *(const bf16x8*)(qp + 16 * dk); }
            const int jstart = (n == 0) ? (4 - wq) : 0;
            const int par = (n - 1) & 1;
            const LAS float* blp = bl + 160 + r32 - 4 * hh;
            float mx = -INFINITY, l = 0.f; f32x16 o[2]; o[0] = f32x16{}; o[1] = f32x16{};
#pragma unroll
            for (int jj = 0; jj < 5; ++jj) {
                if (jj >= jstart) {
                    const int j = wq + jj; const LAS unsigned char* kb = hb + (par ^ (j >> 2)) * 32768 + (j & 3) * 512;
                    f32x16 s = {};
#pragma unroll
                    for (int dk = 0; dk < 4; ++dk) { const bf16x8 kf = *(const LAS bf16x8*)(kb + kaddr[dk]); s = __builtin_amdgcn_mfma_f32_32x32x16_bf16(kf, qf[dk], s, 0, 0, 0); }
                    float rm = -INFINITY;
#pragma unroll
                    for (int r = 0; r < 16; ++r) { const int kk = crow(r, hh); float v = s[r] + blp[-(32 * jj + (r & 3) + 8 * (r >> 2))];
                        if (jj == 0) v = (kk >= r32) ? v : -INFINITY;
                        if (jj == 4) v = (kk <= r32) ? v : -INFINITY;
                        s[r] = v; rm = fmaxf(rm, v); }
                    rm = fmaxf(rm, __shfl_xor(rm, 32));
                    const bool up = rm > mx + 8.0f;
                    if (__any(up)) {
                        const float mnew = up ? rm : mx; const float f = __builtin_amdgcn_exp2f(mx - mnew); l *= f; mx = mnew;
                        if (hh == 0) scr[r32] = f;
                        LDS_WAIT();
#pragma unroll
                        for (int r = 0; r < 16; ++r) { const float fr = scr[crow(r, hh)]; o[0][r] *= fr; o[1][r] *= fr; }
                        LDS_WAIT();
                    }
                    float pe[16];
#pragma unroll
                    for (int r = 0; r < 16; ++r) { pe[r] = __builtin_amdgcn_exp2f(s[r] - mx); l += pe[r]; }
                    const bf16x8 pf0 = pack8(pe), pf1 = pack8(pe + 8);
                    const LAS unsigned char* vb = hb + (par ^ (j >> 2)) * 32768 + (j & 3) * 2048 + vlane;
#pragma unroll
                    for (int dh = 0; dh < 2; ++dh) {
                        const bf16x8 v0 = vfrag(vb + dh * 8192), v1 = vfrag(vb + dh * 8192 + 16 * 64);
                        o[dh] = __builtin_amdgcn_mfma_f32_32x32x16_bf16(pf0, v0, o[dh], 0, 0, 0);
                        o[dh] = __builtin_amdgcn_mfma_f32_32x32x16_bf16(pf1, v1, o[dh], 0, 0, 0);
                    }
                }
            }
            l += __shfl_xor(l, 32);
            const float lse2 = mx + __builtin_amdgcn_logf(l);
            const size_t rowq0 = (size_t)b * SEQ + (size_t)((n * 128 + 32 * wq) * DL + rr);
            if (hh == 0) { scr[r32] = __builtin_amdgcn_rcpf(l);
                if (!FINAL) lse_out[(rowq0 + (size_t)r32 * DL) * 16 + h] = lse2;
                else { const size_t rg = (rowq0 + (size_t)r32 * DL) * 16 + h; const float l0 = lse0[rg], l1 = lse1[rg];
                    const float M = fmaxf(fmaxf(l0, l1), lse2); const float e0 = __builtin_amdgcn_exp2f(l0 - M), e1 = __builtin_amdgcn_exp2f(l1 - M), e2 = __builtin_amdgcn_exp2f(lse2 - M);
                    const float inv = __builtin_amdgcn_rcpf(e0 + e1 + e2); scr[32 + r32] = e0 * inv; scr[64 + r32] = e1 * inv; scr[96 + r32] = e2 * inv; } }
            LDS_WAIT();
            float linv[16];
#pragma unroll
            for (int r = 0; r < 16; ++r) linv[r] = scr[crow(r, hh)];
#pragma unroll
            for (int dh = 0; dh < 2; ++dh) {
#pragma unroll
                for (int r = 0; r < 16; ++r) stg[crow(r, hh) * 32 + r32] = (bf16_t)(cvtpk(o[dh][r] * linv[r], 0.f) & 0xffffu);
                LDS_WAIT();
#pragma unroll
                for (int i = 0; i < 2; ++i) { const int row = (lane >> 2) + 16 * i, ch = lane & 3; u32x4 v = *(const LAS u32x4*)(stg + row * 32 + ch * 8);
                    bf16_t* op = O + (rowq0 + (size_t)row * DL) * DM + h * 64 + 32 * dh + ch * 8;
                    if (FINAL) { const u32x4 a0 = *(const u32x4*)op, a1 = *(const u32x4*)(O1 + (rowq0 + (size_t)row * DL) * DM + h * 64 + 32 * dh + ch * 8);
                        const float w0 = scr[32 + row], w1 = scr[64 + row], w2 = scr[96 + row];
#define CMB(c) cvtpk(w0 * bf_lo(a0.c) + w1 * bf_lo(a1.c) + w2 * bf_lo(v.c), w0 * bf_hi(a0.c) + w1 * bf_hi(a1.c) + w2 * bf_hi(v.c))
                        u32x4 w; w.x = CMB(x); w.y = CMB(y); w.z = CMB(z); w.w = CMB(w); v = w;
#undef CMB
                    }
                    *(u32x4*)op = v; }
                LDS_WAIT();
            }
            __syncthreads();
            if (i < 7) { BLK_WRITE(n2 & 1);
#pragma unroll
                for (int dk = 0; dk < 4; ++dk) qf[dk] = qn[dk]; }
            __syncthreads();
        }
    }
#undef BLK_ISSUE
#undef BLK_WRITE
}

#define XB_TMO      128
#define XB_XCNT(j)  (256  + 64 * (j))
#define XB_XSUB(j)  (1280 + 64 * (j))
#define XB_XGEN(j)  (2304 + 64 * (j))
#define XB_TOP      3328
#define XB_TOPGEN   3392
#define XCD_BAR_WORDS 3456
#define XB_SPIN_CAP (1u << 18)

__device__ __forceinline__ unsigned xb_ld(unsigned* p)              { return __hip_atomic_load(p, __ATOMIC_RELAXED, __HIP_MEMORY_SCOPE_AGENT); }
__device__ __forceinline__ unsigned xb_add(unsigned* p, unsigned v) { return __hip_atomic_fetch_add(p, v, __ATOMIC_RELAXED, __HIP_MEMORY_SCOPE_AGENT); }
__device__ __forceinline__ unsigned xb_xcc_id() { return (unsigned)__builtin_amdgcn_s_getreg((3 << 11) | 20) & 0xFu; }
#define XB_SPIN(cond, bar) do { unsigned _sp = 0; while (cond) { __builtin_amdgcn_s_sleep(1); \
    if ((++_sp & 255u) == 0u) { if (xb_ld(&(bar)[XB_TMO])) break; if (_sp > XB_SPIN_CAP) { atomicAdd(&(bar)[XB_TMO], 1u); break; } } } } while (0)

struct XcdBarrier {
    unsigned* bar; unsigned x;
    volatile LAS unsigned* st;
};

__device__ __forceinline__ XcdBarrier xcd_barrier_post(unsigned* bar, volatile LAS unsigned* st) {
    XcdBarrier b; b.bar = bar; b.x = xb_xcc_id(); b.st = st;
    if (threadIdx.x == 0) (void)xb_add(&bar[XB_XCNT(b.x)], 1u);
    return b;
}
__device__ __forceinline__ void xcd_barrier_complete(unsigned* bar, unsigned x, unsigned& nloc, unsigned& nx) {
    const unsigned G = gridDim.x * gridDim.y * gridDim.z;
    unsigned sum, cnt, mine, sp = 0u;
    for (;;) {
        sum = 0u; cnt = 0u; mine = 0u;
#pragma unroll
        for (unsigned j = 0; j < 16; ++j) { const unsigned c = xb_ld(&bar[XB_XCNT(j)]); sum += c; cnt += (c > 0u) ? 1u : 0u; mine = (j == x) ? c : mine; }
        if (sum == G) break;
        __builtin_amdgcn_s_sleep(1);
        if ((++sp & 255u) == 0u) { if (xb_ld(&bar[XB_TMO])) break; if (sp > XB_SPIN_CAP) { atomicAdd(&bar[XB_TMO], 1u); break; } }
    }
    nloc = mine > 0u ? mine : 1u; nx = cnt > 0u ? cnt : 1u;
}

__device__ __forceinline__ void xcd_barrier(const XcdBarrier& b) {
    asm volatile("s_waitcnt vmcnt(0)" ::: "memory");
    __syncthreads();
    if (threadIdx.x == 0) {
        unsigned* bar = b.bar; asm volatile("" : "+s"(bar)); unsigned bx = b.x; asm volatile("" : "+s"(bx));
        __builtin_amdgcn_s_waitcnt(0);
        unsigned nloc = b.st[0], nx = b.st[1];
        if (nloc == 0u) { xcd_barrier_complete(bar, bx, nloc, nx); b.st[0] = nloc; b.st[1] = nx; }
        const unsigned old = xb_add(&bar[XB_XSUB(bx)], 1u);
        const unsigned gen = old / nloc;
        if (old + 1u == (gen + 1u) * nloc) {
            __builtin_amdgcn_fence(__ATOMIC_RELEASE, "agent");
            asm volatile("s_waitcnt vmcnt(0)" ::: "memory");
            const unsigned og = xb_add(&bar[XB_TOP], 1u);
            const unsigned tg = og / nx;
            if (og + 1u == (tg + 1u) * nx) xb_add(&bar[XB_TOPGEN], 1u);
            else XB_SPIN(xb_ld(&bar[XB_TOPGEN]) == tg, bar);
            __builtin_amdgcn_fence(__ATOMIC_ACQUIRE, "agent");
            xb_add(&bar[XB_XGEN(bx)], 1u);
            asm volatile("s_waitcnt vmcnt(0)" ::: "memory");
        } else {
            XB_SPIN(xb_ld(&bar[XB_XGEN(bx)]) == gen, bar);
            __builtin_amdgcn_fence(__ATOMIC_ACQUIRE, "agent");
            asm volatile("s_waitcnt vmcnt(0)" ::: "memory");
        }
    }
    __syncthreads();
}

constexpr int PROBE_BAR = 0;
constexpr int PROBE_DUP = -1;
enum { K_PRO = 0, K_GS, K_GW, K_NR, K_AA, K_AB0, K_AB1, K_AB2 };
__global__ void __launch_bounds__(512, 2) yoco_fwd(Params P) {
    extern __shared__ __attribute__((aligned(16))) unsigned char lds_raw[];
    LAS unsigned char* lds = (LAS unsigned char*)lds_raw;
    cg::grid_group grid = cg::this_grid();
    volatile LAS unsigned* xst = (volatile LAS unsigned*)(lds + LDS_BYTES - 16);
    if (threadIdx.x < 4) xst[threadIdx.x] = 0u;
    __syncthreads();
    XcdBarrier xb = xcd_barrier_post((unsigned*)P.ws, xst);
    grid.sync();
#define PH_BEGIN() int tid = threadIdx.x; asm volatile("" : "+v"(tid)); const int lane = tid & 63, wid = __builtin_amdgcn_readfirstlane(tid >> 6); \
        unsigned char* ws = P.ws; asm volatile("" : "+s"(ws)); (void)lane; (void)wid;
#define BARRIER() do { for (int k_ = 0; k_ < 1 + PROBE_BAR; ++k_) xcd_barrier(xb); } while (0)
#define REPS(ph) for (int rep_ = 0; rep_ < ((PROBE_DUP == (ph)) ? 2 : 1); ++rep_)
#define PH_GS(ph, AOFF, BOFF, N_, K_, OOFF, RSP) { PH_BEGIN(); REPS(ph) { pg8::Gemm g{(const bf16_t*)(ws + (AOFF)), (const bf16_t*)(ws + (BOFF)), MROWS, N_, K_}; pg8::StaticOrder S; S.init(MROWS, N_, (int)gridDim.x, (int)blockIdx.x); \
        pg8::EpiStore E{(bf16_t*)(ws + (OOFF)), N_, RSP}; pg8::gemm_phase<pg8::EpiStore, pg8::StaticOrder, true, true>(lds, g, S, E); } } BARRIER();
#define PH_GW(ph, BOFF) { PH_BEGIN(); REPS(ph) { pg8::Gemm g{(const bf16_t*)(ws + WS_XN), (const bf16_t*)(ws + (BOFF)), MROWS, 2 * DFF, DM}; pg8::StaticOrder S; S.init(MROWS, 2 * DFF, (int)gridDim.x, (int)blockIdx.x); \
        pg8::EpiSwiglu E{(bf16_t*)(ws + WS_ACT), DFF, (const float*)(ws + WS_RS)}; pg8::gemm_phase<pg8::EpiSwiglu, pg8::StaticOrder, true, true>(lds, g, S, E); } } BARRIER();
#define PH_NR(XIN32, OUT32, GI) { PH_BEGIN(); norm_res_phase<XIN32, OUT32>((const bf16_t*)(ws + WS_H), P.gains + (GI) * DM, P.x, (bf16_t*)(ws + WS_XN), (float*)(ws + WS_RS), P.out, lane, wid); }
#define RSV ((const float*)(ws + WS_RS))
#define RS0 ((const float*)nullptr)
    { PH_BEGIN(); REPS(0) { prologue(P, lds, tid, lane, wid); } } BARRIER();
    PH_GS(1, WS_XN, WS_WQKVA, 3072, 1024, WS_QKV, RSV)
    { PH_BEGIN(); REPS(2) { attnA_phase(lds, (const bf16_t*)(ws + WS_QKV), (bf16_t*)(ws + WS_OB), tid, lane, wid); } } BARRIER();
    PH_GS(3, WS_OB, WS_WOA, 1024, 1024, WS_H, RS0)
    PH_NR(true, false, 1) BARRIER();
    PH_GW(5, WS_WGU0)
    PH_GS(6, WS_ACT, WS_WD0, 1024, DFF, WS_H, RS0)
    PH_NR(false, false, 3) BARRIER();
    PH_GS(8, WS_XN, WS_WB, 3072, 1024, WS_QKV, RSV)
    { PH_BEGIN(); REPS(9) { attnB_phase<1, false>(lds, (const bf16_t*)(ws + WS_QKV), (bf16_t*)(ws + WS_OB), (float*)(ws + WS_LSE0), (const float*)(ws + WS_BIAS), nullptr, nullptr, nullptr, tid, lane, wid); } } BARRIER();
    PH_GS(10, WS_XN, WS_WB + 6 * MiB, 3072, 1024, WS_QKV, RSV)
    { PH_BEGIN(); REPS(11) { attnB_phase<4, false>(lds, (const bf16_t*)(ws + WS_QKV), (bf16_t*)(ws + WS_H), (float*)(ws + WS_LSE1), (const float*)(ws + WS_BIAS) + 3072, nullptr, nullptr, nullptr, tid, lane, wid); } } BARRIER();
    PH_GS(12, WS_XN, WS_WB + 12 * MiB, 3072, 1024, WS_QKV, RSV)
    { PH_BEGIN(); attnB_phase<16, true>(lds, (const bf16_t*)(ws + WS_QKV), (bf16_t*)(ws + WS_OB), nullptr, (const float*)(ws + WS_BIAS) + 6144, (const bf16_t*)(ws + WS_H), (const float*)(ws + WS_LSE0), (const float*)(ws + WS_LSE1), tid, lane, wid); } BARRIER();
    PH_GS(14, WS_OB, WS_WOB, 1024, 1024, WS_H, RS0)
    PH_NR(false, false, 5) BARRIER();
    PH_GW(16, WS_WGU1)
    PH_GS(17, WS_ACT, WS_WD1, 1024, DFF, WS_H, RS0)
    PH_NR(false, true, 7)
}

extern "C" void kernel_launch(void* const* d_in, const int* in_sizes, int n_in, void* d_out, int out_size, void* d_ws, size_t ws_size, hipStream_t stream) {
    static int grid = 0;
    if (grid == 0) {
        if (n_in != 11 || out_size != MROWS * DM || ws_size < WS_END) { fprintf(stderr, "kernel_launch: unexpected shapes (n_in %d, out %d, ws %zu)\n", n_in, out_size, ws_size); grid = -1; return; }
        int dev = 0, cus = 0, per_cu = 0;
        (void)hipGetDevice(&dev); (void)hipDeviceGetAttribute(&cus, hipDeviceAttributeMultiprocessorCount, dev);
        if (hipFuncSetAttribute((const void*)yoco_fwd, hipFuncAttributeMaxDynamicSharedMemorySize, LDS_BYTES) != hipSuccess) { fprintf(stderr, "kernel_launch: hipFuncSetAttribute failed\n"); grid = -1; return; }
        if (hipOccupancyMaxActiveBlocksPerMultiprocessor(&per_cu, (const void*)yoco_fwd, 512, LDS_BYTES) != hipSuccess || per_cu < 1) { fprintf(stderr, "kernel_launch: occupancy query failed (%d)\n", per_cu); per_cu = 1; }
        (void)hipGetLastError();
        grid = cus * per_cu;
        if (grid <= 0) grid = 256;
    }
    if (grid < 0) return;
    if (hipMemsetAsync(d_ws, 0, 131072, stream) != hipSuccess) { fprintf(stderr, "kernel_launch: memset failed\n"); return; }
    Params p{};
    p.x = (const float*)d_in[0]; p.gains = (const float*)d_in[1]; p.w_qkv_a = (const float*)d_in[2]; p.w_o_a = (const float*)d_in[3]; p.g_kv = (const float*)d_in[4];
    p.w_kv_b = (const float*)d_in[5]; p.w_q_b = (const float*)d_in[6]; p.w_o_b = (const float*)d_in[7]; p.rel_bias = (const float*)d_in[8]; p.w_gu = (const float*)d_in[9]; p.w_down = (const float*)d_in[10];
    p.out = (float*)d_out; p.ws = (unsigned char*)d_ws;
    void* args[] = {&p};
    const hipError_t e = hipLaunchCooperativeKernel((const void*)yoco_fwd, dim3(grid), dim3(512), args, LDS_BYTES, stream);
    if (e != hipSuccess) fprintf(stderr, "kernel_launch: cooperative launch failed: %s (grid %d)\n", hipGetErrorString(e), grid);
}
```

```cpp
#include <hip/hip_runtime.h>
#include <hip/hip_cooperative_groups.h>
#include <cstdio>
#include <cstdint>
namespace cg = cooperative_groups;
namespace pg8 {
#define PG8_LAS __attribute__((address_space(3)))
typedef unsigned short bf16_t;
typedef short bf16x8 __attribute__((ext_vector_type(8)));
typedef float f32x4 __attribute__((ext_vector_type(4)));
typedef unsigned u32x4 __attribute__((ext_vector_type(4)));
constexpr int BM = 256, BK = 64, HALF = 128, HTB = HALF * BK * 2  , STAGE_BYTES = 8 * HTB, NXCD = 8, WGM = 8;

__host__ __device__ __forceinline__ int lds_byte(int r, int c) { const int st = (r >> 4) * 2 + (c >> 5), rr = r & 15, cc = c & 31, ob = rr * 64 + cc * 2; return st * 1024 + (ob ^ (((ob >> 9) & 1) << 5)); }
__host__ __device__ __forceinline__ void stage_rc(int b, int& R, int& C) { const int st = b / 1024, sb = b % 1024, swz = sb ^ (((sb >> 9) & 1) << 5); R = (st >> 1) * 16 + swz / 64; C = (st & 1) * 32 + (swz % 64) / 2; }
__host__ __device__ __forceinline__ int perm32(int rho) { const int n = rho >> 4, i = rho & 15; return 8 * (i >> 2) + 4 * n + (i & 3); }

struct Unit { int pm, pn; };
struct Gemm { const bf16_t* A; const bf16_t* Bt; int M, N, K; };

struct StaticOrder {
    int nM, nN, nwg, G, c;
    __host__ __device__ void init(int M, int N, int G_, int c_) { nM = M / BM; nN = N / BM; nwg = nM * nN; G = G_; c = c_; }
    __host__ __device__ bool next(int i, Unit& u) const {
        const long L = (long)i * G + c; if (L >= nwg) return false;
        int wgid = (int)L; { const int q = nwg / NXCD, r = nwg % NXCD, xcd = wgid % NXCD, off = wgid / NXCD; wgid = (xcd < r ? xcd * (q + 1) : r * (q + 1) + (xcd - r) * q) + off; }
        const int nig = WGM * nN, gid = wgid / nig, fm = gid * WGM, gsz = (nM - fm) < WGM ? (nM - fm) : WGM;
        u.pm = fm + ((wgid % nig) % gsz); u.pn = (wgid % nig) / gsz; return true;
    }
    __device__ __forceinline__ void a_ready(const Unit&) const {}
    __device__ __forceinline__ void done(const Unit&) const {}
};


typedef float f32x2_t __attribute__((ext_vector_type(2))); typedef __bf16 bf16x2_t __attribute__((ext_vector_type(2)));
__device__ __forceinline__ unsigned cvtpk(float lo, float hi) { f32x2_t v = {lo, hi}; bf16x2_t b = __builtin_convertvector(v, bf16x2_t); return __builtin_bit_cast(unsigned, b); }

struct EpiStore {
    static constexpr bool PERM = true, AFTER_DRAIN = false, FUSED = false;
    bf16_t* O; int ldc; const float* rs;
    __device__ __forceinline__ void operator()(const f32x4 (&acc)[2][2][4][2], const Unit& u, int wr, int wc, int fr, int fq) const {
        const int row0 = u.pm * BM + wr * 64 + fr; const int col0 = u.pn * BM + wc * 32 + 8 * fq;
#pragma unroll
        for (int ai = 0; ai < 2; ++ai)
#pragma unroll
            for (int m = 0; m < 4; ++m) { bf16_t* rowp = O + (size_t)(row0 + ai * HALF + m * 16) * ldc + col0; const float sc = rs ? rs[row0 + ai * HALF + m * 16] : 1.0f;
#pragma unroll
                for (int bj = 0; bj < 2; ++bj) { const f32x4 v0 = acc[ai][bj][m][0] * sc, v1 = acc[ai][bj][m][1] * sc;
                    u32x4 w; w.x = cvtpk(v0[0], v0[1]); w.y = cvtpk(v0[2], v0[3]); w.z = cvtpk(v1[0], v1[1]); w.w = cvtpk(v1[2], v1[3]);
                    *(u32x4*)(rowp + bj * HALF) = w; } }
    }
};
struct EpiSwiglu {
    static constexpr bool PERM = true, AFTER_DRAIN = false, FUSED = false;
    bf16_t* O; int ldc; const float* rs;
    __device__ __forceinline__ float act(float g, float u) const { const float e = __builtin_amdgcn_exp2f(-1.4426950408889634f * g); return g * u * __builtin_amdgcn_rcpf(1.0f + e); }
    __device__ __forceinline__ void operator()(const f32x4 (&acc)[2][2][4][2], const Unit& u, int wr, int wc, int fr, int fq) const {
        const int row0 = u.pm * BM + wr * 64 + fr; const int col0 = u.pn * HALF + wc * 32 + 8 * fq;
#pragma unroll
        for (int ai = 0; ai < 2; ++ai)
#pragma unroll
            for (int m = 0; m < 4; ++m) { bf16_t* rowp = O + (size_t)(row0 + ai * HALF + m * 16) * ldc + col0; const float sc = rs[row0 + ai * HALF + m * 16];
                const f32x4 g0 = acc[ai][0][m][0] * sc, g1 = acc[ai][0][m][1] * sc, u0 = acc[ai][1][m][0] * sc, u1 = acc[ai][1][m][1] * sc;
                u32x4 w; w.x = cvtpk(act(g0[0], u0[0]), act(g0[1], u0[1])); w.y = cvtpk(act(g0[2], u0[2]), act(g0[3], u0[3]));
                w.z = cvtpk(act(g1[0], u1[0]), act(g1[1], u1[1])); w.w = cvtpk(act(g1[2], u1[2]), act(g1[3], u1[3]));
                *(u32x4*)rowp = w; }
    }
};


template <class Epi, class Sched, bool ALIGN_EPI = false, bool SP2 = false>
__device__ __forceinline__ void gemm_phase(PG8_LAS unsigned char* lds, const Gemm g, const Sched& S, const Epi& E) {
    const int tid = threadIdx.x, wid = __builtin_amdgcn_readfirstlane(tid >> 6), lane = tid & 63, wr = wid >> 2, wc = wid & 3, fr = lane & 15, fq = lane >> 4;
    const int K = g.K, nt = K / BK;
    unsigned voffA, voffB;
    { int R, C; stage_rc(tid * 16, R, C); const int Rb = Epi::PERM ? ((R & ~31) + perm32(R & 31)) : R;
        voffA = (unsigned)(R * K + C) * 2u; voffB = (unsigned)(Rb * K + C) * 2u; }
    const size_t rstep = (size_t)64 * K * 2;
    const size_t kstep = (size_t)(BK * 2);
    const size_t hstep = (size_t)HALF * K * 2;
    const size_t tstep = 2 * hstep;
    const unsigned ldsw = (unsigned)wid * 1024u;
    const int aoff = lds_byte(wr * 64 + fr, fq * 8), boff = lds_byte(wc * 32 + fr, fq * 8);
#define PG8_SA(b, h) (((b) * 2 + (h)) * HTB)
#define PG8_SB(b, h) ((4 + (b) * 2 + (h)) * HTB)
#define PG8_STAGE(bufoff, gbase, voff) do { _Pragma("unroll") for (int _i = 0; _i < 2; ++_i) \
        __builtin_amdgcn_global_load_lds((const unsigned*)((const char*)(gbase) + _i * rstep + (voff)), (PG8_LAS unsigned*)(lds + (bufoff) + ldsw + _i * 8192), 16, 0, 0); } while (0)
#define PG8_LDA(dst, b, h) do { _Pragma("unroll") for (int m = 0; m < 4; ++m) _Pragma("unroll") for (int k = 0; k < 2; ++k) dst[m][k] = *(const PG8_LAS bf16x8*)(lds + PG8_SA(b, h) + aoff + m * 2048 + k * 1024); } while (0)
#define PG8_LDB(dst, b, h) do { _Pragma("unroll") for (int n = 0; n < 2; ++n) _Pragma("unroll") for (int k = 0; k < 2; ++k) dst[n][k] = *(const PG8_LAS bf16x8*)(lds + PG8_SB(b, h) + boff + n * 2048 + k * 1024); } while (0)
#define PG8_MMA(ai, bj, At, Bt) do { __builtin_amdgcn_s_setprio(1); _Pragma("unroll") for (int m = 0; m < 4; ++m) _Pragma("unroll") for (int n = 0; n < 2; ++n) _Pragma("unroll") for (int k = 0; k < 2; ++k) \
        acc[ai][bj][m][n] = __builtin_amdgcn_mfma_f32_16x16x32_bf16(Bt[n][k], At[m][k], acc[ai][bj][m][n], 0, 0, 0); __builtin_amdgcn_s_setprio(0); } while (0)
#define PG8_WAIT_V(n) asm volatile("s_waitcnt vmcnt(" #n ")" ::: "memory")
#define PG8_WAIT_L(n) asm volatile("s_waitcnt lgkmcnt(" #n ")" ::: "memory")
#define PG8_BAR __builtin_amdgcn_s_barrier()
#define PG8_SCHED __builtin_amdgcn_sched_barrier(0)
    Unit cur, nxt; int ui = 0;
    if (!S.next(0, cur)) return;
    f32x4 acc[2][2][4][2];
#pragma unroll
    for (int a = 0; a < 2; ++a)
#pragma unroll
        for (int b = 0; b < 2; ++b)
#pragma unroll
            for (int m = 0; m < 4; ++m)
#pragma unroll
                for (int n = 0; n < 2; ++n) acc[a][b][m][n] = (f32x4){0.f, 0.f, 0.f, 0.f};
    bf16x8 At[4][2], B0[2][2], B1[2][2];
    const char* cA = (const char*)g.A + (size_t)cur.pm * tstep; const char* cB = (const char*)g.Bt + (size_t)cur.pn * tstep;
    S.a_ready(cur);
    if constexpr (SP2) {
        PG8_STAGE(PG8_SB(0, 0), cB, voffB); PG8_STAGE(PG8_SB(0, 1), cB + hstep, voffB); PG8_STAGE(PG8_SA(0, 0), cA, voffA); PG8_STAGE(PG8_SA(0, 1), cA + hstep, voffA);
        if (wr == 1) PG8_BAR;
        PG8_WAIT_V(2); PG8_BAR;
        PG8_STAGE(PG8_SB(1, 0), cB + kstep, voffB); PG8_STAGE(PG8_SA(1, 0), cA + kstep, voffA); PG8_STAGE(PG8_SB(1, 1), cB + hstep + kstep, voffB);
        PG8_WAIT_V(6); PG8_BAR;
    } else {
        PG8_STAGE(PG8_SB(0, 0), cB, voffB); PG8_STAGE(PG8_SA(0, 0), cA, voffA); PG8_STAGE(PG8_SB(0, 1), cB + hstep, voffB); PG8_STAGE(PG8_SA(0, 1), cA + hstep, voffA);
        if (wr == 1) PG8_BAR;
        PG8_WAIT_V(4); PG8_BAR;
        PG8_STAGE(PG8_SB(1, 0), cB + kstep, voffB); PG8_STAGE(PG8_SA(1, 0), cA + kstep, voffA); PG8_STAGE(PG8_SB(1, 1), cB + hstep + kstep, voffB);
        PG8_WAIT_V(6); PG8_BAR;
    }
    for (;;) {
        const bool has_next = S.next(ui + 1, nxt);
        const char* nA = has_next ? (const char*)g.A + (size_t)nxt.pm * tstep : cA; const char* nB = has_next ? (const char*)g.Bt + (size_t)nxt.pn * tstep : cB;
        for (int t = 0; t < nt; t += 2) {
            const bool last = (t == nt - 2);
            const char* a1 = cA + (size_t)(t + 1) * kstep;
            const char* a2 = last ? nA : cA + (size_t)(t + 2) * kstep; const char* b2 = last ? nB : cB + (size_t)(t + 2) * kstep;
            const char* a3 = a2 + kstep; const char* b3 = b2 + kstep;
            if (last && has_next) S.a_ready(nxt);
            if constexpr (SP2) {
            PG8_LDB(B0, 0, 0); PG8_LDB(B1, 0, 1); PG8_SCHED; PG8_LDA(At, 0, 0); PG8_STAGE(PG8_SA(1, 1), a1 + hstep, voffA);
            PG8_WAIT_V(8); PG8_WAIT_L(0); PG8_BAR; PG8_MMA(0, 0, At, B0); PG8_MMA(0, 1, At, B1); PG8_BAR; PG8_SCHED;
            PG8_LDA(At, 0, 1); PG8_STAGE(PG8_SB(0, 0), b2, voffB); PG8_STAGE(PG8_SB(0, 1), b2 + hstep, voffB); PG8_STAGE(PG8_SA(0, 0), a2, voffA);
            PG8_WAIT_V(8); PG8_WAIT_L(0); PG8_BAR; PG8_MMA(1, 0, At, B0); PG8_MMA(1, 1, At, B1); PG8_BAR; PG8_SCHED;
            PG8_LDB(B0, 1, 0); PG8_LDB(B1, 1, 1); PG8_SCHED; PG8_LDA(At, 1, 0); PG8_STAGE(PG8_SA(0, 1), a2 + hstep, voffA);
            PG8_WAIT_V(8); PG8_WAIT_L(0); PG8_BAR; PG8_MMA(0, 0, At, B0); PG8_MMA(0, 1, At, B1); PG8_BAR; PG8_SCHED;
            PG8_LDA(At, 1, 1); PG8_STAGE(PG8_SB(1, 0), b3, voffB); PG8_STAGE(PG8_SB(1, 1), b3 + hstep, voffB); PG8_STAGE(PG8_SA(1, 0), a3, voffA);
            PG8_WAIT_V(8); PG8_WAIT_L(0); PG8_BAR; PG8_MMA(1, 0, At, B0); PG8_MMA(1, 1, At, B1); PG8_BAR; PG8_SCHED;
            } else {
            PG8_LDB(B0, 0, 0); PG8_SCHED; PG8_LDA(At, 0, 0); PG8_STAGE(PG8_SA(1, 1), a1 + hstep, voffA);
            PG8_WAIT_L(8); PG8_BAR; PG8_WAIT_L(0); PG8_MMA(0, 0, At, B0); PG8_BAR; PG8_SCHED;
            PG8_LDB(B1, 0, 1); PG8_STAGE(PG8_SB(0, 0), b2, voffB);
            PG8_BAR; PG8_WAIT_L(0); PG8_MMA(0, 1, At, B1); PG8_BAR;
            PG8_LDA(At, 0, 1); PG8_STAGE(PG8_SA(0, 0), a2, voffA);
            PG8_BAR; PG8_WAIT_L(0); PG8_MMA(1, 0, At, B0); PG8_BAR; PG8_SCHED;
            PG8_STAGE(PG8_SB(0, 1), b2 + hstep, voffB);
            PG8_WAIT_V(6); PG8_BAR; PG8_MMA(1, 1, At, B1); PG8_BAR;
            PG8_LDB(B0, 1, 0); PG8_SCHED; PG8_LDA(At, 1, 0); PG8_STAGE(PG8_SA(0, 1), a2 + hstep, voffA);
            PG8_WAIT_L(8); PG8_BAR; PG8_WAIT_L(0); PG8_MMA(0, 0, At, B0); PG8_BAR; PG8_SCHED;
            PG8_LDB(B1, 1, 1); PG8_STAGE(PG8_SB(1, 0), b3, voffB);
            PG8_BAR; PG8_WAIT_L(0); PG8_MMA(0, 1, At, B1); PG8_BAR;
            PG8_LDA(At, 1, 1); PG8_STAGE(PG8_SA(1, 0), a3, voffA);
            PG8_BAR; PG8_WAIT_L(0); PG8_MMA(1, 0, At, B0); PG8_BAR; PG8_SCHED;
            PG8_STAGE(PG8_SB(1, 1), b3 + hstep, voffB);
            PG8_WAIT_V(6); PG8_BAR; PG8_MMA(1, 1, At, B1); PG8_BAR;
            }
        }
        if constexpr (ALIGN_EPI) { if (wr == 0) PG8_BAR; }
        if constexpr (Epi::FUSED) { E.fused(acc, cur, wr, wc, fr, fq, lds + STAGE_BYTES, wid, lane); } else
        if constexpr (!Epi::AFTER_DRAIN) { E(acc, cur, wr, wc, fr, fq); S.done(cur); }
        if (!has_next) break;
#pragma unroll
        for (int a = 0; a < 2; ++a)
#pragma unroll
            for (int b = 0; b < 2; ++b)
#pragma unroll
                for (int m = 0; m < 4; ++m)
#pragma unroll
                    for (int n = 0; n < 2; ++n) acc[a][b][m][n] = (f32x4){0.f, 0.f, 0.f, 0.f};
        cur = nxt; cA = nA; cB = nB; ++ui;
        if constexpr (ALIGN_EPI) { if (wr == 1) PG8_BAR; }
    }
    PG8_WAIT_V(0);
    if constexpr (!ALIGN_EPI) { if (wr == 0) PG8_BAR; }
    PG8_BAR;
    if constexpr (Epi::AFTER_DRAIN) { E.fused(acc, cur, wr, wc, fr, fq, lds, wid, lane); S.done(cur); }
#undef PG8_SA
#undef PG8_SB
#undef PG8_STAGE
#undef PG8_LDA
#undef PG8_LDB
#undef PG8_MMA
#undef PG8_WAIT_V
#undef PG8_WAIT_L
#undef PG8_BAR
#undef PG8_SCHED
}
}

#define LAS __attribute__((address_space(3)))
typedef pg8::bf16_t bf16_t; typedef pg8::bf16x8 bf16x8; typedef pg8::f32x4 f32x4; typedef pg8::u32x4 u32x4;
typedef float f32x16 __attribute__((ext_vector_type(16)));
typedef unsigned u32x2 __attribute__((ext_vector_type(2)));
typedef short v4i16_t __attribute__((ext_vector_type(4)));
using pg8::cvtpk;

constexpr int BATCH = 16, SEQ = 2048, DM = 1024, NH = 16, HD = 64, DFF = 2816, MROWS = BATCH * SEQ;
constexpr float RMS_EPS = 1e-6f;
constexpr float LOG2E = 1.4426950408889634f;
constexpr float QSCALE = 0.125f * LOG2E;
constexpr size_t MiB = 1u << 20;
constexpr size_t WS_CNT = 16384  , WS_SLOT = 63 * MiB + 65536  ;
constexpr size_t WS_WQKVA = 1 * MiB, WS_WOA = 7 * MiB, WS_WGU0 = 9 * MiB, WS_WD0 = 20 * MiB, WS_WB = 26 * MiB  , WS_WOB = 44 * MiB,
                 WS_WGU1 = 46 * MiB, WS_WD1 = 57 * MiB, WS_BIAS = 63 * MiB, WS_XN = 65 * MiB, WS_QKV = 129 * MiB, WS_ACT = 129 * MiB  ,
                 WS_OB = 321 * MiB, WS_H = 385 * MiB, WS_LSE0 = 449 * MiB, WS_LSE1 = 451 * MiB, WS_RS = 453 * MiB  , WS_END = 454 * MiB;
constexpr int LDS_BYTES = 155648;

struct Params { const float *x, *gains, *w_qkv_a, *w_o_a, *g_kv, *w_kv_b, *w_q_b, *w_o_b, *rel_bias, *w_gu, *w_down; float* out; unsigned char* ws; };

#define LDS_WAIT() asm volatile("s_waitcnt lgkmcnt(0)" ::: "memory")
__device__ __forceinline__ float wave_sum(float v) {
#pragma unroll
    for (int o = 1; o < 64; o <<= 1) v += __shfl_xor(v, o);
    return v;
}
__device__ __forceinline__ int crow(int r, int hi) { return (r & 3) + 8 * (r >> 2) + 4 * hi; }
__device__ __forceinline__ float bf_lo(unsigned w) { return __uint_as_float(w << 16); }
__device__ __forceinline__ float bf_hi(unsigned w) { return __uint_as_float(w & 0xffff0000u); }

__device__ __forceinline__ void conv_item(const float* __restrict__ W, int ldw, int col, int K, const float* __restrict__ gain, float scale, bf16_t* WT, int drow, LAS float* scr, int kb, int lane) {
    const int k0 = 64 * kb, ks = lane >> 3, n4 = lane & 7;
    f32x4 v[8]; float gs[8];
#pragma unroll
    for (int i = 0; i < 8; ++i) { const int kk = 8 * i + ks; v[i] = *(const f32x4*)(W + (size_t)(k0 + kk) * ldw + col + 4 * n4); gs[i] = gain ? gain[k0 + kk] * scale : scale; }
#pragma unroll
    for (int i = 0; i < 8; ++i) { const int kk = 8 * i + ks; LAS float* d = scr + kk * 33 + 4 * n4; d[0] = v[i].x * gs[i]; d[1] = v[i].y * gs[i]; d[2] = v[i].z * gs[i]; d[3] = v[i].w * gs[i]; }
    LDS_WAIT();
    const int c = lane & 7;
#pragma unroll
    for (int j = 0; j < 4; ++j) { const int n = (lane >> 3) + 8 * j; const LAS float* s = scr + (8 * c) * 33 + n;
        u32x4 o; o.x = cvtpk(s[0 * 33], s[1 * 33]); o.y = cvtpk(s[2 * 33], s[3 * 33]); o.z = cvtpk(s[4 * 33], s[5 * 33]); o.w = cvtpk(s[6 * 33], s[7 * 33]);
        *(u32x4*)(WT + (size_t)(drow + n) * K + k0 + 8 * c) = o; }
    LDS_WAIT();
}
template <int MODE> __device__ __forceinline__ void conv_seg(const float* src, int ld, int col0, int ncols, int K, const float* gain, float scale, bf16_t* dst, int drow0,
                                                             LAS float* scr, int gw, int NGW, int& off, int lane) {
    const int nblk = ncols >> 5, items = nblk * (K >> 6);
    int it0 = gw - (off % NGW); if (it0 < 0) it0 += NGW; off += items;
    for (int it = it0; it < items; it += NGW) {
        const int kb = it / nblk, nb = it - kb * nblk, c = 32 * nb; int drow;
        if (MODE == 1) { const int upf = c >= DFF ? 1 : 0, cc = c - upf * DFF; drow = 256 * (cc >> 7) + 128 * upf + (cc & 127); } else drow = drow0 + c;
        conv_item(src, ld, col0 + c, K, gain, scale, dst, drow, scr, kb, lane);
    }
}
__device__ __forceinline__ void norm_row_bf16(const float* xrow, bf16_t* orow, float* rs, int lane) {
    const f32x4* xr = (const f32x4*)xrow + lane;
    f32x4 v[4]; float s = 0.f;
#pragma unroll
    for (int j = 0; j < 4; ++j) { v[j] = xr[64 * j]; s += (v[j].x * v[j].x + v[j].y * v[j].y) + (v[j].z * v[j].z + v[j].w * v[j].w); }
    const float r = 1.0f / sqrtf(wave_sum(s) * (1.f / DM) + RMS_EPS);
    if (lane == 0) *rs = r;
    u32x2* o8 = (u32x2*)orow + lane;
#pragma unroll
    for (int j = 0; j < 4; ++j) { u32x2 w; w.x = cvtpk(v[j].x, v[j].y); w.y = cvtpk(v[j].z, v[j].w); o8[64 * j] = w; }
}
__device__ __forceinline__ void prologue(const Params& P, LAS unsigned char* lds, int tid, int lane, int wave) {
    LAS float* scr = (LAS float*)(lds + wave * 16384);
    const int G = gridDim.x, gw = blockIdx.x * 8 + wave, NGW = G * 8;
    unsigned char* ws = P.ws; int off = 0;
    const float* g00 = P.gains + 0 * DM; const float* g02 = P.gains + 2 * DM; const float* g10 = P.gains + 4 * DM; const float* g12 = P.gains + 6 * DM;
    conv_seg<0>(P.w_qkv_a, 3072, 0, 1024, 1024, g00, QSCALE, (bf16_t*)(ws + WS_WQKVA), 0, scr, gw, NGW, off, lane);
    conv_seg<0>(P.w_qkv_a, 3072, 1024, 2048, 1024, g00, 1.0f, (bf16_t*)(ws + WS_WQKVA), 1024, scr, gw, NGW, off, lane);
    conv_seg<0>(P.w_o_a, 1024, 0, 1024, 1024, nullptr, 1.0f, (bf16_t*)(ws + WS_WOA), 0, scr, gw, NGW, off, lane);
    conv_seg<1>(P.w_gu, 2 * DFF, 0, 2 * DFF, 1024, g02, 1.0f, (bf16_t*)(ws + WS_WGU0), 0, scr, gw, NGW, off, lane);
    conv_seg<0>(P.w_down, 1024, 0, 1024, DFF, nullptr, 1.0f, (bf16_t*)(ws + WS_WD0), 0, scr, gw, NGW, off, lane);
    for (int g = 0; g < 3; ++g) {
        bf16_t* wb = (bf16_t*)(ws + WS_WB + (size_t)g * 6 * MiB);
        conv_seg<0>(P.w_q_b, 3072, 1024 * g, 1024, 1024, g10, QSCALE, wb, 0, scr, gw, NGW, off, lane);
        conv_seg<0>(P.w_kv_b, 6144, 2048 * g, 2048, 1024, P.g_kv, 1.0f, wb, 1024, scr, gw, NGW, off, lane);
    }
    conv_seg<0>(P.w_o_b, 1024, 0, 1024, 1024, nullptr, 1.0f, (bf16_t*)(ws + WS_WOB), 0, scr, gw, NGW, off, lane);
    conv_seg<1>(P.w_gu + (size_t)DM * 2 * DFF, 2 * DFF, 0, 2 * DFF, 1024, g12, 1.0f, (bf16_t*)(ws + WS_WGU1), 0, scr, gw, NGW, off, lane);
    conv_seg<0>(P.w_down + (size_t)DFF * DM, 1024, 0, 1024, DFF, nullptr, 1.0f, (bf16_t*)(ws + WS_WD1), 0, scr, gw, NGW, off, lane);
    bf16_t* XN = (bf16_t*)(ws + WS_XN);
    for (int m = gw; m < MROWS; m += NGW) norm_row_bf16(P.x + (size_t)m * DM, XN + (size_t)m * DM, (float*)(ws + WS_RS) + m, lane);
    float* BT = (float*)(ws + WS_BIAS);
    for (int idx = blockIdx.x * 512 + tid; idx < 3 * 16 * 192; idx += G * 512) {
        const int g = idx / 3072, rem = idx - g * 3072, h = rem / 192, e = rem - h * 192, rel = e - 32; float v = 0.f;
        if (rel >= 0 && rel <= 128) { const int dl = (g == 0) ? 1 : ((g == 1) ? 4 : 16); const int n = rel * dl; int bk;
            if (n < 16) bk = n;
            else { bk = 16 + (n >= 22) + (n >= 30) + (n >= 40) + (n >= 54) + (n >= 73) + (n >= 99) + (n >= 134) + (n >= 182) + (n >= 246) + (n >= 332) + (n >= 450) + (n >= 609) + (n >= 825) + (n >= 1117) + (n >= 1513); }
            v = P.rel_bias[bk * 16 + h] * LOG2E; }
        BT[idx] = v;
    }
}

template <bool XIN32, bool OUT32> __device__ __forceinline__ void norm_res_phase(const bf16_t* H, const float* gain, const float* Xin32, bf16_t* XB, float* RS, float* Out32, int lane, int wave) {
    const int gw = blockIdx.x * 8 + wave, NGW = gridDim.x * 8;
    f32x4 gv[4];
#pragma unroll
    for (int j = 0; j < 4; ++j) gv[j] = *((const f32x4*)gain + lane + 64 * j);
    for (int m = gw; m < MROWS; m += NGW) {
        const u32x2* hp = (const u32x2*)(H + (size_t)m * DM) + lane;
        f32x4 hv[4], xv[4]; float ss = 0.f;
#pragma unroll
        for (int j = 0; j < 4; ++j) { const u32x2 w = hp[64 * j]; hv[j] = (f32x4){bf_lo(w.x), bf_hi(w.x), bf_lo(w.y), bf_hi(w.y)};
            if (XIN32) xv[j] = *((const f32x4*)(Xin32 + (size_t)m * DM) + lane + 64 * j);
            else { const u32x2 xw = *((const u32x2*)(XB + (size_t)m * DM) + lane + 64 * j); xv[j] = (f32x4){bf_lo(xw.x), bf_hi(xw.x), bf_lo(xw.y), bf_hi(xw.y)}; }
            ss += (hv[j].x * hv[j].x + hv[j].y * hv[j].y) + (hv[j].z * hv[j].z + hv[j].w * hv[j].w); }
        const float r = 1.0f / sqrtf(wave_sum(ss) * (1.f / DM) + RMS_EPS);
        float s2 = 0.f;
#pragma unroll
        for (int j = 0; j < 4; ++j) { xv[j] = xv[j] + hv[j] * r * gv[j];
            s2 += (xv[j].x * xv[j].x + xv[j].y * xv[j].y) + (xv[j].z * xv[j].z + xv[j].w * xv[j].w); }
        if (OUT32) { f32x4* op = (f32x4*)(Out32 + (size_t)m * DM) + lane;
#pragma unroll
            for (int j = 0; j < 4; ++j) op[64 * j] = xv[j]; }
        else { const float r2 = 1.0f / sqrtf(wave_sum(s2) * (1.f / DM) + RMS_EPS); if (lane == 0) RS[m] = r2; u32x2* o8 = (u32x2*)(XB + (size_t)m * DM) + lane;
#pragma unroll
            for (int j = 0; j < 4; ++j) { u32x2 w; w.x = cvtpk(xv[j].x, xv[j].y); w.y = cvtpk(xv[j].z, xv[j].w); o8[64 * j] = w; } }
    }
}

__device__ __forceinline__ bf16x8 vfrag(const LAS unsigned char* p) {
    const v4i16_t lo = __builtin_amdgcn_ds_read_tr16_b64_v4i16((LAS v4i16_t*)p);
    const v4i16_t hi = __builtin_amdgcn_ds_read_tr16_b64_v4i16((LAS v4i16_t*)(p + 512));
    return (bf16x8){lo[0], lo[1], lo[2], lo[3], hi[0], hi[1], hi[2], hi[3]};
}
__device__ __forceinline__ bf16x8 pack8(const float* a) {
    u32x4 w; w.x = cvtpk(a[0], a[1]); w.y = cvtpk(a[2], a[3]); w.z = cvtpk(a[4], a[5]); w.w = cvtpk(a[6], a[7]); return __builtin_bit_cast(bf16x8, w);
}

template <bool MASK> __device__ __forceinline__ void sb_subtile(const LAS unsigned char* kbuf, const LAS unsigned char* vbuf  , int sub, const bf16x8 (&qf)[4], const int (&kaddr)[4],
                                                                float& carry, f32x16 (&o)[2], int r32, int hh) {
    f32x16 S = {};
#pragma unroll
    for (int dk = 0; dk < 4; ++dk) { const bf16x8 kf = *(const LAS bf16x8*)(kbuf + kaddr[dk] + sub * 512); S = __builtin_amdgcn_mfma_f32_32x32x16_bf16(kf, qf[dk], S, 0, 0, 0); }
    float p[16];
#pragma unroll
    for (int r = 0; r < 16; ++r) { const float u = __builtin_amdgcn_exp2f(S[r]); float wv = __builtin_amdgcn_rcpf(1.0f + u);
        if (MASK) wv = (crow(r, hh) < r32) ? wv : 1.0f; p[r] = wv; }
    float go[4], t[4];
#pragma unroll
    for (int i = 0; i < 4; ++i) { p[4 * i + 2] *= p[4 * i + 3]; p[4 * i + 1] *= p[4 * i + 2]; p[4 * i] *= p[4 * i + 1];
        const auto rr = __builtin_amdgcn_permlane32_swap(__float_as_uint(p[4 * i]), __float_as_uint(p[4 * i]), false, false);
        go[i] = __uint_as_float(rr[1]); t[i] = __uint_as_float(rr[0]) * __uint_as_float(rr[1]); }
    const float R2 = t[3], R1 = t[3] * t[2], R0 = R1 * t[1];
    float E[4];
    E[3] = carry * (hh ? 1.0f : go[3]); E[2] = carry * R2 * (hh ? 1.0f : go[2]); E[1] = carry * R1 * (hh ? 1.0f : go[1]); E[0] = carry * R0 * (hh ? 1.0f : go[0]);
    carry = carry * R0 * t[0];
    float A[16];
#pragma unroll
    for (int i = 0; i < 4; ++i) { const float I3 = E[i] * p[4 * i + 3], I2 = E[i] * p[4 * i + 2], I1 = E[i] * p[4 * i + 1], I0 = E[i] * p[4 * i];
        A[4 * i + 3] = E[i] - I3; A[4 * i + 2] = I3 - I2; A[4 * i + 1] = I2 - I1; A[4 * i] = I1 - I0; }
    const bf16x8 pf0 = pack8(A), pf1 = pack8(A + 8);
#pragma unroll
    for (int dh = 0; dh < 2; ++dh) {
        const bf16x8 v0 = vfrag(vbuf + dh * 4096 + (32 * sub) * 64), v1 = vfrag(vbuf + dh * 4096 + (32 * sub + 16) * 64);
        o[dh] = __builtin_amdgcn_mfma_f32_32x32x16_bf16(pf0, v0, o[dh], 0, 0, 0);
        o[dh] = __builtin_amdgcn_mfma_f32_32x32x16_bf16(pf1, v1, o[dh], 0, 0, 0);
    }
}

__device__ __forceinline__ void attnA_phase(LAS unsigned char* lds, const bf16_t* __restrict__ QKV, bf16_t* __restrict__ O, int tid, int lane, int wid) {
    const int r32 = lane & 31, hh = lane >> 5;
    int kaddr[4];
#pragma unroll
    for (int dk = 0; dk < 4; ++dk) { const int c = 2 * dk + hh; kaddr[dk] = c * 1024 + ((r32 ^ c) << 4); }
    const int vlane = (4 * hh + ((lane & 15) >> 2)) * 64 + ((lane >> 4) & 1) * 32 + (lane & 3) * 8;
    LAS unsigned* flags = (LAS unsigned*)(lds + 32768);
    const int lkey = tid >> 3, lc = tid & 7;
    const int kwoff = lc * 1024 + ((lkey ^ lc) << 4), vwoff = 16384 + (lc >> 2) * 4096 + lkey * 64 + (lc & 3) * 16;
    for (int u = blockIdx.x; u < BATCH * NH * 8; u += gridDim.x) {
        const int bh = u >> 3, qb = ((u & 7) + (u >> 8)) & 7, b = bh >> 4, h = bh & 15;
        const size_t rowbase = (size_t)b * SEQ; const int q0 = qb * 256, R0 = q0 + 32 * wid;
        bf16x8 qf[4];
        { const bf16_t* qp = QKV + (rowbase + R0 + r32) * 3072 + h * 64 + 8 * hh;
#pragma unroll
          for (int dk = 0; dk < 4; ++dk) qf[dk] = *(const bf16x8*)(qp + 16 * dk); }
        const bf16_t* kvg = QKV + (rowbase + lkey) * 3072 + 1024 + h * 64 + 8 * lc;
        const int NT = 4 * qb + 4;
        { const bf16_t* kg = kvg + (size_t)(64 * (NT - 1)) * 3072; const u32x4 kr = *(const u32x4*)kg, vr = *(const u32x4*)(kg + 1024);
          *(LAS u32x4*)(lds + kwoff) = kr; *(LAS u32x4*)(lds + vwoff) = vr; }
        __syncthreads();
        float carry = 1.0f; f32x16 o[2]; o[0] = f32x16{}; o[1] = f32x16{};
        int cur = 0;
        for (int kt = NT - 1; kt >= 0; --kt) {
            u32x4 kr, vr;
            if (kt > 0) { const bf16_t* kg = kvg + (size_t)(64 * (kt - 1)) * 3072; kr = *(const u32x4*)kg; vr = *(const u32x4*)(kg + 1024); }
            const int diff = R0 - 64 * kt;
            const LAS unsigned char* kbuf = lds + cur * 8192; const LAS unsigned char* vbuf = lds + 16384 + cur * 8192 + vlane;
            bool walive = __any(carry >= 1.17549435e-38f);
            if (walive) {
            if (diff >= 64) { sb_subtile<false>(kbuf, vbuf, 1, qf, kaddr, carry, o, r32, hh); sb_subtile<false>(kbuf, vbuf, 0, qf, kaddr, carry, o, r32, hh); }
            else if (diff == 32) { sb_subtile<true>(kbuf, vbuf, 1, qf, kaddr, carry, o, r32, hh); sb_subtile<false>(kbuf, vbuf, 0, qf, kaddr, carry, o, r32, hh); }
            else if (diff == 0) { sb_subtile<true>(kbuf, vbuf, 0, qf, kaddr, carry, o, r32, hh); }
            walive = __any(carry >= 1.17549435e-38f); }
            if (kt > 0) { *(LAS u32x4*)(lds + (cur ^ 1) * 8192 + kwoff) = kr; *(LAS u32x4*)(lds + (cur ^ 1) * 8192 + vwoff) = vr; }
            if (lane == 0) flags[cur * 8 + wid] = walive ? 1u : 0u;
            __syncthreads();
            const u32x4 f0 = *(const LAS u32x4*)(flags + cur * 8), f1 = *(const LAS u32x4*)(flags + cur * 8 + 4);
            cur ^= 1;
            if (((f0.x | f0.y) | (f0.z | f0.w) | (f1.x | f1.y) | (f1.z | f1.w)) == 0u) break;
        }
        { LAS bf16_t* stg = (LAS bf16_t*)(lds + 36864 + wid * 4096);
#pragma unroll
          for (int r = 0; r < 16; ++r) { const int qq = crow(r, hh);
#pragma unroll
              for (int dh = 0; dh < 2; ++dh) stg[qq * 64 + 32 * dh + r32] = (bf16_t)(cvtpk(o[dh][r], 0.f) & 0xffffu); }
          LDS_WAIT();
          bf16_t* op = O + (rowbase + R0) * DM + h * 64;
#pragma unroll
          for (int i = 0; i < 4; ++i) { const int row = (lane >> 3) + 8 * i, ch = lane & 7; const u32x4 v = *(const LAS u32x4*)(stg + row * 64 + ch * 8); *(u32x4*)(op + (size_t)row * DM + ch * 8) = v; }
          LDS_WAIT(); }
    }
}

template <int DL, bool FINAL> __device__ __forceinline__ void attnB_phase(LAS unsigned char* lds, const bf16_t* __restrict__ QKV, bf16_t* O, float* lse_out, const float* __restrict__ BT,
                                                                          const bf16_t* O1, const float* lse0, const float* lse1, int tid, int lane, int wid) {
    constexpr int NB = 16 / DL;
    const int r32 = lane & 31, hh = lane >> 5, half = wid >> 2, wq = wid & 3, ht = tid & 255;
    LAS unsigned char* hb = lds + half * 65536;
    LAS float* bl = (LAS float*)(lds + 131072 + half * 768);
    LAS float* scr = (LAS float*)(lds + 131072 + 1536 + wid * 512);
    LAS bf16_t* stg = (LAS bf16_t*)(lds + 131072 + 1536 + 4096 + wid * 2048);
    int kaddr[4];
#pragma unroll
    for (int dk = 0; dk < 4; ++dk) { const int c = 2 * dk + hh; kaddr[dk] = c * 2048 + ((r32 ^ c) << 4); }
    const int vlane = 16384 + (4 * hh + ((lane & 15) >> 2)) * 64 + ((lane >> 4) & 1) * 32 + (lane & 3) * 8;
    const int key_in = ht >> 3, c8 = ht & 7;
    const int kwo = c8 * 2048 + ((key_in ^ c8) << 4), vwo = 16384 + (c8 >> 2) * 8192 + key_in * 64 + (c8 & 3) * 16;
#define BLK_ISSUE(nblk, rres) do { _Pragma("unroll") for (int i_ = 0; i_ < 4; ++i_) { const bf16_t* kg_ = kvbase + (size_t)(((nblk) * 128 + 32 * i_ + key_in) * DL + (rres)) * 3072; \
        kr[i_] = *(const u32x4*)kg_; vr[i_] = *(const u32x4*)(kg_ + 1024); } } while (0)
#define BLK_WRITE(slot) do { _Pragma("unroll") for (int i_ = 0; i_ < 4; ++i_) { *(LAS u32x4*)(hb + (slot) * 32768 + kwo + 512 * i_) = kr[i_]; *(LAS u32x4*)(hb + (slot) * 32768 + vwo + 2048 * i_) = vr[i_]; } } while (0)
    for (int hidx = blockIdx.x; hidx < BATCH * NH; hidx += gridDim.x) {
        const int ub = (2 * hidx + half) * 8, bh = ub >> 4, b = bh >> 4, h = bh & 15;
        const bf16_t* kvbase = QKV + (size_t)b * SEQ * 3072 + 1024 + h * 64 + 8 * c8;
        const bf16_t* qbase = QKV + (size_t)b * SEQ * 3072 + h * 64 + 8 * hh;
        u32x4 kr[4], vr[4]; bf16x8 qf[4];
        __syncthreads();
        { const int cc = ub & 15, rr = cc / NB, n = cc % NB;
          BLK_ISSUE(n, rr); BLK_WRITE(n & 1);
          if (n > 0) { BLK_ISSUE(n - 1, rr); BLK_WRITE((n - 1) & 1); }
          if (ht < 192) bl[ht] = BT[h * 192 + ht];
          const bf16_t* qp = qbase + (size_t)((n * 128 + 32 * wq + r32) * DL + rr) * 3072;
#pragma unroll
          for (int dk = 0; dk < 4; ++dk) qf[dk] = *(const bf16x8*)(qp + 16 * dk); }
        __syncthreads();
        for (int i = 0; i < 8; ++i) {
            const int cc = (ub + i) & 15, rr = cc / NB, n = cc % NB;
            bf16x8 qn[4]; int n2 = 0;
            if (i < 7) { const int cc2 = (ub + i + 1) & 15, rr2 = cc2 / NB; n2 = cc2 % NB; BLK_ISSUE(n2, rr2);
                const bf16_t* qp = qbase + (size_t)((n2 * 128 + 32 * wq + r32) * DL + rr2) * 3072;
#pragma unroll
                for (int dk = 0; dk < 4; ++dk) qn[dk] = *(const bf16x8*)(qp + 16 * dk); }
            const int jstart = (n == 0) ? (4 - wq) : 0;
            const int par = (n - 1) & 1;
            const LAS float* blp = bl + 160 + r32 - 4 * hh;
            float mx = -INFINITY, l = 0.f; f32x16 o[2]; o[0] = f32x16{}; o[1] = f32x16{};
#pragma unroll
            for (int jj = 0; jj < 5; ++jj) {
                if (jj >= jstart) {
                    const int j = wq + jj; const LAS unsigned char* kb = hb + (par ^ (j >> 2)) * 32768 + (j & 3) * 512;
                    f32x16 s = {};
#pragma unroll
                    for (int dk = 0; dk < 4; ++dk) { const bf16x8 kf = *(const LAS bf16x8*)(kb + kaddr[dk]); s = __builtin_amdgcn_mfma_f32_32x32x16_bf16(kf, qf[dk], s, 0, 0, 0); }
                    float rm = -INFINITY;
#pragma unroll
                    for (int r = 0; r < 16; ++r) { const int kk = crow(r, hh); float v = s[r] + blp[-(32 * jj + (r & 3) + 8 * (r >> 2))];
                        if (jj == 0) v = (kk >= r32) ? v : -INFINITY;
                        if (jj == 4) v = (kk <= r32) ? v : -INFINITY;
                        s[r] = v; rm = fmaxf(rm, v); }
                    rm = fmaxf(rm, __shfl_xor(rm, 32));
                    const bool up = rm > mx + 8.0f;
                    if (__any(up)) {
                        const float mnew = up ? rm : mx; const float f = __builtin_amdgcn_exp2f(mx - mnew); l *= f; mx = mnew;
                        if (hh == 0) scr[r32] = f;
                        LDS_WAIT();
#pragma unroll
                        for (int r = 0; r < 16; ++r) { const float fr = scr[crow(r, hh)]; o[0][r] *= fr; o[1][r] *= fr; }
                        LDS_WAIT();
                    }
                    float pe[16];
#pragma unroll
                    for (int r = 0; r < 16; ++r) { pe[r] = __builtin_amdgcn_exp2f(s[r] - mx); l += pe[r]; }
                    const bf16x8 pf0 = pack8(pe), pf1 = pack8(pe + 8);
                    const LAS unsigned char* vb = hb + (par ^ (j >> 2)) * 32768 + (j & 3) * 2048 + vlane;
#pragma unroll
                    for (int dh = 0; dh < 2; ++dh) {
                        const bf16x8 v0 = vfrag(vb + dh * 8192), v1 = vfrag(vb + dh * 8192 + 16 * 64);
                        o[dh] = __builtin_amdgcn_mfma_f32_32x32x16_bf16(pf0, v0, o[dh], 0, 0, 0);
                        o[dh] = __builtin_amdgcn_mfma_f32_32x32x16_bf16(pf1, v1, o[dh], 0, 0, 0);
                    }
                }
            }
            l += __shfl_xor(l, 32);
            const float lse2 = mx + __builtin_amdgcn_logf(l);
            const size_t rowq0 = (size_t)b * SEQ + (size_t)((n * 128 + 32 * wq) * DL + rr);
            if (hh == 0) { scr[r32] = __builtin_amdgcn_rcpf(l);
                if (!FINAL) lse_out[(rowq0 + (size_t)r32 * DL) * 16 + h] = lse2;
                else { const size_t rg = (rowq0 + (size_t)r32 * DL) * 16 + h; const float l0 = lse0[rg], l1 = lse1[rg];
                    const float M = fmaxf(fmaxf(l0, l1), lse2); const float e0 = __builtin_amdgcn_exp2f(l0 - M), e1 = __builtin_amdgcn_exp2f(l1 - M), e2 = __builtin_amdgcn_exp2f(lse2 - M);
                    const float inv = __builtin_amdgcn_rcpf(e0 + e1 + e2); scr[32 + r32] = e0 * inv; scr[64 + r32] = e1 * inv; scr[96 + r32] = e2 * inv; } }
            LDS_WAIT();
            float linv[16];
#pragma unroll
            for (int r = 0; r < 16; ++r) linv[r] = scr[crow(r, hh)];
#pragma unroll
            for (int dh = 0; dh < 2; ++dh) {
#pragma unroll
                for (int r = 0; r < 16; ++r) stg[crow(r, hh) * 32 + r32] = (bf16_t)(cvtpk(o[dh][r] * linv[r], 0.f) & 0xffffu);
                LDS_WAIT();
#pragma unroll
                for (int i = 0; i < 2; ++i) { const int row = (lane >> 2) + 16 * i, ch = lane & 3; u32x4 v = *(const LAS u32x4*)(stg + row * 32 + ch * 8);
                    bf16_t* op = O + (rowq0 + (size_t)row * DL) * DM + h * 64 + 32 * dh + ch * 8;
                    if (FINAL) { const u32x4 a0 = *(const u32x4*)op, a1 = *(const u32x4*)(O1 + (rowq0 + (size_t)row * DL) * DM + h * 64 + 32 * dh + ch * 8);
                        const float w0 = scr[32 + row], w1 = scr[64 + row], w2 = scr[96 + row];
#define CMB(c) cvtpk(w0 * bf_lo(a0.c) + w1 * bf_lo(a1.c) + w2 * bf_lo(v.c), w0 * bf_hi(a0.c) + w1 * bf_hi(a1.c) + w2 * bf_hi(v.c))
                        u32x4 w; w.x = CMB(x); w.y = CMB(y); w.z = CMB(z); w.w = CMB(w); v = w;
#undef CMB
                    }
                    *(u32x4*)op = v; }
                LDS_WAIT();
            }
            __syncthreads();
            if (i < 7) { BLK_WRITE(n2 & 1);
#pragma unroll
                for (int dk = 0; dk < 4; ++dk) qf[dk] = qn[dk]; }
            __syncthreads();
        }
    }
#undef BLK_ISSUE
#undef BLK_WRITE
}

#define XB_TMO      128
#define XB_XCNT(j)  (256  + 64 * (j))
#define XB_XSUB(j)  (1280 + 64 * (j))
#define XB_XGEN(j)  (2304 + 64 * (j))
#define XB_TOP      3328
#define XB_TOPGEN   3392
#define XCD_BAR_WORDS 3456
#define XB_SPIN_CAP (1u << 18)

__device__ __forceinline__ unsigned xb_ld(unsigned* p)              { return __hip_atomic_load(p, __ATOMIC_RELAXED, __HIP_MEMORY_SCOPE_AGENT); }
__device__ __forceinline__ unsigned xb_add(unsigned* p, unsigned v) { return __hip_atomic_fetch_add(p, v, __ATOMIC_RELAXED, __HIP_MEMORY_SCOPE_AGENT); }
__device__ __forceinline__ unsigned xb_xcc_id() { return (unsigned)__builtin_amdgcn_s_getreg((3 << 11) | 20) & 0xFu; }
#define XB_SPIN(cond, bar) do { unsigned _sp = 0; while (cond) { __builtin_amdgcn_s_sleep(1); \
    if ((++_sp & 255u) == 0u) { if (xb_ld(&(bar)[XB_TMO])) break; if (_sp > XB_SPIN_CAP) { atomicAdd(&(bar)[XB_TMO], 1u); break; } } } } while (0)

struct XcdBarrier {
    unsigned* bar; unsigned x;
    volatile LAS unsigned* st;
};

__device__ __forceinline__ XcdBarrier xcd_barrier_post(unsigned* bar, volatile LAS unsigned* st) {
    XcdBarrier b; b.bar = bar; b.x = xb_xcc_id(); b.st = st;
    if (threadIdx.x == 0) (void)xb_add(&bar[XB_XCNT(b.x)], 1u);
    return b;
}
__device__ __forceinline__ void xcd_barrier_complete(unsigned* bar, unsigned x, unsigned& nloc, unsigned& nx) {
    const unsigned G = gridDim.x * gridDim.y * gridDim.z;
    unsigned sum, cnt, mine, sp = 0u;
    for (;;) {
        sum = 0u; cnt = 0u; mine = 0u;
#pragma unroll
        for (unsigned j = 0; j < 16; ++j) { const unsigned c = xb_ld(&bar[XB_XCNT(j)]); sum += c; cnt += (c > 0u) ? 1u : 0u; mine = (j == x) ? c : mine; }
        if (sum == G) break;
        __builtin_amdgcn_s_sleep(1);
        if ((++sp & 255u) == 0u) { if (xb_ld(&bar[XB_TMO])) break; if (sp > XB_SPIN_CAP) { atomicAdd(&bar[XB_TMO], 1u); break; } }
    }
    nloc = mine > 0u ? mine : 1u; nx = cnt > 0u ? cnt : 1u;
}

__device__ __forceinline__ void xcd_barrier(const XcdBarrier& b) {
    asm volatile("s_waitcnt vmcnt(0)" ::: "memory");
    __syncthreads();
    if (threadIdx.x == 0) {
        unsigned* bar = b.bar; asm volatile("" : "+s"(bar)); unsigned bx = b.x; asm volatile("" : "+s"(bx));
        __builtin_amdgcn_s_waitcnt(0);
        unsigned nloc = b.st[0], nx = b.st[1];
        if (nloc == 0u) { xcd_barrier_complete(bar, bx, nloc, nx); b.st[0] = nloc; b.st[1] = nx; }
        const unsigned old = xb_add(&bar[XB_XSUB(bx)], 1u);
        const unsigned gen = old / nloc;
        if (old + 1u == (gen + 1u) * nloc) {
            __builtin_amdgcn_fence(__ATOMIC_RELEASE, "agent");
            asm volatile("s_waitcnt vmcnt(0)" ::: "memory");
            const unsigned og = xb_add(&bar[XB_TOP], 1u);
            const unsigned tg = og / nx;
            if (og + 1u == (tg + 1u) * nx) xb_add(&bar[XB_TOPGEN], 1u);
            else XB_SPIN(xb_ld(&bar[XB_TOPGEN]) == tg, bar);
            __builtin_amdgcn_fence(__ATOMIC_ACQUIRE, "agent");
            asm volatile("s_waitcnt vmcnt(0)" ::: "memory");
        } else {
            XB_SPIN(xb_ld(&bar[XB_TOPGEN]) == gen, bar);
            __builtin_amdgcn_fence(__ATOMIC_ACQUIRE, "agent");
            asm volatile("s_waitcnt vmcnt(0)" ::: "memory");
        }
    }
    __syncthreads();
}

constexpr int PROBE_BAR = 0;
constexpr int PROBE_DUP = -1;
enum { K_PRO = 0, K_GS, K_GW, K_NR, K_AA, K_AB0, K_AB1, K_AB2 };
__global__ void __launch_bounds__(512, 2) yoco_fwd(Params P) {
    extern __shared__ __attribute__((aligned(16))) unsigned char lds_raw[];
    LAS unsigned char* lds = (LAS unsigned char*)lds_raw;
    cg::grid_group grid = cg::this_grid();
    volatile LAS unsigned* xst = (volatile LAS unsigned*)(lds + LDS_BYTES - 16);
    if (threadIdx.x < 4) xst[threadIdx.x] = 0u;
    __syncthreads();
    XcdBarrier xb = xcd_barrier_post((unsigned*)P.ws, xst);
    grid.sync();
#define PH_BEGIN() int tid = threadIdx.x; asm volatile("" : "+v"(tid)); const int lane = tid & 63, wid = __builtin_amdgcn_readfirstlane(tid >> 6); \
        unsigned char* ws = P.ws; asm volatile("" : "+s"(ws)); (void)lane; (void)wid;
#define BARRIER() do { for (int k_ = 0; k_ < 1 + PROBE_BAR; ++k_) xcd_barrier(xb); } while (0)
#define REPS(ph) for (int rep_ = 0; rep_ < ((PROBE_DUP == (ph)) ? 2 : 1); ++rep_)
#define PH_GS(ph, AOFF, BOFF, N_, K_, OOFF, RSP) { PH_BEGIN(); REPS(ph) { pg8::Gemm g{(const bf16_t*)(ws + (AOFF)), (const bf16_t*)(ws + (BOFF)), MROWS, N_, K_}; pg8::StaticOrder S; S.init(MROWS, N_, (int)gridDim.x, (int)blockIdx.x); \
        pg8::EpiStore E{(bf16_t*)(ws + (OOFF)), N_, RSP}; pg8::gemm_phase<pg8::EpiStore, pg8::StaticOrder, true, true>(lds, g, S, E); } } BARRIER();
#define PH_GW(ph, BOFF) { PH_BEGIN(); REPS(ph) { pg8::Gemm g{(const bf16_t*)(ws + WS_XN), (const bf16_t*)(ws + (BOFF)), MROWS, 2 * DFF, DM}; pg8::StaticOrder S; S.init(MROWS, 2 * DFF, (int)gridDim.x, (int)blockIdx.x); \
        pg8::EpiSwiglu E{(bf16_t*)(ws + WS_ACT), DFF, (const float*)(ws + WS_RS)}; pg8::gemm_phase<pg8::EpiSwiglu, pg8::StaticOrder, true, true>(lds, g, S, E); } } BARRIER();
#define PH_NR(XIN32, OUT32, GI) { PH_BEGIN(); norm_res_phase<XIN32, OUT32>((const bf16_t*)(ws + WS_H), P.gains + (GI) * DM, P.x, (bf16_t*)(ws + WS_XN), (float*)(ws + WS_RS), P.out, lane, wid); }
#define RSV ((const float*)(ws + WS_RS))
#define RS0 ((const float*)nullptr)
    { PH_BEGIN(); REPS(0) { prologue(P, lds, tid, lane, wid); } } BARRIER();
    PH_GS(1, WS_XN, WS_WQKVA, 3072, 1024, WS_QKV, RSV)
    { PH_BEGIN(); REPS(2) { attnA_phase(lds, (const bf16_t*)(ws + WS_QKV), (bf16_t*)(ws + WS_OB), tid, lane, wid); } } BARRIER();
    PH_GS(3, WS_OB, WS_WOA, 1024, 1024, WS_H, RS0)
    PH_NR(true, false, 1) BARRIER();
    PH_GW(5, WS_WGU0)
    PH_GS(6, WS_ACT, WS_WD0, 1024, DFF, WS_H, RS0)
    PH_NR(false, false, 3) BARRIER();
    PH_GS(8, WS_XN, WS_WB, 3072, 1024, WS_QKV, RSV)
    { PH_BEGIN(); REPS(9) { attnB_phase<1, false>(lds, (const bf16_t*)(ws + WS_QKV), (bf16_t*)(ws + WS_OB), (float*)(ws + WS_LSE0), (const float*)(ws + WS_BIAS), nullptr, nullptr, nullptr, tid, lane, wid); } } BARRIER();
    PH_GS(10, WS_XN, WS_WB + 6 * MiB, 3072, 1024, WS_QKV, RSV)
    { PH_BEGIN(); REPS(11) { attnB_phase<4, false>(lds, (const bf16_t*)(ws + WS_QKV), (bf16_t*)(ws + WS_H), (float*)(ws + WS_LSE1), (const float*)(ws + WS_BIAS) + 3072, nullptr, nullptr, nullptr, tid, lane, wid); } } BARRIER();
    PH_GS(12, WS_XN, WS_WB + 12 * MiB, 3072, 1024, WS_QKV, RSV)
    { PH_BEGIN(); attnB_phase<16, true>(lds, (const bf16_t*)(ws + WS_QKV), (bf16_t*)(ws + WS_OB), nullptr, (const float*)(ws + WS_BIAS) + 6144, (const bf16_t*)(ws + WS_H), (const float*)(ws + WS_LSE0), (const float*)(ws + WS_LSE1), tid, lane, wid); } BARRIER();
    PH_GS(14, WS_OB, WS_WOB, 1024, 1024, WS_H, RS0)
    PH_NR(false, false, 5) BARRIER();
    PH_GW(16, WS_WGU1)
    PH_GS(17, WS_ACT, WS_WD1, 1024, DFF, WS_H, RS0)
    PH_NR(false, true, 7)
}

extern "C" void kernel_launch(void* const* d_in, const int* in_sizes, int n_in, void* d_out, int out_size, void* d_ws, size_t ws_size, hipStream_t stream) {
    static int grid = 0;
    if (grid == 0) {
        if (n_in != 11 || out_size != MROWS * DM || ws_size < WS_END) { fprintf(stderr, "kernel_launch: unexpected shapes (n_in %d, out %d, ws %zu)\n", n_in, out_size, ws_size); grid = -1; return; }
        int dev = 0, cus = 0, per_cu = 0;
        (void)hipGetDevice(&dev); (void)hipDeviceGetAttribute(&cus, hipDeviceAttributeMultiprocessorCount, dev);
        if (hipFuncSetAttribute((const void*)yoco_fwd, hipFuncAttributeMaxDynamicSharedMemorySize, LDS_BYTES) != hipSuccess) { fprintf(stderr, "kernel_launch: hipFuncSetAttribute failed\n"); grid = -1; return; }
        if (hipOccupancyMaxActiveBlocksPerMultiprocessor(&per_cu, (const void*)yoco_fwd, 512, LDS_BYTES) != hipSuccess || per_cu < 1) { fprintf(stderr, "kernel_launch: occupancy query failed (%d)\n", per_cu); per_cu = 1; }
        (void)hipGetLastError();
        grid = cus * per_cu;
        if (grid <= 0) grid = 256;
    }
    if (grid < 0) return;
    if (hipMemsetAsync(d_ws, 0, 131072, stream) != hipSuccess) { fprintf(stderr, "kernel_launch: memset failed\n"); return; }
    Params p{};
    p.x = (const float*)d_in[0]; p.gains = (const float*)d_in[1]; p.w_qkv_a = (const float*)d_in[2]; p.w_o_a = (const float*)d_in[3]; p.g_kv = (const float*)d_in[4];
    p.w_kv_b = (const float*)d_in[5]; p.w_q_b = (const float*)d_in[6]; p.w_o_b = (const float*)d_in[7]; p.rel_bias = (const float*)d_in[8]; p.w_gu = (const float*)d_in[9]; p.w_down = (const float*)d_in[10];
    p.out = (float*)d_out; p.ws = (unsigned char*)d_ws;
    void* args[] = {&p};
    const hipError_t e = hipLaunchCooperativeKernel((const void*)yoco_fwd, dim3(grid), dim3(512), args, LDS_BYTES, stream);
    if (e != hipSuccess) fprintf(stderr, "kernel_launch: cooperative launch failed: %s (grid %d)\n", hipGetErrorString(e), grid);
}
```

```cpp
#include <hip/hip_runtime.h>
#include <hip/hip_cooperative_groups.h>
#include <cstdio>
#include <cstdint>
namespace cg = cooperative_groups;
namespace pg8 {
#define PG8_LAS __attribute__((address_space(3)))
typedef unsigned short bf16_t;
typedef short bf16x8 __attribute__((ext_vector_type(8)));
typedef float f32x4 __attribute__((ext_vector_type(4)));
typedef unsigned u32x4 __attribute__((ext_vector_type(4)));
constexpr int BM = 256, BK = 64, HALF = 128, HTB = HALF * BK * 2  , STAGE_BYTES = 8 * HTB, NXCD = 8, WGM = 8;

__host__ __device__ __forceinline__ int lds_byte(int r, int c) { const int st = (r >> 4) * 2 + (c >> 5), rr = r & 15, cc = c & 31, ob = rr * 64 + cc * 2; return st * 1024 + (ob ^ (((ob >> 9) & 1) << 5)); }
__host__ __device__ __forceinline__ void stage_rc(int b, int& R, int& C) { const int st = b / 1024, sb = b % 1024, swz = sb ^ (((sb >> 9) & 1) << 5); R = (st >> 1) * 16 + swz / 64; C = (st & 1) * 32 + (swz % 64) / 2; }
__host__ __device__ __forceinline__ int perm32(int rho) { const int n = rho >> 4, i = rho & 15; return 8 * (i >> 2) + 4 * n + (i & 3); }

struct Unit { int pm, pn; };
struct Gemm { const bf16_t* A; const bf16_t* Bt; int M, N, K; };

struct StaticOrder {
    int nM, nN, nwg, G, c;
    __host__ __device__ void init(int M, int N, int G_, int c_) { nM = M / BM; nN = N / BM; nwg = nM * nN; G = G_; c = c_; }
    __host__ __device__ bool next(int i, Unit& u) const {
        const long L = (long)i * G + c; if (L >= nwg) return false;
        int wgid = (int)L; { const int q = nwg / NXCD, r = nwg % NXCD, xcd = wgid % NXCD, off = wgid / NXCD; wgid = (xcd < r ? xcd * (q + 1) : r * (q + 1) + (xcd - r) * q) + off; }
        const int nig = WGM * nN, gid = wgid / nig, fm = gid * WGM, gsz = (nM - fm) < WGM ? (nM - fm) : WGM;
        u.pm = fm + ((wgid % nig) % gsz); u.pn = (wgid % nig) / gsz; return true;
    }
    __device__ __forceinline__ void a_ready(const Unit&) const {}
    __device__ __forceinline__ void done(const Unit&) const {}
};


typedef float f32x2_t __attribute__((ext_vector_type(2))); typedef __bf16 bf16x2_t __attribute__((ext_vector_type(2)));
__device__ __forceinline__ unsigned cvtpk(float lo, float hi) { f32x2_t v = {lo, hi}; bf16x2_t b = __builtin_convertvector(v, bf16x2_t); return __builtin_bit_cast(unsigned, b); }

struct EpiStore {
    static constexpr bool PERM = true, AFTER_DRAIN = false, FUSED = false, HAS_RS = true;
    bf16_t* O; int ldc; const float* rs;
    __device__ __forceinline__ void operator()(const f32x4 (&acc)[2][2][4][2], const Unit& u, int wr, int wc, int fr, int fq, const PG8_LAS float* rsl) const {
        const int row0 = u.pm * BM + wr * 64 + fr; const int col0 = u.pn * BM + wc * 32 + 8 * fq;
#pragma unroll
        for (int ai = 0; ai < 2; ++ai)
#pragma unroll
            for (int m = 0; m < 4; ++m) { bf16_t* rowp = O + (size_t)(row0 + ai * HALF + m * 16) * ldc + col0; const float sc = rs ? rsl[wr * 64 + fr + ai * HALF + m * 16] : 1.0f;
#pragma unroll
                for (int bj = 0; bj < 2; ++bj) { const f32x4 v0 = acc[ai][bj][m][0] * sc, v1 = acc[ai][bj][m][1] * sc;
                    u32x4 w; w.x = cvtpk(v0[0], v0[1]); w.y = cvtpk(v0[2], v0[3]); w.z = cvtpk(v1[0], v1[1]); w.w = cvtpk(v1[2], v1[3]);
                    *(u32x4*)(rowp + bj * HALF) = w; } }
    }
};
struct EpiSwiglu {
    static constexpr bool PERM = true, AFTER_DRAIN = false, FUSED = false, HAS_RS = true;
    bf16_t* O; int ldc; const float* rs;
    __device__ __forceinline__ float act(float g, float u) const { const float e = __builtin_amdgcn_exp2f(-1.4426950408889634f * g); return g * u * __builtin_amdgcn_rcpf(1.0f + e); }
    __device__ __forceinline__ void operator()(const f32x4 (&acc)[2][2][4][2], const Unit& u, int wr, int wc, int fr, int fq, const PG8_LAS float* rsl) const {
        const int row0 = u.pm * BM + wr * 64 + fr; const int col0 = u.pn * HALF + wc * 32 + 8 * fq;
#pragma unroll
        for (int ai = 0; ai < 2; ++ai)
#pragma unroll
            for (int m = 0; m < 4; ++m) { bf16_t* rowp = O + (size_t)(row0 + ai * HALF + m * 16) * ldc + col0; const float sc = rsl[wr * 64 + fr + ai * HALF + m * 16];
                const f32x4 g0 = acc[ai][0][m][0] * sc, g1 = acc[ai][0][m][1] * sc, u0 = acc[ai][1][m][0] * sc, u1 = acc[ai][1][m][1] * sc;
                u32x4 w; w.x = cvtpk(act(g0[0], u0[0]), act(g0[1], u0[1])); w.y = cvtpk(act(g0[2], u0[2]), act(g0[3], u0[3]));
                w.z = cvtpk(act(g1[0], u1[0]), act(g1[1], u1[1])); w.w = cvtpk(act(g1[2], u1[2]), act(g1[3], u1[3]));
                *(u32x4*)rowp = w; }
    }
};


template <class Epi, class Sched, bool ALIGN_EPI = false, bool SP2 = false>
__device__ __forceinline__ void gemm_phase(PG8_LAS unsigned char* lds, const Gemm g, const Sched& S, const Epi& E) {
    const int tid = threadIdx.x, wid = __builtin_amdgcn_readfirstlane(tid >> 6), lane = tid & 63, wr = wid >> 2, wc = wid & 3, fr = lane & 15, fq = lane >> 4;
    const int K = g.K, nt = K / BK;
    unsigned voffA, voffB;
    { int R, C; stage_rc(tid * 16, R, C); const int Rb = Epi::PERM ? ((R & ~31) + perm32(R & 31)) : R;
        voffA = (unsigned)(R * K + C) * 2u; voffB = (unsigned)(Rb * K + C) * 2u; }
    const size_t rstep = (size_t)64 * K * 2;
    const size_t kstep = (size_t)(BK * 2);
    const size_t hstep = (size_t)HALF * K * 2;
    const size_t tstep = 2 * hstep;
    const unsigned ldsw = (unsigned)wid * 1024u;
    const int aoff = lds_byte(wr * 64 + fr, fq * 8), boff = lds_byte(wc * 32 + fr, fq * 8);
#define PG8_SA(b, h) (((b) * 2 + (h)) * HTB)
#define PG8_SB(b, h) ((4 + (b) * 2 + (h)) * HTB)
#define PG8_STAGE(bufoff, gbase, voff) do { _Pragma("unroll") for (int _i = 0; _i < 2; ++_i) \
        __builtin_amdgcn_global_load_lds((const unsigned*)((const char*)(gbase) + _i * rstep + (voff)), (PG8_LAS unsigned*)(lds + (bufoff) + ldsw + _i * 8192), 16, 0, 0); } while (0)
#define PG8_LDA(dst, b, h) do { _Pragma("unroll") for (int m = 0; m < 4; ++m) _Pragma("unroll") for (int k = 0; k < 2; ++k) dst[m][k] = *(const PG8_LAS bf16x8*)(lds + PG8_SA(b, h) + aoff + m * 2048 + k * 1024); } while (0)
#define PG8_LDB(dst, b, h) do { _Pragma("unroll") for (int n = 0; n < 2; ++n) _Pragma("unroll") for (int k = 0; k < 2; ++k) dst[n][k] = *(const PG8_LAS bf16x8*)(lds + PG8_SB(b, h) + boff + n * 2048 + k * 1024); } while (0)
#define PG8_MMA(ai, bj, At, Bt) do { __builtin_amdgcn_s_setprio(1); _Pragma("unroll") for (int m = 0; m < 4; ++m) _Pragma("unroll") for (int n = 0; n < 2; ++n) _Pragma("unroll") for (int k = 0; k < 2; ++k) \
        acc[ai][bj][m][n] = __builtin_amdgcn_mfma_f32_16x16x32_bf16(Bt[n][k], At[m][k], acc[ai][bj][m][n], 0, 0, 0); __builtin_amdgcn_s_setprio(0); } while (0)
#define PG8_WAIT_V(n) asm volatile("s_waitcnt vmcnt(" #n ")" ::: "memory")
#define PG8_WAIT_L(n) asm volatile("s_waitcnt lgkmcnt(" #n ")" ::: "memory")
#define PG8_BAR __builtin_amdgcn_s_barrier()
#define PG8_SCHED __builtin_amdgcn_sched_barrier(0)
    Unit cur, nxt; int ui = 0;
    if (!S.next(0, cur)) return;
    f32x4 acc[2][2][4][2];
#pragma unroll
    for (int a = 0; a < 2; ++a)
#pragma unroll
        for (int b = 0; b < 2; ++b)
#pragma unroll
            for (int m = 0; m < 4; ++m)
#pragma unroll
                for (int n = 0; n < 2; ++n) acc[a][b][m][n] = (f32x4){0.f, 0.f, 0.f, 0.f};
    bf16x8 At[4][2], B0[2][2], B1[2][2];
    const char* cA = (const char*)g.A + (size_t)cur.pm * tstep; const char* cB = (const char*)g.Bt + (size_t)cur.pn * tstep;
    S.a_ready(cur);
    if constexpr (SP2) {
        PG8_STAGE(PG8_SB(0, 0), cB, voffB); PG8_STAGE(PG8_SB(0, 1), cB + hstep, voffB); PG8_STAGE(PG8_SA(0, 0), cA, voffA); PG8_STAGE(PG8_SA(0, 1), cA + hstep, voffA);
        if (wr == 1) PG8_BAR;
        PG8_WAIT_V(2); PG8_BAR;
        PG8_STAGE(PG8_SB(1, 0), cB + kstep, voffB); PG8_STAGE(PG8_SA(1, 0), cA + kstep, voffA); PG8_STAGE(PG8_SB(1, 1), cB + hstep + kstep, voffB);
        PG8_WAIT_V(6); PG8_BAR;
    } else {
        PG8_STAGE(PG8_SB(0, 0), cB, voffB); PG8_STAGE(PG8_SA(0, 0), cA, voffA); PG8_STAGE(PG8_SB(0, 1), cB + hstep, voffB); PG8_STAGE(PG8_SA(0, 1), cA + hstep, voffA);
        if (wr == 1) PG8_BAR;
        PG8_WAIT_V(4); PG8_BAR;
        PG8_STAGE(PG8_SB(1, 0), cB + kstep, voffB); PG8_STAGE(PG8_SA(1, 0), cA + kstep, voffA); PG8_STAGE(PG8_SB(1, 1), cB + hstep + kstep, voffB);
        PG8_WAIT_V(6); PG8_BAR;
    }
    for (;;) {
        if constexpr (Epi::HAS_RS) { if (E.rs != nullptr && wid < 4)
            __builtin_amdgcn_global_load_lds((const unsigned*)(E.rs + cur.pm * BM + wid * 64 + lane), (PG8_LAS unsigned*)(lds + STAGE_BYTES + (ui & 1) * 1024 + wid * 256), 4, 0, 0); }
        const bool has_next = S.next(ui + 1, nxt);
        const char* nA = has_next ? (const char*)g.A + (size_t)nxt.pm * tstep : cA; const char* nB = has_next ? (const char*)g.Bt + (size_t)nxt.pn * tstep : cB;
        for (int t = 0; t < nt; t += 2) {
            const bool last = (t == nt - 2);
            const char* a1 = cA + (size_t)(t + 1) * kstep;
            const char* a2 = last ? nA : cA + (size_t)(t + 2) * kstep; const char* b2 = last ? nB : cB + (size_t)(t + 2) * kstep;
            const char* a3 = a2 + kstep; const char* b3 = b2 + kstep;
            if (last && has_next) S.a_ready(nxt);
            if constexpr (SP2) {
            PG8_LDB(B0, 0, 0); PG8_LDB(B1, 0, 1); PG8_SCHED; PG8_LDA(At, 0, 0); PG8_STAGE(PG8_SA(1, 1), a1 + hstep, voffA);
            PG8_WAIT_V(8); PG8_WAIT_L(0); PG8_BAR; PG8_MMA(0, 0, At, B0); PG8_MMA(0, 1, At, B1); PG8_BAR; PG8_SCHED;
            PG8_LDA(At, 0, 1); PG8_STAGE(PG8_SB(0, 0), b2, voffB); PG8_STAGE(PG8_SB(0, 1), b2 + hstep, voffB); PG8_STAGE(PG8_SA(0, 0), a2, voffA);
            PG8_WAIT_V(8); PG8_WAIT_L(0); PG8_BAR; PG8_MMA(1, 0, At, B0); PG8_MMA(1, 1, At, B1); PG8_BAR; PG8_SCHED;
            PG8_LDB(B0, 1, 0); PG8_LDB(B1, 1, 1); PG8_SCHED; PG8_LDA(At, 1, 0); PG8_STAGE(PG8_SA(0, 1), a2 + hstep, voffA);
            PG8_WAIT_V(8); PG8_WAIT_L(0); PG8_BAR; PG8_MMA(0, 0, At, B0); PG8_MMA(0, 1, At, B1); PG8_BAR; PG8_SCHED;
            PG8_LDA(At, 1, 1); PG8_STAGE(PG8_SB(1, 0), b3, voffB); PG8_STAGE(PG8_SB(1, 1), b3 + hstep, voffB); PG8_STAGE(PG8_SA(1, 0), a3, voffA);
            PG8_WAIT_V(8); PG8_WAIT_L(0); PG8_BAR; PG8_MMA(1, 0, At, B0); PG8_MMA(1, 1, At, B1); PG8_BAR; PG8_SCHED;
            } else {
            PG8_LDB(B0, 0, 0); PG8_SCHED; PG8_LDA(At, 0, 0); PG8_STAGE(PG8_SA(1, 1), a1 + hstep, voffA);
            PG8_WAIT_L(8); PG8_BAR; PG8_WAIT_L(0); PG8_MMA(0, 0, At, B0); PG8_BAR; PG8_SCHED;
            PG8_LDB(B1, 0, 1); PG8_STAGE(PG8_SB(0, 0), b2, voffB);
            PG8_BAR; PG8_WAIT_L(0); PG8_MMA(0, 1, At, B1); PG8_BAR;
            PG8_LDA(At, 0, 1); PG8_STAGE(PG8_SA(0, 0), a2, voffA);
            PG8_BAR; PG8_WAIT_L(0); PG8_MMA(1, 0, At, B0); PG8_BAR; PG8_SCHED;
            PG8_STAGE(PG8_SB(0, 1), b2 + hstep, voffB);
            PG8_WAIT_V(6); PG8_BAR; PG8_MMA(1, 1, At, B1); PG8_BAR;
            PG8_LDB(B0, 1, 0); PG8_SCHED; PG8_LDA(At, 1, 0); PG8_STAGE(PG8_SA(0, 1), a2 + hstep, voffA);
            PG8_WAIT_L(8); PG8_BAR; PG8_WAIT_L(0); PG8_MMA(0, 0, At, B0); PG8_BAR; PG8_SCHED;
            PG8_LDB(B1, 1, 1); PG8_STAGE(PG8_SB(1, 0), b3, voffB);
            PG8_BAR; PG8_WAIT_L(0); PG8_MMA(0, 1, At, B1); PG8_BAR;
            PG8_LDA(At, 1, 1); PG8_STAGE(PG8_SA(1, 0), a3, voffA);
            PG8_BAR; PG8_WAIT_L(0); PG8_MMA(1, 0, At, B0); PG8_BAR; PG8_SCHED;
            PG8_STAGE(PG8_SB(1, 1), b3 + hstep, voffB);
            PG8_WAIT_V(6); PG8_BAR; PG8_MMA(1, 1, At, B1); PG8_BAR;
            }
        }
        if constexpr (ALIGN_EPI) { if (wr == 0) PG8_BAR; }
        if constexpr (Epi::FUSED) { E.fused(acc, cur, wr, wc, fr, fq, lds + STAGE_BYTES, wid, lane); } else
        if constexpr (!Epi::AFTER_DRAIN) { E(acc, cur, wr, wc, fr, fq, (const PG8_LAS float*)(lds + STAGE_BYTES + (ui & 1) * 1024)); S.done(cur); }
        if (!has_next) break;
#pragma unroll
        for (int a = 0; a < 2; ++a)
#pragma unroll
            for (int b = 0; b < 2; ++b)
#pragma unroll
                for (int m = 0; m < 4; ++m)
#pragma unroll
                    for (int n = 0; n < 2; ++n) acc[a][b][m][n] = (f32x4){0.f, 0.f, 0.f, 0.f};
        cur = nxt; cA = nA; cB = nB; ++ui;
        if constexpr (ALIGN_EPI) { if (wr == 1) PG8_BAR; }
    }
    PG8_WAIT_V(0);
    if constexpr (!ALIGN_EPI) { if (wr == 0) PG8_BAR; }
    PG8_BAR;
    if constexpr (Epi::AFTER_DRAIN) { E.fused(acc, cur, wr, wc, fr, fq, lds, wid, lane); S.done(cur); }
#undef PG8_SA
#undef PG8_SB
#undef PG8_STAGE
#undef PG8_LDA
#undef PG8_LDB
#undef PG8_MMA
#undef PG8_WAIT_V
#undef PG8_WAIT_L
#undef PG8_BAR
#undef PG8_SCHED
}
}

#define LAS __attribute__((address_space(3)))
typedef pg8::bf16_t bf16_t; typedef pg8::bf16x8 bf16x8; typedef pg8::f32x4 f32x4; typedef pg8::u32x4 u32x4;
typedef float f32x16 __attribute__((ext_vector_type(16)));
typedef unsigned u32x2 __attribute__((ext_vector_type(2)));
typedef short v4i16_t __attribute__((ext_vector_type(4)));
using pg8::cvtpk;

constexpr int BATCH = 16, SEQ = 2048, DM = 1024, NH = 16, HD = 64, DFF = 2816, MROWS = BATCH * SEQ;
constexpr float RMS_EPS = 1e-6f;
constexpr float LOG2E = 1.4426950408889634f;
constexpr float QSCALE = 0.125f * LOG2E;
constexpr size_t MiB = 1u << 20;
constexpr size_t WS_CNT = 16384  , WS_SLOT = 63 * MiB + 65536  ;
constexpr size_t WS_WQKVA = 1 * MiB, WS_WOA = 7 * MiB, WS_WGU0 = 9 * MiB, WS_WD0 = 20 * MiB, WS_WB = 26 * MiB  , WS_WOB = 44 * MiB,
                 WS_WGU1 = 46 * MiB, WS_WD1 = 57 * MiB, WS_BIAS = 63 * MiB, WS_XN = 65 * MiB, WS_QKV = 129 * MiB, WS_ACT = 129 * MiB  ,
                 WS_OB = 321 * MiB, WS_H = 385 * MiB, WS_LSE0 = 449 * MiB, WS_LSE1 = 451 * MiB, WS_RS = 453 * MiB  , WS_END = 454 * MiB;
constexpr int LDS_BYTES = 155648;

struct Params { const float *x, *gains, *w_qkv_a, *w_o_a, *g_kv, *w_kv_b, *w_q_b, *w_o_b, *rel_bias, *w_gu, *w_down; float* out; unsigned char* ws; };

#define LDS_WAIT() asm volatile("s_waitcnt lgkmcnt(0)" ::: "memory")
__device__ __forceinline__ float wave_sum(float v) {
#pragma unroll
    for (int o = 1; o < 64; o <<= 1) v += __shfl_xor(v, o);
    return v;
}
__device__ __forceinline__ int crow(int r, int hi) { return (r & 3) + 8 * (r >> 2) + 4 * hi; }
__device__ __forceinline__ float bf_lo(unsigned w) { return __uint_as_float(w << 16); }
__device__ __forceinline__ float bf_hi(unsigned w) { return __uint_as_float(w & 0xffff0000u); }

__device__ __forceinline__ void conv_item(const float* __restrict__ W, int ldw, int col, int K, const float* __restrict__ gain, float scale, bf16_t* WT, int drow, LAS float* scr, int kb, int lane) {
    const int k0 = 64 * kb, ks = lane >> 3, n4 = lane & 7;
    f32x4 v[8]; float gs[8];
#pragma unroll
    for (int i = 0; i < 8; ++i) { const int kk = 8 * i + ks; v[i] = *(const f32x4*)(W + (size_t)(k0 + kk) * ldw + col + 4 * n4); gs[i] = gain ? gain[k0 + kk] * scale : scale; }
#pragma unroll
    for (int i = 0; i < 8; ++i) { const int kk = 8 * i + ks; LAS float* d = scr + kk * 33 + 4 * n4; d[0] = v[i].x * gs[i]; d[1] = v[i].y * gs[i]; d[2] = v[i].z * gs[i]; d[3] = v[i].w * gs[i]; }
    LDS_WAIT();
    const int c = lane & 7;
#pragma unroll
    for (int j = 0; j < 4; ++j) { const int n = (lane >> 3) + 8 * j; const LAS float* s = scr + (8 * c) * 33 + n;
        u32x4 o; o.x = cvtpk(s[0 * 33], s[1 * 33]); o.y = cvtpk(s[2 * 33], s[3 * 33]); o.z = cvtpk(s[4 * 33], s[5 * 33]); o.w = cvtpk(s[6 * 33], s[7 * 33]);
        *(u32x4*)(WT + (size_t)(drow + n) * K + k0 + 8 * c) = o; }
    LDS_WAIT();
}
template <int MODE> __device__ __forceinline__ void conv_seg(const float* src, int ld, int col0, int ncols, int K, const float* gain, float scale, bf16_t* dst, int drow0,
                                                             LAS float* scr, int gw, int NGW, int& off, int lane) {
    const int nblk = ncols >> 5, items = nblk * (K >> 6);
    int it0 = gw - (off % NGW); if (it0 < 0) it0 += NGW; off += items;
    for (int it = it0; it < items; it += NGW) {
        const int kb = it / nblk, nb = it - kb * nblk, c = 32 * nb; int drow;
        if (MODE == 1) { const int upf = c >= DFF ? 1 : 0, cc = c - upf * DFF; drow = 256 * (cc >> 7) + 128 * upf + (cc & 127); } else drow = drow0 + c;
        conv_item(src, ld, col0 + c, K, gain, scale, dst, drow, scr, kb, lane);
    }
}
__device__ __forceinline__ void norm_row_bf16(const float* xrow, bf16_t* orow, float* rs, int lane) {
    const f32x4* xr = (const f32x4*)xrow + lane;
    f32x4 v[4]; float s = 0.f;
#pragma unroll
    for (int j = 0; j < 4; ++j) { v[j] = xr[64 * j]; s += (v[j].x * v[j].x + v[j].y * v[j].y) + (v[j].z * v[j].z + v[j].w * v[j].w); }
    const float r = 1.0f / sqrtf(wave_sum(s) * (1.f / DM) + RMS_EPS);
    if (lane == 0) *rs = r;
    u32x2* o8 = (u32x2*)orow + lane;
#pragma unroll
    for (int j = 0; j < 4; ++j) { u32x2 w; w.x = cvtpk(v[j].x, v[j].y); w.y = cvtpk(v[j].z, v[j].w); o8[64 * j] = w; }
}
__device__ __forceinline__ void prologue(const Params& P, LAS unsigned char* lds, int tid, int lane, int wave) {
    LAS float* scr = (LAS float*)(lds + wave * 16384);
    const int G = gridDim.x, gw = blockIdx.x * 8 + wave, NGW = G * 8;
    unsigned char* ws = P.ws; int off = 0;
    const float* g00 = P.gains + 0 * DM; const float* g02 = P.gains + 2 * DM; const float* g10 = P.gains + 4 * DM; const float* g12 = P.gains + 6 * DM;
    conv_seg<0>(P.w_qkv_a, 3072, 0, 1024, 1024, g00, QSCALE, (bf16_t*)(ws + WS_WQKVA), 0, scr, gw, NGW, off, lane);
    conv_seg<0>(P.w_qkv_a, 3072, 1024, 2048, 1024, g00, 1.0f, (bf16_t*)(ws + WS_WQKVA), 1024, scr, gw, NGW, off, lane);
    conv_seg<0>(P.w_o_a, 1024, 0, 1024, 1024, nullptr, 1.0f, (bf16_t*)(ws + WS_WOA), 0, scr, gw, NGW, off, lane);
    conv_seg<1>(P.w_gu, 2 * DFF, 0, 2 * DFF, 1024, g02, 1.0f, (bf16_t*)(ws + WS_WGU0), 0, scr, gw, NGW, off, lane);
    conv_seg<0>(P.w_down, 1024, 0, 1024, DFF, nullptr, 1.0f, (bf16_t*)(ws + WS_WD0), 0, scr, gw, NGW, off, lane);
    for (int g = 0; g < 3; ++g) {
        bf16_t* wb = (bf16_t*)(ws + WS_WB + (size_t)g * 6 * MiB);
        conv_seg<0>(P.w_q_b, 3072, 1024 * g, 1024, 1024, g10, QSCALE, wb, 0, scr, gw, NGW, off, lane);
        conv_seg<0>(P.w_kv_b, 6144, 2048 * g, 2048, 1024, P.g_kv, 1.0f, wb, 1024, scr, gw, NGW, off, lane);
    }
    conv_seg<0>(P.w_o_b, 1024, 0, 1024, 1024, nullptr, 1.0f, (bf16_t*)(ws + WS_WOB), 0, scr, gw, NGW, off, lane);
    conv_seg<1>(P.w_gu + (size_t)DM * 2 * DFF, 2 * DFF, 0, 2 * DFF, 1024, g12, 1.0f, (bf16_t*)(ws + WS_WGU1), 0, scr, gw, NGW, off, lane);
    conv_seg<0>(P.w_down + (size_t)DFF * DM, 1024, 0, 1024, DFF, nullptr, 1.0f, (bf16_t*)(ws + WS_WD1), 0, scr, gw, NGW, off, lane);
    bf16_t* XN = (bf16_t*)(ws + WS_XN);
    for (int m = gw; m < MROWS; m += NGW) norm_row_bf16(P.x + (size_t)m * DM, XN + (size_t)m * DM, (float*)(ws + WS_RS) + m, lane);
    float* BT = (float*)(ws + WS_BIAS);
    for (int idx = blockIdx.x * 512 + tid; idx < 3 * 16 * 192; idx += G * 512) {
        const int g = idx / 3072, rem = idx - g * 3072, h = rem / 192, e = rem - h * 192, rel = e - 32; float v = 0.f;
        if (rel >= 0 && rel <= 128) { const int dl = (g == 0) ? 1 : ((g == 1) ? 4 : 16); const int n = rel * dl; int bk;
            if (n < 16) bk = n;
            else { bk = 16 + (n >= 22) + (n >= 30) + (n >= 40) + (n >= 54) + (n >= 73) + (n >= 99) + (n >= 134) + (n >= 182) + (n >= 246) + (n >= 332) + (n >= 450) + (n >= 609) + (n >= 825) + (n >= 1117) + (n >= 1513); }
            v = P.rel_bias[bk * 16 + h] * LOG2E; }
        BT[idx] = v;
    }
}

template <bool XIN32, bool OUT32> __device__ __forceinline__ void norm_res_phase(const bf16_t* H, const float* gain, const float* Xin32, bf16_t* XB, float* RS, float* Out32, int lane, int wave) {
    const int gw = blockIdx.x * 8 + wave, NGW = gridDim.x * 8;
    f32x4 gv[4];
#pragma unroll
    for (int j = 0; j < 4; ++j) gv[j] = *((const f32x4*)gain + lane + 64 * j);
    for (int m = gw; m < MROWS; m += NGW) {
        const u32x2* hp = (const u32x2*)(H + (size_t)m * DM) + lane;
        f32x4 hv[4], xv[4]; float ss = 0.f;
#pragma unroll
        for (int j = 0; j < 4; ++j) { const u32x2 w = hp[64 * j]; hv[j] = (f32x4){bf_lo(w.x), bf_hi(w.x), bf_lo(w.y), bf_hi(w.y)};
            if (XIN32) xv[j] = *((const f32x4*)(Xin32 + (size_t)m * DM) + lane + 64 * j);
            else { const u32x2 xw = *((const u32x2*)(XB + (size_t)m * DM) + lane + 64 * j); xv[j] = (f32x4){bf_lo(xw.x), bf_hi(xw.x), bf_lo(xw.y), bf_hi(xw.y)}; }
            ss += (hv[j].x * hv[j].x + hv[j].y * hv[j].y) + (hv[j].z * hv[j].z + hv[j].w * hv[j].w); }
        const float r = 1.0f / sqrtf(wave_sum(ss) * (1.f / DM) + RMS_EPS);
        float s2 = 0.f;
#pragma unroll
        for (int j = 0; j < 4; ++j) { xv[j] = xv[j] + hv[j] * r * gv[j];
            s2 += (xv[j].x * xv[j].x + xv[j].y * xv[j].y) + (xv[j].z * xv[j].z + xv[j].w * xv[j].w); }
        if (OUT32) { f32x4* op = (f32x4*)(Out32 + (size_t)m * DM) + lane;
#pragma unroll
            for (int j = 0; j < 4; ++j) op[64 * j] = xv[j]; }
        else { const float r2 = 1.0f / sqrtf(wave_sum(s2) * (1.f / DM) + RMS_EPS); if (lane == 0) RS[m] = r2; u32x2* o8 = (u32x2*)(XB + (size_t)m * DM) + lane;
#pragma unroll
            for (int j = 0; j < 4; ++j) { u32x2 w; w.x = cvtpk(xv[j].x, xv[j].y); w.y = cvtpk(xv[j].z, xv[j].w); o8[64 * j] = w; } }
    }
}

__device__ __forceinline__ bf16x8 vfrag(const LAS unsigned char* p) {
    const v4i16_t lo = __builtin_amdgcn_ds_read_tr16_b64_v4i16((LAS v4i16_t*)p);
    const v4i16_t hi = __builtin_amdgcn_ds_read_tr16_b64_v4i16((LAS v4i16_t*)(p + 512));
    return (bf16x8){lo[0], lo[1], lo[2], lo[3], hi[0], hi[1], hi[2], hi[3]};
}
__device__ __forceinline__ bf16x8 pack8(const float* a) {
    u32x4 w; w.x = cvtpk(a[0], a[1]); w.y = cvtpk(a[2], a[3]); w.z = cvtpk(a[4], a[5]); w.w = cvtpk(a[6], a[7]); return __builtin_bit_cast(bf16x8, w);
}

template <bool MASK> __device__ __forceinline__ void sb_subtile(const LAS unsigned char* kbuf, const LAS unsigned char* vbuf  , int sub, const bf16x8 (&qf)[4], const int (&kaddr)[4],
                                                                float& carry, f32x16 (&o)[2], int r32, int hh) {
    f32x16 S = {};
#pragma unroll
    for (int dk = 0; dk < 4; ++dk) { const bf16x8 kf = *(const LAS bf16x8*)(kbuf + kaddr[dk] + sub * 512); S = __builtin_amdgcn_mfma_f32_32x32x16_bf16(kf, qf[dk], S, 0, 0, 0); }
    float p[16];
#pragma unroll
    for (int r = 0; r < 16; ++r) { const float u = __builtin_amdgcn_exp2f(S[r]); float wv = __builtin_amdgcn_rcpf(1.0f + u);
        if (MASK) wv = (crow(r, hh) < r32) ? wv : 1.0f; p[r] = wv; }
    float go[4], t[4];
#pragma unroll
    for (int i = 0; i < 4; ++i) { p[4 * i + 2] *= p[4 * i + 3]; p[4 * i + 1] *= p[4 * i + 2]; p[4 * i] *= p[4 * i + 1];
        const auto rr = __builtin_amdgcn_permlane32_swap(__float_as_uint(p[4 * i]), __float_as_uint(p[4 * i]), false, false);
        go[i] = __uint_as_float(rr[1]); t[i] = __uint_as_float(rr[0]) * __uint_as_float(rr[1]); }
    const float R2 = t[3], R1 = t[3] * t[2], R0 = R1 * t[1];
    float E[4];
    E[3] = carry * (hh ? 1.0f : go[3]); E[2] = carry * R2 * (hh ? 1.0f : go[2]); E[1] = carry * R1 * (hh ? 1.0f : go[1]); E[0] = carry * R0 * (hh ? 1.0f : go[0]);
    carry = carry * R0 * t[0];
    float A[16];
#pragma unroll
    for (int i = 0; i < 4; ++i) { const float I3 = E[i] * p[4 * i + 3], I2 = E[i] * p[4 * i + 2], I1 = E[i] * p[4 * i + 1], I0 = E[i] * p[4 * i];
        A[4 * i + 3] = E[i] - I3; A[4 * i + 2] = I3 - I2; A[4 * i + 1] = I2 - I1; A[4 * i] = I1 - I0; }
    const bf16x8 pf0 = pack8(A), pf1 = pack8(A + 8);
#pragma unroll
    for (int dh = 0; dh < 2; ++dh) {
        const bf16x8 v0 = vfrag(vbuf + dh * 4096 + (32 * sub) * 64), v1 = vfrag(vbuf + dh * 4096 + (32 * sub + 16) * 64);
        o[dh] = __builtin_amdgcn_mfma_f32_32x32x16_bf16(pf0, v0, o[dh], 0, 0, 0);
        o[dh] = __builtin_amdgcn_mfma_f32_32x32x16_bf16(pf1, v1, o[dh], 0, 0, 0);
    }
}

__device__ __forceinline__ void attnA_phase(LAS unsigned char* lds, const bf16_t* __restrict__ QKV, bf16_t* __restrict__ O, int tid, int lane, int wid) {
    const int r32 = lane & 31, hh = lane >> 5;
    int kaddr[4];
#pragma unroll
    for (int dk = 0; dk < 4; ++dk) { const int c = 2 * dk + hh; kaddr[dk] = c * 1024 + ((r32 ^ c) << 4); }
    const int vlane = (4 * hh + ((lane & 15) >> 2)) * 64 + ((lane >> 4) & 1) * 32 + (lane & 3) * 8;
    LAS unsigned* flags = (LAS unsigned*)(lds + 32768);
    const int lkey = tid >> 3, lc = tid & 7;
    const int kwoff = lc * 1024 + ((lkey ^ lc) << 4), vwoff = 16384 + (lc >> 2) * 4096 + lkey * 64 + (lc & 3) * 16;
    for (int u = blockIdx.x; u < BATCH * NH * 8; u += gridDim.x) {
        const int bh = u >> 3, qb = ((u & 7) + (u >> 8)) & 7, b = bh >> 4, h = bh & 15;
        const size_t rowbase = (size_t)b * SEQ; const int q0 = qb * 256, R0 = q0 + 32 * wid;
        bf16x8 qf[4];
        { const bf16_t* qp = QKV + (rowbase + R0 + r32) * 3072 + h * 64 + 8 * hh;
#pragma unroll
          for (int dk = 0; dk < 4; ++dk) qf[dk] = *(const bf16x8*)(qp + 16 * dk); }
        const bf16_t* kvg = QKV + (rowbase + lkey) * 3072 + 1024 + h * 64 + 8 * lc;
        const int NT = 4 * qb + 4;
        { const bf16_t* kg = kvg + (size_t)(64 * (NT - 1)) * 3072; const u32x4 kr = *(const u32x4*)kg, vr = *(const u32x4*)(kg + 1024);
          *(LAS u32x4*)(lds + kwoff) = kr; *(LAS u32x4*)(lds + vwoff) = vr; }
        __syncthreads();
        float carry = 1.0f; f32x16 o[2]; o[0] = f32x16{}; o[1] = f32x16{};
        int cur = 0;
        for (int kt = NT - 1; kt >= 0; --kt) {
            u32x4 kr, vr;
            if (kt > 0) { const bf16_t* kg = kvg + (size_t)(64 * (kt - 1)) * 3072; kr = *(const u32x4*)kg; vr = *(const u32x4*)(kg + 1024); }
            const int diff = R0 - 64 * kt;
            const LAS unsigned char* kbuf = lds + cur * 8192; const LAS unsigned char* vbuf = lds + 16384 + cur * 8192 + vlane;
            bool walive = __any(carry >= 1.17549435e-38f);
            if (walive) {
            if (diff >= 64) { sb_subtile<false>(kbuf, vbuf, 1, qf, kaddr, carry, o, r32, hh); sb_subtile<false>(kbuf, vbuf, 0, qf, kaddr, carry, o, r32, hh); }
            else if (diff == 32) { sb_subtile<true>(kbuf, vbuf, 1, qf, kaddr, carry, o, r32, hh); sb_subtile<false>(kbuf, vbuf, 0, qf, kaddr, carry, o, r32, hh); }
            else if (diff == 0) { sb_subtile<true>(kbuf, vbuf, 0, qf, kaddr, carry, o, r32, hh); }
            walive = __any(carry >= 1.17549435e-38f); }
            if (kt > 0) { *(LAS u32x4*)(lds + (cur ^ 1) * 8192 + kwoff) = kr; *(LAS u32x4*)(lds + (cur ^ 1) * 8192 + vwoff) = vr; }
            if (lane == 0) flags[cur * 8 + wid] = walive ? 1u : 0u;
            __syncthreads();
            const u32x4 f0 = *(const LAS u32x4*)(flags + cur * 8), f1 = *(const LAS u32x4*)(flags + cur * 8 + 4);
            cur ^= 1;
            if (((f0.x | f0.y) | (f0.z | f0.w) | (f1.x | f1.y) | (f1.z | f1.w)) == 0u) break;
        }
        { LAS bf16_t* stg = (LAS bf16_t*)(lds + 36864 + wid * 4096);
#pragma unroll
          for (int r = 0; r < 16; ++r) { const int qq = crow(r, hh);
#pragma unroll
              for (int dh = 0; dh < 2; ++dh) stg[qq * 64 + 32 * dh + r32] = (bf16_t)(cvtpk(o[dh][r], 0.f) & 0xffffu); }
          LDS_WAIT();
          bf16_t* op = O + (rowbase + R0) * DM + h * 64;
#pragma unroll
          for (int i = 0; i < 4; ++i) { const int row = (lane >> 3) + 8 * i, ch = lane & 7; const u32x4 v = *(const LAS u32x4*)(stg + row * 64 + ch * 8); *(u32x4*)(op + (size_t)row * DM + ch * 8) = v; }
          LDS_WAIT(); }
    }
}

template <int DL, bool FINAL> __device__ __forceinline__ void attnB_phase(LAS unsigned char* lds, const bf16_t* __restrict__ QKV, bf16_t* O, float* lse_out, const float* __restrict__ BT,
                                                                          const bf16_t* O1, const float* lse0, const float* lse1, int tid, int lane, int wid) {
    constexpr int NB = 16 / DL;
    const int r32 = lane & 31, hh = lane >> 5, half = wid >> 2, wq = wid & 3, ht = tid & 255;
    LAS unsigned char* hb = lds + half * 65536;
    LAS float* bl = (LAS float*)(lds + 131072 + half * 768);
    LAS float* scr = (LAS float*)(lds + 131072 + 1536 + wid * 512);
    LAS bf16_t* stg = (LAS bf16_t*)(lds + 131072 + 1536 + 4096 + wid * 2048);
    int kaddr[4];
#pragma unroll
    for (int dk = 0; dk < 4; ++dk) { const int c = 2 * dk + hh; kaddr[dk] = c * 2048 + ((r32 ^ c) << 4); }
    const int vlane = 16384 + (4 * hh + ((lane & 15) >> 2)) * 64 + ((lane >> 4) & 1) * 32 + (lane & 3) * 8;
    const int key_in = ht >> 3, c8 = ht & 7;
    const int kwo = c8 * 2048 + ((key_in ^ c8) << 4), vwo = 16384 + (c8 >> 2) * 8192 + key_in * 64 + (c8 & 3) * 16;
#define BLK_ISSUE(nblk, rres) do { _Pragma("unroll") for (int i_ = 0; i_ < 4; ++i_) { const bf16_t* kg_ = kvbase + (size_t)(((nblk) * 128 + 32 * i_ + key_in) * DL + (rres)) * 3072; \
        kr[i_] = *(const u32x4*)kg_; vr[i_] = *(const u32x4*)(kg_ + 1024); } } while (0)
#define BLK_WRITE(slot) do { _Pragma("unroll") for (int i_ = 0; i_ < 4; ++i_) { *(LAS u32x4*)(hb + (slot) * 32768 + kwo + 512 * i_) = kr[i_]; *(LAS u32x4*)(hb + (slot) * 32768 + vwo + 2048 * i_) = vr[i_]; } } while (0)
    for (int hidx = blockIdx.x; hidx < BATCH * NH; hidx += gridDim.x) {
        const int ub = (2 * hidx + half) * 8, bh = ub >> 4, b = bh >> 4, h = bh & 15;
        const bf16_t* kvbase = QKV + (size_t)b * SEQ * 3072 + 1024 + h * 64 + 8 * c8;
        const bf16_t* qbase = QKV + (size_t)b * SEQ * 3072 + h * 64 + 8 * hh;
        u32x4 kr[4], vr[4]; bf16x8 qf[4];
        __syncthreads();
        { const int cc = ub & 15, rr = cc / NB, n = cc % NB;
          BLK_ISSUE(n, rr); BLK_WRITE(n & 1);
          if (n > 0) { BLK_ISSUE(n - 1, rr); BLK_WRITE((n - 1) & 1); }
          if (ht < 192) bl[ht] = BT[h * 192 + ht];
          const bf16_t* qp = qbase + (size_t)((n * 128 + 32 * wq + r32) * DL + rr) * 3072;
#pragma unroll
          for (int dk = 0; dk < 4; ++dk) qf[dk] = *(const bf16x8*)(qp + 16 * dk); }
        __syncthreads();
        for (int i = 0; i < 8; ++i) {
            const int cc = (ub + i) & 15, rr = cc / NB, n = cc % NB;
            bf16x8 qn[4]; int n2 = 0;
            if (i < 7) { const int cc2 = (ub + i + 1) & 15, rr2 = cc2 / NB; n2 = cc2 % NB; BLK_ISSUE(n2, rr2);
                const bf16_t* qp = qbase + (size_t)((n2 * 128 + 32 * wq + r32) * DL + rr2) * 3072;
#pragma unroll
                for (int dk = 0; dk < 4; ++dk) qn[dk] = *(const bf16x8*)(qp + 16 * dk); }
            const int jstart = (n == 0) ? (4 - wq) : 0;
            const int par = (n - 1) & 1;
            const LAS float* blp = bl + 160 + r32 - 4 * hh;
            float mx = -INFINITY, l = 0.f; f32x16 o[2]; o[0] = f32x16{}; o[1] = f32x16{};
#pragma unroll
            for (int jj = 0; jj < 5; ++jj) {
                if (jj >= jstart) {
                    const int j = wq + jj; const LAS unsigned char* kb = hb + (par ^ (j >> 2)) * 32768 + (j & 3) * 512;
                    f32x16 s = {};
#pragma unroll
                    for (int dk = 0; dk < 4; ++dk) { const bf16x8 kf = *(const LAS bf16x8*)(kb + kaddr[dk]); s = __builtin_amdgcn_mfma_f32_32x32x16_bf16(kf, qf[dk], s, 0, 0, 0); }
                    float rm = -INFINITY;
#pragma unroll
                    for (int r = 0; r < 16; ++r) { const int kk = crow(r, hh); float v = s[r] + blp[-(32 * jj + (r & 3) + 8 * (r >> 2))];
                        if (jj == 0) v = (kk >= r32) ? v : -INFINITY;
                        if (jj == 4) v = (kk <= r32) ? v : -INFINITY;
                        s[r] = v; rm = fmaxf(rm, v); }
                    rm = fmaxf(rm, __shfl_xor(rm, 32));
                    const bool up = rm > mx + 8.0f;
                    if (__any(up)) {
                        const float mnew = up ? rm : mx; const float f = __builtin_amdgcn_exp2f(mx - mnew); l *= f; mx = mnew;
                        if (hh == 0) scr[r32] = f;
                        LDS_WAIT();
#pragma unroll
                        for (int r = 0; r < 16; ++r) { const float fr = scr[crow(r, hh)]; o[0][r] *= fr; o[1][r] *= fr; }
                        LDS_WAIT();
                    }
                    float pe[16];
#pragma unroll
                    for (int r = 0; r < 16; ++r) { pe[r] = __builtin_amdgcn_exp2f(s[r] - mx); l += pe[r]; }
                    const bf16x8 pf0 = pack8(pe), pf1 = pack8(pe + 8);
                    const LAS unsigned char* vb = hb + (par ^ (j >> 2)) * 32768 + (j & 3) * 2048 + vlane;
#pragma unroll
                    for (int dh = 0; dh < 2; ++dh) {
                        const bf16x8 v0 = vfrag(vb + dh * 8192), v1 = vfrag(vb + dh * 8192 + 16 * 64);
                        o[dh] = __builtin_amdgcn_mfma_f32_32x32x16_bf16(pf0, v0, o[dh], 0, 0, 0);
                        o[dh] = __builtin_amdgcn_mfma_f32_32x32x16_bf16(pf1, v1, o[dh], 0, 0, 0);
                    }
                }
            }
            l += __shfl_xor(l, 32);
            const float lse2 = mx + __builtin_amdgcn_logf(l);
            const size_t rowq0 = (size_t)b * SEQ + (size_t)((n * 128 + 32 * wq) * DL + rr);
            if (hh == 0) { scr[r32] = __builtin_amdgcn_rcpf(l);
                if (!FINAL) lse_out[(rowq0 + (size_t)r32 * DL) * 16 + h] = lse2;
                else { const size_t rg = (rowq0 + (size_t)r32 * DL) * 16 + h; const float l0 = lse0[rg], l1 = lse1[rg];
                    const float M = fmaxf(fmaxf(l0, l1), lse2); const float e0 = __builtin_amdgcn_exp2f(l0 - M), e1 = __builtin_amdgcn_exp2f(l1 - M), e2 = __builtin_amdgcn_exp2f(lse2 - M);
                    const float inv = __builtin_amdgcn_rcpf(e0 + e1 + e2); scr[32 + r32] = e0 * inv; scr[64 + r32] = e1 * inv; scr[96 + r32] = e2 * inv; } }
            LDS_WAIT();
            float linv[16];
#pragma unroll
            for (int r = 0; r < 16; ++r) linv[r] = scr[crow(r, hh)];
#pragma unroll
            for (int dh = 0; dh < 2; ++dh) {
#pragma unroll
                for (int r = 0; r < 16; ++r) stg[crow(r, hh) * 32 + r32] = (bf16_t)(cvtpk(o[dh][r] * linv[r], 0.f) & 0xffffu);
                LDS_WAIT();
#pragma unroll
                for (int i = 0; i < 2; ++i) { const int row = (lane >> 2) + 16 * i, ch = lane & 3; u32x4 v = *(const LAS u32x4*)(stg + row * 32 + ch * 8);
                    bf16_t* op = O + (rowq0 + (size_t)row * DL) * DM + h * 64 + 32 * dh + ch * 8;
                    if (FINAL) { const u32x4 a0 = *(const u32x4*)op, a1 = *(const u32x4*)(O1 + (rowq0 + (size_t)row * DL) * DM + h * 64 + 32 * dh + ch * 8);
                        const float w0 = scr[32 + row], w1 = scr[64 + row], w2 = scr[96 + row];
#define CMB(c) cvtpk(w0 * bf_lo(a0.c) + w1 * bf_lo(a1.c) + w2 * bf_lo(v.c), w0 * bf_hi(a0.c) + w1 * bf_hi(a1.c) + w2 * bf_hi(v.c))
                        u32x4 w; w.x = CMB(x); w.y = CMB(y); w.z = CMB(z); w.w = CMB(w); v = w;
#undef CMB
                    }
                    *(u32x4*)op = v; }
                LDS_WAIT();
            }
            __syncthreads();
            if (i < 7) { BLK_WRITE(n2 & 1);
#pragma unroll
                for (int dk = 0; dk < 4; ++dk) qf[dk] = qn[dk]; }
            __syncthreads();
        }
    }
#undef BLK_ISSUE
#undef BLK_WRITE
}

#define XB_TMO      128
#define XB_XCNT(j)  (256  + 64 * (j))
#define XB_XSUB(j)  (1280 + 64 * (j))
#define XB_XGEN(j)  (2304 + 64 * (j))
#define XB_TOP      3328
#define XB_TOPGEN   3392
#define XCD_BAR_WORDS 3456
#define XB_SPIN_CAP (1u << 18)

__device__ __forceinline__ unsigned xb_ld(unsigned* p)              { return __hip_atomic_load(p, __ATOMIC_RELAXED, __HIP_MEMORY_SCOPE_AGENT); }
__device__ __forceinline__ unsigned xb_add(unsigned* p, unsigned v) { return __hip_atomic_fetch_add(p, v, __ATOMIC_RELAXED, __HIP_MEMORY_SCOPE_AGENT); }
__device__ __forceinline__ unsigned xb_xcc_id() { return (unsigned)__builtin_amdgcn_s_getreg((3 << 11) | 20) & 0xFu; }
#define XB_SPIN(cond, bar) do { unsigned _sp = 0; while (cond) { __builtin_amdgcn_s_sleep(1); \
    if ((++_sp & 255u) == 0u) { if (xb_ld(&(bar)[XB_TMO])) break; if (_sp > XB_SPIN_CAP) { atomicAdd(&(bar)[XB_TMO], 1u); break; } } } } while (0)

struct XcdBarrier {
    unsigned* bar; unsigned x;
    volatile LAS unsigned* st;
};

__device__ __forceinline__ XcdBarrier xcd_barrier_post(unsigned* bar, volatile LAS unsigned* st) {
    XcdBarrier b; b.bar = bar; b.x = xb_xcc_id(); b.st = st;
    if (threadIdx.x == 0) (void)xb_add(&bar[XB_XCNT(b.x)], 1u);
    return b;
}
__device__ __forceinline__ void xcd_barrier_complete(unsigned* bar, unsigned x, unsigned& nloc, unsigned& nx) {
    const unsigned G = gridDim.x * gridDim.y * gridDim.z;
    unsigned sum, cnt, mine, sp = 0u;
    for (;;) {
        sum = 0u; cnt = 0u; mine = 0u;
#pragma unroll
        for (unsigned j = 0; j < 16; ++j) { const unsigned c = xb_ld(&bar[XB_XCNT(j)]); sum += c; cnt += (c > 0u) ? 1u : 0u; mine = (j == x) ? c : mine; }
        if (sum == G) break;
        __builtin_amdgcn_s_sleep(1);
        if ((++sp & 255u) == 0u) { if (xb_ld(&bar[XB_TMO])) break; if (sp > XB_SPIN_CAP) { atomicAdd(&bar[XB_TMO], 1u); break; } }
    }
    nloc = mine > 0u ? mine : 1u; nx = cnt > 0u ? cnt : 1u;
}

__device__ __forceinline__ void xcd_barrier(const XcdBarrier& b) {
    asm volatile("s_waitcnt vmcnt(0)" ::: "memory");
    __syncthreads();
    if (threadIdx.x == 0) {
        unsigned* bar = b.bar; asm volatile("" : "+s"(bar)); unsigned bx = b.x; asm volatile("" : "+s"(bx));
        __builtin_amdgcn_s_waitcnt(0);
        unsigned nloc = b.st[0], nx = b.st[1];
        if (nloc == 0u) { xcd_barrier_complete(bar, bx, nloc, nx); b.st[0] = nloc; b.st[1] = nx; }
        const unsigned old = xb_add(&bar[XB_XSUB(bx)], 1u);
        const unsigned gen = old / nloc;
        if (old + 1u == (gen + 1u) * nloc) {
            __builtin_amdgcn_fence(__ATOMIC_RELEASE, "agent");
            asm volatile("s_waitcnt vmcnt(0)" ::: "memory");
            const unsigned og = xb_add(&bar[XB_TOP], 1u);
            const unsigned tg = og / nx;
            if (og + 1u == (tg + 1u) * nx) xb_add(&bar[XB_TOPGEN], 1u);
            else XB_SPIN(xb_ld(&bar[XB_TOPGEN]) == tg, bar);
            __builtin_amdgcn_fence(__ATOMIC_ACQUIRE, "agent");
            asm volatile("s_waitcnt vmcnt(0)" ::: "memory");
        } else {
            XB_SPIN(xb_ld(&bar[XB_TOPGEN]) == gen, bar);
            __builtin_amdgcn_fence(__ATOMIC_ACQUIRE, "agent");
            asm volatile("s_waitcnt vmcnt(0)" ::: "memory");
        }
    }
    __syncthreads();
}

constexpr int PROBE_BAR = 0;
constexpr int PROBE_DUP = -1;
enum { K_PRO = 0, K_GS, K_GW, K_NR, K_AA, K_AB0, K_AB1, K_AB2 };
__global__ void __launch_bounds__(512, 2) yoco_fwd(Params P) {
    extern __shared__ __attribute__((aligned(16))) unsigned char lds_raw[];
    LAS unsigned char* lds = (LAS unsigned char*)lds_raw;
    cg::grid_group grid = cg::this_grid();
    volatile LAS unsigned* xst = (volatile LAS unsigned*)(lds + LDS_BYTES - 16);
    if (threadIdx.x < 4) xst[threadIdx.x] = 0u;
    __syncthreads();
    XcdBarrier xb = xcd_barrier_post((unsigned*)P.ws, xst);
    grid.sync();
#define PH_BEGIN() int tid = threadIdx.x; asm volatile("" : "+v"(tid)); const int lane = tid & 63, wid = __builtin_amdgcn_readfirstlane(tid >> 6); \
        unsigned char* ws = P.ws; asm volatile("" : "+s"(ws)); (void)lane; (void)wid;
#define BARRIER() do { for (int k_ = 0; k_ < 1 + PROBE_BAR; ++k_) xcd_barrier(xb); } while (0)
#define REPS(ph) for (int rep_ = 0; rep_ < ((PROBE_DUP == (ph)) ? 2 : 1); ++rep_)
#define PH_GS(ph, AOFF, BOFF, N_, K_, OOFF, RSP) { PH_BEGIN(); REPS(ph) { pg8::Gemm g{(const bf16_t*)(ws + (AOFF)), (const bf16_t*)(ws + (BOFF)), MROWS, N_, K_}; pg8::StaticOrder S; S.init(MROWS, N_, (int)gridDim.x, (int)blockIdx.x); \
        pg8::EpiStore E{(bf16_t*)(ws + (OOFF)), N_, RSP}; pg8::gemm_phase<pg8::EpiStore, pg8::StaticOrder, true, true>(lds, g, S, E); } } BARRIER();
#define PH_GW(ph, BOFF) { PH_BEGIN(); REPS(ph) { pg8::Gemm g{(const bf16_t*)(ws + WS_XN), (const bf16_t*)(ws + (BOFF)), MROWS, 2 * DFF, DM}; pg8::StaticOrder S; S.init(MROWS, 2 * DFF, (int)gridDim.x, (int)blockIdx.x); \
        pg8::EpiSwiglu E{(bf16_t*)(ws + WS_ACT), DFF, (const float*)(ws + WS_RS)}; pg8::gemm_phase<pg8::EpiSwiglu, pg8::StaticOrder, true, true>(lds, g, S, E); } } BARRIER();
#define PH_NR(XIN32, OUT32, GI) { PH_BEGIN(); norm_res_phase<XIN32, OUT32>((const bf16_t*)(ws + WS_H), P.gains + (GI) * DM, P.x, (bf16_t*)(ws + WS_XN), (float*)(ws + WS_RS), P.out, lane, wid); }
#define RSV ((const float*)(ws + WS_RS))
#define RS0 ((const float*)nullptr)
    { PH_BEGIN(); REPS(0) { prologue(P, lds, tid, lane, wid); } } BARRIER();
    PH_GS(1, WS_XN, WS_WQKVA, 3072, 1024, WS_QKV, RSV)
    { PH_BEGIN(); REPS(2) { attnA_phase(lds, (const bf16_t*)(ws + WS_QKV), (bf16_t*)(ws + WS_OB), tid, lane, wid); } } BARRIER();
    PH_GS(3, WS_OB, WS_WOA, 1024, 1024, WS_H, RS0)
    PH_NR(true, false, 1) BARRIER();
    PH_GW(5, WS_WGU0)
    PH_GS(6, WS_ACT, WS_WD0, 1024, DFF, WS_H, RS0)
    PH_NR(false, false, 3) BARRIER();
    PH_GS(8, WS_XN, WS_WB, 3072, 1024, WS_QKV, RSV)
    { PH_BEGIN(); REPS(9) { attnB_phase<1, false>(lds, (const bf16_t*)(ws + WS_QKV), (bf16_t*)(ws + WS_OB), (float*)(ws + WS_LSE0), (const float*)(ws + WS_BIAS), nullptr, nullptr, nullptr, tid, lane, wid); } } BARRIER();
    PH_GS(10, WS_XN, WS_WB + 6 * MiB, 3072, 1024, WS_QKV, RSV)
    { PH_BEGIN(); REPS(11) { attnB_phase<4, false>(lds, (const bf16_t*)(ws + WS_QKV), (bf16_t*)(ws + WS_H), (float*)(ws + WS_LSE1), (const float*)(ws + WS_BIAS) + 3072, nullptr, nullptr, nullptr, tid, lane, wid); } } BARRIER();
    PH_GS(12, WS_XN, WS_WB + 12 * MiB, 3072, 1024, WS_QKV, RSV)
    { PH_BEGIN(); attnB_phase<16, true>(lds, (const bf16_t*)(ws + WS_QKV), (bf16_t*)(ws + WS_OB), nullptr, (const float*)(ws + WS_BIAS) + 6144, (const bf16_t*)(ws + WS_H), (const float*)(ws + WS_LSE0), (const float*)(ws + WS_LSE1), tid, lane, wid); } BARRIER();
    PH_GS(14, WS_OB, WS_WOB, 1024, 1024, WS_H, RS0)
    PH_NR(false, false, 5) BARRIER();
    PH_GW(16, WS_WGU1)
    PH_GS(17, WS_ACT, WS_WD1, 1024, DFF, WS_H, RS0)
    PH_NR(false, true, 7)
}

extern "C" void kernel_launch(void* const* d_in, const int* in_sizes, int n_in, void* d_out, int out_size, void* d_ws, size_t ws_size, hipStream_t stream) {
    static int grid = 0;
    if (grid == 0) {
        if (n_in != 11 || out_size != MROWS * DM || ws_size < WS_END) { fprintf(stderr, "kernel_launch: unexpected shapes (n_in %d, out %d, ws %zu)\n", n_in, out_size, ws_size); grid = -1; return; }
        int dev = 0, cus = 0, per_cu = 0;
        (void)hipGetDevice(&dev); (void)hipDeviceGetAttribute(&cus, hipDeviceAttributeMultiprocessorCount, dev);
        if (hipFuncSetAttribute((const void*)yoco_fwd, hipFuncAttributeMaxDynamicSharedMemorySize, LDS_BYTES) != hipSuccess) { fprintf(stderr, "kernel_launch: hipFuncSetAttribute failed\n"); grid = -1; return; }
        if (hipOccupancyMaxActiveBlocksPerMultiprocessor(&per_cu, (const void*)yoco_fwd, 512, LDS_BYTES) != hipSuccess || per_cu < 1) { fprintf(stderr, "kernel_launch: occupancy query failed (%d)\n", per_cu); per_cu = 1; }
        (void)hipGetLastError();
        grid = cus * per_cu;
        if (grid <= 0) grid = 256;
    }
    if (grid < 0) return;
    if (hipMemsetAsync(d_ws, 0, 131072, stream) != hipSuccess) { fprintf(stderr, "kernel_launch: memset failed\n"); return; }
    Params p{};
    p.x = (const float*)d_in[0]; p.gains = (const float*)d_in[1]; p.w_qkv_a = (const float*)d_in[2]; p.w_o_a = (const float*)d_in[3]; p.g_kv = (const float*)d_in[4];
    p.w_kv_b = (const float*)d_in[5]; p.w_q_b = (const float*)d_in[6]; p.w_o_b = (const float*)d_in[7]; p.rel_bias = (const float*)d_in[8]; p.w_gu = (const float*)d_in[9]; p.w_down = (const float*)d_in[10];
    p.out = (float*)d_out; p.ws = (unsigned char*)d_ws;
    void* args[] = {&p};
    const hipError_t e = hipLaunchCooperativeKernel((const void*)yoco_fwd, dim3(grid), dim3(512), args, LDS_BYTES, stream);
    if (e != hipSuccess) fprintf(stderr, "kernel_launch: cooperative launch failed: %s (grid %d)\n", hipGetErrorString(e), grid);
}
```

```cpp
#include <hip/hip_runtime.h>
#include <hip/hip_cooperative_groups.h>
#include <cstdio>
#include <cstdint>
namespace cg = cooperative_groups;
namespace pg8 {
#define PG8_LAS __attribute__((address_space(3)))
typedef unsigned short bf16_t;
typedef short bf16x8 __attribute__((ext_vector_type(8)));
typedef float f32x4 __attribute__((ext_vector_type(4)));
typedef unsigned u32x4 __attribute__((ext_vector_type(4)));
constexpr int BM = 256, BK = 64, HALF = 128, HTB = HALF * BK * 2  , STAGE_BYTES = 8 * HTB, NXCD = 8, WGM = 8;

__host__ __device__ __forceinline__ int lds_byte(int r, int c) { const int st = (r >> 4) * 2 + (c >> 5), rr = r & 15, cc = c & 31, ob = rr * 64 + cc * 2; return st * 1024 + (ob ^ (((ob >> 9) & 1) << 5)); }
__host__ __device__ __forceinline__ void stage_rc(int b, int& R, int& C) { const int st = b / 1024, sb = b % 1024, swz = sb ^ (((sb >> 9) & 1) << 5); R = (st >> 1) * 16 + swz / 64; C = (st & 1) * 32 + (swz % 64) / 2; }
__host__ __device__ __forceinline__ int perm32(int rho) { const int n = rho >> 4, i = rho & 15; return 8 * (i >> 2) + 4 * n + (i & 3); }

struct Unit { int pm, pn; };
struct Gemm { const bf16_t* A; const bf16_t* Bt; int M, N, K; };

struct StaticOrder {
    int nM, nN, nwg, G, c;
    __host__ __device__ void init(int M, int N, int G_, int c_) { nM = M / BM; nN = N / BM; nwg = nM * nN; G = G_; c = c_; }
    __host__ __device__ bool next(int i, Unit& u) const {
        const long L = (long)i * G + c; if (L >= nwg) return false;
        int wgid = (int)L; { const int q = nwg / NXCD, r = nwg % NXCD, xcd = wgid % NXCD, off = wgid / NXCD; wgid = (xcd < r ? xcd * (q + 1) : r * (q + 1) + (xcd - r) * q) + off; }
        const int nig = WGM * nN, gid = wgid / nig, fm = gid * WGM, gsz = (nM - fm) < WGM ? (nM - fm) : WGM;
        u.pm = fm + ((wgid % nig) % gsz); u.pn = (wgid % nig) / gsz; return true;
    }
    __device__ __forceinline__ void a_ready(const Unit&) const {}
    __device__ __forceinline__ void done(const Unit&) const {}
};


typedef float f32x2_t __attribute__((ext_vector_type(2))); typedef __bf16 bf16x2_t __attribute__((ext_vector_type(2)));
__device__ __forceinline__ unsigned cvtpk(float lo, float hi) { f32x2_t v = {lo, hi}; bf16x2_t b = __builtin_convertvector(v, bf16x2_t); return __builtin_bit_cast(unsigned, b); }

struct EpiStore {
    static constexpr bool PERM = true, AFTER_DRAIN = false, FUSED = false, HAS_RS = true;
    bf16_t* O; int ldc; const float* rs;
    __device__ __forceinline__ void operator()(const f32x4 (&acc)[2][2][4][2], const Unit& u, int wr, int wc, int fr, int fq, const PG8_LAS float* rsl) const {
        const int row0 = u.pm * BM + wr * 64 + fr; const int col0 = u.pn * BM + wc * 32 + 8 * fq;
#pragma unroll
        for (int ai = 0; ai < 2; ++ai)
#pragma unroll
            for (int m = 0; m < 4; ++m) { bf16_t* rowp = O + (size_t)(row0 + ai * HALF + m * 16) * ldc + col0; const float sc = rs ? rsl[wr * 64 + fr + ai * HALF + m * 16] : 1.0f;
#pragma unroll
                for (int bj = 0; bj < 2; ++bj) { const f32x4 v0 = acc[ai][bj][m][0] * sc, v1 = acc[ai][bj][m][1] * sc;
                    u32x4 w; w.x = cvtpk(v0[0], v0[1]); w.y = cvtpk(v0[2], v0[3]); w.z = cvtpk(v1[0], v1[1]); w.w = cvtpk(v1[2], v1[3]);
                    *(u32x4*)(rowp + bj * HALF) = w; } }
    }
};
struct EpiSwiglu {
    static constexpr bool PERM = true, AFTER_DRAIN = false, FUSED = false, HAS_RS = true;
    bf16_t* O; int ldc; const float* rs;
    __device__ __forceinline__ float act(float g, float u) const { const float e = __builtin_amdgcn_exp2f(-1.4426950408889634f * g); return g * u * __builtin_amdgcn_rcpf(1.0f + e); }
    __device__ __forceinline__ void operator()(const f32x4 (&acc)[2][2][4][2], const Unit& u, int wr, int wc, int fr, int fq, const PG8_LAS float* rsl) const {
        const int row0 = u.pm * BM + wr * 64 + fr; const int col0 = u.pn * HALF + wc * 32 + 8 * fq;
#pragma unroll
        for (int ai = 0; ai < 2; ++ai)
#pragma unroll
            for (int m = 0; m < 4; ++m) { bf16_t* rowp = O + (size_t)(row0 + ai * HALF + m * 16) * ldc + col0; const float sc = rsl[wr * 64 + fr + ai * HALF + m * 16];
                const f32x4 g0 = acc[ai][0][m][0] * sc, g1 = acc[ai][0][m][1] * sc, u0 = acc[ai][1][m][0] * sc, u1 = acc[ai][1][m][1] * sc;
                u32x4 w; w.x = cvtpk(act(g0[0], u0[0]), act(g0[1], u0[1])); w.y = cvtpk(act(g0[2], u0[2]), act(g0[3], u0[3]));
                w.z = cvtpk(act(g1[0], u1[0]), act(g1[1], u1[1])); w.w = cvtpk(act(g1[2], u1[2]), act(g1[3], u1[3]));
                *(u32x4*)rowp = w; }
    }
};


template <class Epi, class Sched, bool ALIGN_EPI = false, bool SP2 = false>
__device__ __forceinline__ void gemm_phase(PG8_LAS unsigned char* lds, const Gemm g, const Sched& S, const Epi& E) {
    const int tid = threadIdx.x, wid = __builtin_amdgcn_readfirstlane(tid >> 6), lane = tid & 63, wr = wid >> 2, wc = wid & 3, fr = lane & 15, fq = lane >> 4;
    const int K = g.K, nt = K / BK;
    unsigned voffA, voffB;
    { int R, C; stage_rc(tid * 16, R, C); const int Rb = Epi::PERM ? ((R & ~31) + perm32(R & 31)) : R;
        voffA = (unsigned)(R * K + C) * 2u; voffB = (unsigned)(Rb * K + C) * 2u; }
    const size_t rstep = (size_t)64 * K * 2;
    const size_t kstep = (size_t)(BK * 2);
    const size_t hstep = (size_t)HALF * K * 2;
    const size_t tstep = 2 * hstep;
    const unsigned ldsw = (unsigned)wid * 1024u;
    const int aoff = lds_byte(wr * 64 + fr, fq * 8), boff = lds_byte(wc * 32 + fr, fq * 8);
#define PG8_SA(b, h) (((b) * 2 + (h)) * HTB)
#define PG8_SB(b, h) ((4 + (b) * 2 + (h)) * HTB)
#define PG8_STAGE(bufoff, gbase, voff) do { _Pragma("unroll") for (int _i = 0; _i < 2; ++_i) \
        __builtin_amdgcn_global_load_lds((const unsigned*)((const char*)(gbase) + _i * rstep + (voff)), (PG8_LAS unsigned*)(lds + (bufoff) + ldsw + _i * 8192), 16, 0, 0); } while (0)
#define PG8_LDA(dst, b, h) do { _Pragma("unroll") for (int m = 0; m < 4; ++m) _Pragma("unroll") for (int k = 0; k < 2; ++k) dst[m][k] = *(const PG8_LAS bf16x8*)(lds + PG8_SA(b, h) + aoff + m * 2048 + k * 1024); } while (0)
#define PG8_LDB(dst, b, h) do { _Pragma("unroll") for (int n = 0; n < 2; ++n) _Pragma("unroll") for (int k = 0; k < 2; ++k) dst[n][k] = *(const PG8_LAS bf16x8*)(lds + PG8_SB(b, h) + boff + n * 2048 + k * 1024); } while (0)
#define PG8_MMA(ai, bj, At, Bt) do { __builtin_amdgcn_s_setprio(1); _Pragma("unroll") for (int m = 0; m < 4; ++m) _Pragma("unroll") for (int n = 0; n < 2; ++n) _Pragma("unroll") for (int k = 0; k < 2; ++k) \
        acc[ai][bj][m][n] = __builtin_amdgcn_mfma_f32_16x16x32_bf16(Bt[n][k], At[m][k], acc[ai][bj][m][n], 0, 0, 0); __builtin_amdgcn_s_setprio(0); } while (0)
#define PG8_WAIT_V(n) asm volatile("s_waitcnt vmcnt(" #n ")" ::: "memory")
#define PG8_WAIT_L(n) asm volatile("s_waitcnt lgkmcnt(" #n ")" ::: "memory")
#define PG8_BAR __builtin_amdgcn_s_barrier()
#define PG8_SCHED __builtin_amdgcn_sched_barrier(0)
    Unit cur, nxt; int ui = 0;
    if (!S.next(0, cur)) return;
    f32x4 acc[2][2][4][2];
#pragma unroll
    for (int a = 0; a < 2; ++a)
#pragma unroll
        for (int b = 0; b < 2; ++b)
#pragma unroll
            for (int m = 0; m < 4; ++m)
#pragma unroll
                for (int n = 0; n < 2; ++n) acc[a][b][m][n] = (f32x4){0.f, 0.f, 0.f, 0.f};
    bf16x8 At[4][2], B0[2][2], B1[2][2];
    const char* cA = (const char*)g.A + (size_t)cur.pm * tstep; const char* cB = (const char*)g.Bt + (size_t)cur.pn * tstep;
    S.a_ready(cur);
    if constexpr (SP2) {
        PG8_STAGE(PG8_SB(0, 0), cB, voffB); PG8_STAGE(PG8_SB(0, 1), cB + hstep, voffB); PG8_STAGE(PG8_SA(0, 0), cA, voffA); PG8_STAGE(PG8_SA(0, 1), cA + hstep, voffA);
        if (wr == 1) PG8_BAR;
        PG8_WAIT_V(2); PG8_BAR;
        PG8_STAGE(PG8_SB(1, 0), cB + kstep, voffB); PG8_STAGE(PG8_SA(1, 0), cA + kstep, voffA); PG8_STAGE(PG8_SB(1, 1), cB + hstep + kstep, voffB);
        PG8_WAIT_V(6); PG8_BAR;
    } else {
        PG8_STAGE(PG8_SB(0, 0), cB, voffB); PG8_STAGE(PG8_SA(0, 0), cA, voffA); PG8_STAGE(PG8_SB(0, 1), cB + hstep, voffB); PG8_STAGE(PG8_SA(0, 1), cA + hstep, voffA);
        if (wr == 1) PG8_BAR;
        PG8_WAIT_V(4); PG8_BAR;
        PG8_STAGE(PG8_SB(1, 0), cB + kstep, voffB); PG8_STAGE(PG8_SA(1, 0), cA + kstep, voffA); PG8_STAGE(PG8_SB(1, 1), cB + hstep + kstep, voffB);
        PG8_WAIT_V(6); PG8_BAR;
    }
    for (;;) {
        if constexpr (Epi::HAS_RS) { if (E.rs != nullptr && wid < 4)
            __builtin_amdgcn_global_load_lds((const unsigned*)(E.rs + cur.pm * BM + wid * 64 + lane), (PG8_LAS unsigned*)(lds + STAGE_BYTES + (ui & 1) * 1024 + wid * 256), 4, 0, 0); }
        const bool has_next = S.next(ui + 1, nxt);
        const char* nA = has_next ? (const char*)g.A + (size_t)nxt.pm * tstep : cA; const char* nB = has_next ? (const char*)g.Bt + (size_t)nxt.pn * tstep : cB;
        for (int t = 0; t < nt; t += 2) {
            const bool last = (t == nt - 2);
            const char* a1 = cA + (size_t)(t + 1) * kstep;
            const char* a2 = last ? nA : cA + (size_t)(t + 2) * kstep; const char* b2 = last ? nB : cB + (size_t)(t + 2) * kstep;
            const char* a3 = a2 + kstep; const char* b3 = b2 + kstep;
            if (last && has_next) S.a_ready(nxt);
            if constexpr (SP2) {
            PG8_LDB(B0, 0, 0); PG8_LDB(B1, 0, 1); PG8_SCHED; PG8_LDA(At, 0, 0); PG8_STAGE(PG8_SA(1, 1), a1 + hstep, voffA);
            PG8_WAIT_V(8); PG8_WAIT_L(0); PG8_BAR; PG8_MMA(0, 0, At, B0); PG8_MMA(0, 1, At, B1); PG8_BAR; PG8_SCHED;
            PG8_LDA(At, 0, 1); PG8_STAGE(PG8_SB(0, 0), b2, voffB); PG8_STAGE(PG8_SB(0, 1), b2 + hstep, voffB); PG8_STAGE(PG8_SA(0, 0), a2, voffA);
            PG8_WAIT_V(8); PG8_WAIT_L(0); PG8_BAR; PG8_MMA(1, 0, At, B0); PG8_MMA(1, 1, At, B1); PG8_BAR; PG8_SCHED;
            PG8_LDB(B0, 1, 0); PG8_LDB(B1, 1, 1); PG8_SCHED; PG8_LDA(At, 1, 0); PG8_STAGE(PG8_SA(0, 1), a2 + hstep, voffA);
            PG8_WAIT_V(8); PG8_WAIT_L(0); PG8_BAR; PG8_MMA(0, 0, At, B0); PG8_MMA(0, 1, At, B1); PG8_BAR; PG8_SCHED;
            PG8_LDA(At, 1, 1); PG8_STAGE(PG8_SB(1, 0), b3, voffB); PG8_STAGE(PG8_SB(1, 1), b3 + hstep, voffB); PG8_STAGE(PG8_SA(1, 0), a3, voffA);
            PG8_WAIT_V(8); PG8_WAIT_L(0); PG8_BAR; PG8_MMA(1, 0, At, B0); PG8_MMA(1, 1, At, B1); PG8_BAR; PG8_SCHED;
            } else {
            PG8_LDB(B0, 0, 0); PG8_SCHED; PG8_LDA(At, 0, 0); PG8_STAGE(PG8_SA(1, 1), a1 + hstep, voffA);
            PG8_WAIT_L(8); PG8_BAR; PG8_WAIT_L(0); PG8_MMA(0, 0, At, B0); PG8_BAR; PG8_SCHED;
            PG8_LDB(B1, 0, 1); PG8_STAGE(PG8_SB(0, 0), b2, voffB);
            PG8_BAR; PG8_WAIT_L(0); PG8_MMA(0, 1, At, B1); PG8_BAR;
            PG8_LDA(At, 0, 1); PG8_STAGE(PG8_SA(0, 0), a2, voffA);
            PG8_BAR; PG8_WAIT_L(0); PG8_MMA(1, 0, At, B0); PG8_BAR; PG8_SCHED;
            PG8_STAGE(PG8_SB(0, 1), b2 + hstep, voffB);
            PG8_WAIT_V(6); PG8_BAR; PG8_MMA(1, 1, At, B1); PG8_BAR;
            PG8_LDB(B0, 1, 0); PG8_SCHED; PG8_LDA(At, 1, 0); PG8_STAGE(PG8_SA(0, 1), a2 + hstep, voffA);
            PG8_WAIT_L(8); PG8_BAR; PG8_WAIT_L(0); PG8_MMA(0, 0, At, B0); PG8_BAR; PG8_SCHED;
            PG8_LDB(B1, 1, 1); PG8_STAGE(PG8_SB(1, 0), b3, voffB);
            PG8_BAR; PG8_WAIT_L(0); PG8_MMA(0, 1, At, B1); PG8_BAR;
            PG8_LDA(At, 1, 1); PG8_STAGE(PG8_SA(1, 0), a3, voffA);
            PG8_BAR; PG8_WAIT_L(0); PG8_MMA(1, 0, At, B0); PG8_BAR; PG8_SCHED;
            PG8_STAGE(PG8_SB(1, 1), b3 + hstep, voffB);
            PG8_WAIT_V(6); PG8_BAR; PG8_MMA(1, 1, At, B1); PG8_BAR;
            }
        }
        if constexpr (ALIGN_EPI) { if (wr == 0) PG8_BAR; }
        if constexpr (Epi::FUSED) { E.fused(acc, cur, wr, wc, fr, fq, lds + STAGE_BYTES, wid, lane); } else
        if constexpr (!Epi::AFTER_DRAIN) { E(acc, cur, wr, wc, fr, fq, (const PG8_LAS float*)(lds + STAGE_BYTES + (ui & 1) * 1024)); S.done(cur); }
        if (!has_next) break;
#pragma unroll
        for (int a = 0; a < 2; ++a)
#pragma unroll
            for (int b = 0; b < 2; ++b)
#pragma unroll
                for (int m = 0; m < 4; ++m)
#pragma unroll
                    for (int n = 0; n < 2; ++n) acc[a][b][m][n] = (f32x4){0.f, 0.f, 0.f, 0.f};
        cur = nxt; cA = nA; cB = nB; ++ui;
        if constexpr (ALIGN_EPI) { if (wr == 1) PG8_BAR; }
    }
    PG8_WAIT_V(0);
    if constexpr (!ALIGN_EPI) { if (wr == 0) PG8_BAR; }
    PG8_BAR;
    if constexpr (Epi::AFTER_DRAIN) { E.fused(acc, cur, wr, wc, fr, fq, lds, wid, lane); S.done(cur); }
#undef PG8_SA
#undef PG8_SB
#undef PG8_STAGE
#undef PG8_LDA
#undef PG8_LDB
#undef PG8_MMA
#undef PG8_WAIT_V
#undef PG8_WAIT_L
#undef PG8_BAR
#undef PG8_SCHED
}
}

#define LAS __attribute__((address_space(3)))
typedef pg8::bf16_t bf16_t; typedef pg8::bf16x8 bf16x8; typedef pg8::f32x4 f32x4; typedef pg8::u32x4 u32x4;
typedef float f32x16 __attribute__((ext_vector_type(16)));
typedef unsigned u32x2 __attribute__((ext_vector_type(2)));
typedef short v4i16_t __attribute__((ext_vector_type(4)));
using pg8::cvtpk;

constexpr int BATCH = 16, SEQ = 2048, DM = 1024, NH = 16, HD = 64, DFF = 2816, MROWS = BATCH * SEQ;
constexpr float RMS_EPS = 1e-6f;
constexpr float LOG2E = 1.4426950408889634f;
constexpr float QSCALE = 0.125f * LOG2E;
constexpr size_t MiB = 1u << 20;
constexpr size_t WS_CNT = 16384  , WS_SLOT = 63 * MiB + 65536  ;
constexpr size_t WS_WQKVA = 1 * MiB, WS_WOA = 7 * MiB, WS_WGU0 = 9 * MiB, WS_WD0 = 20 * MiB, WS_WB = 26 * MiB  , WS_WOB = 44 * MiB,
                 WS_WGU1 = 46 * MiB, WS_WD1 = 57 * MiB, WS_BIAS = 63 * MiB, WS_XN = 65 * MiB, WS_QKV = 129 * MiB, WS_ACT = 129 * MiB  ,
                 WS_OB = 321 * MiB, WS_H = 385 * MiB, WS_LSE0 = 449 * MiB, WS_LSE1 = 451 * MiB, WS_RS = 453 * MiB  , WS_END = 454 * MiB;
constexpr int LDS_BYTES = 155648;

struct Params { const float *x, *gains, *w_qkv_a, *w_o_a, *g_kv, *w_kv_b, *w_q_b, *w_o_b, *rel_bias, *w_gu, *w_down; float* out; unsigned char* ws; };

#define LDS_WAIT() asm volatile("s_waitcnt lgkmcnt(0)" ::: "memory")
__device__ __forceinline__ float wave_sum(float v) {
#pragma unroll
    for (int o = 1; o < 64; o <<= 1) v += __shfl_xor(v, o);
    return v;
}
__device__ __forceinline__ int crow(int r, int hi) { return (r & 3) + 8 * (r >> 2) + 4 * hi; }
__device__ __forceinline__ float bf_lo(unsigned w) { return __uint_as_float(w << 16); }
__device__ __forceinline__ float bf_hi(unsigned w) { return __uint_as_float(w & 0xffff0000u); }

__device__ __forceinline__ void conv_item(const float* __restrict__ W, int ldw, int col, int K, const float* __restrict__ gain, float scale, bf16_t* WT, int drow, LAS float* scr, int kb, int lane) {
    const int k0 = 64 * kb, ks = lane >> 3, n4 = lane & 7;
    f32x4 v[8]; float gs[8];
#pragma unroll
    for (int i = 0; i < 8; ++i) { const int kk = 8 * i + ks; v[i] = *(const f32x4*)(W + (size_t)(k0 + kk) * ldw + col + 4 * n4); gs[i] = gain ? gain[k0 + kk] * scale : scale; }
#pragma unroll
    for (int i = 0; i < 8; ++i) { const int kk = 8 * i + ks; LAS float* d = scr + kk * 33 + 4 * n4; d[0] = v[i].x * gs[i]; d[1] = v[i].y * gs[i]; d[2] = v[i].z * gs[i]; d[3] = v[i].w * gs[i]; }
    LDS_WAIT();
    const int c = lane & 7;
#pragma unroll
    for (int j = 0; j < 4; ++j) { const int n = (lane >> 3) + 8 * j; const LAS float* s = scr + (8 * c) * 33 + n;
        u32x4 o; o.x = cvtpk(s[0 * 33], s[1 * 33]); o.y = cvtpk(s[2 * 33], s[3 * 33]); o.z = cvtpk(s[4 * 33], s[5 * 33]); o.w = cvtpk(s[6 * 33], s[7 * 33]);
        *(u32x4*)(WT + (size_t)(drow + n) * K + k0 + 8 * c) = o; }
    LDS_WAIT();
}
template <int MODE> __device__ __forceinline__ void conv_seg(const float* src, int ld, int col0, int ncols, int K, const float* gain, float scale, bf16_t* dst, int drow0,
                                                             LAS float* scr, int gw, int NGW, int& off, int lane) {
    const int nblk = ncols >> 5, items = nblk * (K >> 6);
    int it0 = gw - (off % NGW); if (it0 < 0) it0 += NGW; off += items;
    for (int it = it0; it < items; it += NGW) {
        const int kb = it / nblk, nb = it - kb * nblk, c = 32 * nb; int drow;
        if (MODE == 1) { const int upf = c >= DFF ? 1 : 0, cc = c - upf * DFF; drow = 256 * (cc >> 7) + 128 * upf + (cc & 127); } else drow = drow0 + c;
        conv_item(src, ld, col0 + c, K, gain, scale, dst, drow, scr, kb, lane);
    }
}
__device__ __forceinline__ void norm_row_bf16(const float* xrow, bf16_t* orow, float* rs, int lane) {
    const f32x4* xr = (const f32x4*)xrow + lane;
    f32x4 v[4]; float s = 0.f;
#pragma unroll
    for (int j = 0; j < 4; ++j) { v[j] = xr[64 * j]; s += (v[j].x * v[j].x + v[j].y * v[j].y) + (v[j].z * v[j].z + v[j].w * v[j].w); }
    const float r = 1.0f / sqrtf(wave_sum(s) * (1.f / DM) + RMS_EPS);
    if (lane == 0) *rs = r;
    u32x2* o8 = (u32x2*)orow + lane;
#pragma unroll
    for (int j = 0; j < 4; ++j) { u32x2 w; w.x = cvtpk(v[j].x, v[j].y); w.y = cvtpk(v[j].z, v[j].w); o8[64 * j] = w; }
}
__device__ __forceinline__ void prologue(const Params& P, LAS unsigned char* lds, int tid, int lane, int wave) {
    LAS float* scr = (LAS float*)(lds + wave * 16384);
    const int G = gridDim.x, gw = blockIdx.x * 8 + wave, NGW = G * 8;
    unsigned char* ws = P.ws; int off = 0;
    const float* g00 = P.gains + 0 * DM; const float* g02 = P.gains + 2 * DM; const float* g10 = P.gains + 4 * DM; const float* g12 = P.gains + 6 * DM;
    conv_seg<0>(P.w_qkv_a, 3072, 0, 1024, 1024, g00, QSCALE, (bf16_t*)(ws + WS_WQKVA), 0, scr, gw, NGW, off, lane);
    conv_seg<0>(P.w_qkv_a, 3072, 1024, 2048, 1024, g00, 1.0f, (bf16_t*)(ws + WS_WQKVA), 1024, scr, gw, NGW, off, lane);
    conv_seg<0>(P.w_o_a, 1024, 0, 1024, 1024, nullptr, 1.0f, (bf16_t*)(ws + WS_WOA), 0, scr, gw, NGW, off, lane);
    conv_seg<1>(P.w_gu, 2 * DFF, 0, 2 * DFF, 1024, g02, 1.0f, (bf16_t*)(ws + WS_WGU0), 0, scr, gw, NGW, off, lane);
    conv_seg<0>(P.w_down, 1024, 0, 1024, DFF, nullptr, 1.0f, (bf16_t*)(ws + WS_WD0), 0, scr, gw, NGW, off, lane);
    for (int g = 0; g < 3; ++g) {
        bf16_t* wb = (bf16_t*)(ws + WS_WB + (size_t)g * 6 * MiB);
        conv_seg<0>(P.w_q_b, 3072, 1024 * g, 1024, 1024, g10, QSCALE, wb, 0, scr, gw, NGW, off, lane);
        conv_seg<0>(P.w_kv_b, 6144, 2048 * g, 2048, 1024, P.g_kv, 1.0f, wb, 1024, scr, gw, NGW, off, lane);
    }
    conv_seg<0>(P.w_o_b, 1024, 0, 1024, 1024, nullptr, 1.0f, (bf16_t*)(ws + WS_WOB), 0, scr, gw, NGW, off, lane);
    conv_seg<1>(P.w_gu + (size_t)DM * 2 * DFF, 2 * DFF, 0, 2 * DFF, 1024, g12, 1.0f, (bf16_t*)(ws + WS_WGU1), 0, scr, gw, NGW, off, lane);
    conv_seg<0>(P.w_down + (size_t)DFF * DM, 1024, 0, 1024, DFF, nullptr, 1.0f, (bf16_t*)(ws + WS_WD1), 0, scr, gw, NGW, off, lane);
    bf16_t* XN = (bf16_t*)(ws + WS_XN);
    for (int m = gw; m < MROWS; m += NGW) norm_row_bf16(P.x + (size_t)m * DM, XN + (size_t)m * DM, (float*)(ws + WS_RS) + m, lane);
    float* BT = (float*)(ws + WS_BIAS);
    for (int idx = blockIdx.x * 512 + tid; idx < 3 * 16 * 192; idx += G * 512) {
        const int g = idx / 3072, rem = idx - g * 3072, h = rem / 192, e = rem - h * 192, rel = e - 32; float v = 0.f;
        if (rel >= 0 && rel <= 128) { const int dl = (g == 0) ? 1 : ((g == 1) ? 4 : 16); const int n = rel * dl; int bk;
            if (n < 16) bk = n;
            else { bk = 16 + (n >= 22) + (n >= 30) + (n >= 40) + (n >= 54) + (n >= 73) + (n >= 99) + (n >= 134) + (n >= 182) + (n >= 246) + (n >= 332) + (n >= 450) + (n >= 609) + (n >= 825) + (n >= 1117) + (n >= 1513); }
            v = P.rel_bias[bk * 16 + h] * LOG2E; }
        BT[idx] = v;
    }
}

template <bool XIN32, bool OUT32> __device__ __forceinline__ void norm_res_phase(const bf16_t* H, const float* gain, const float* Xin32, bf16_t* XB, float* RS, float* Out32, int lane, int wave) {
    const int gw = blockIdx.x * 8 + wave, NGW = gridDim.x * 8;
    f32x4 gv[4];
#pragma unroll
    for (int j = 0; j < 4; ++j) gv[j] = *((const f32x4*)gain + lane + 64 * j);
    for (int m = gw; m < MROWS; m += NGW) {
        const u32x2* hp = (const u32x2*)(H + (size_t)m * DM) + lane;
        f32x4 hv[4], xv[4]; float ss = 0.f;
#pragma unroll
        for (int j = 0; j < 4; ++j) { const u32x2 w = hp[64 * j]; hv[j] = (f32x4){bf_lo(w.x), bf_hi(w.x), bf_lo(w.y), bf_hi(w.y)};
            if (XIN32) xv[j] = *((const f32x4*)(Xin32 + (size_t)m * DM) + lane + 64 * j);
            else { const u32x2 xw = *((const u32x2*)(XB + (size_t)m * DM) + lane + 64 * j); xv[j] = (f32x4){bf_lo(xw.x), bf_hi(xw.x), bf_lo(xw.y), bf_hi(xw.y)}; }
            ss += (hv[j].x * hv[j].x + hv[j].y * hv[j].y) + (hv[j].z * hv[j].z + hv[j].w * hv[j].w); }
        const float r = 1.0f / sqrtf(wave_sum(ss) * (1.f / DM) + RMS_EPS);
        float s2 = 0.f;
#pragma unroll
        for (int j = 0; j < 4; ++j) { xv[j] = xv[j] + hv[j] * r * gv[j];
            s2 += (xv[j].x * xv[j].x + xv[j].y * xv[j].y) + (xv[j].z * xv[j].z + xv[j].w * xv[j].w); }
        if (OUT32) { f32x4* op = (f32x4*)(Out32 + (size_t)m * DM) + lane;
#pragma unroll
            for (int j = 0; j < 4; ++j) op[64 * j] = xv[j]; }
        else { const float r2 = 1.0f / sqrtf(wave_sum(s2) * (1.f / DM) + RMS_EPS); if (lane == 0) RS[m] = r2; u32x2* o8 = (u32x2*)(XB + (size_t)m * DM) + lane;
#pragma unroll
            for (int j = 0; j < 4; ++j) { u32x2 w; w.x = cvtpk(xv[j].x, xv[j].y); w.y = cvtpk(xv[j].z, xv[j].w); o8[64 * j] = w; } }
    }
}

__device__ __forceinline__ bf16x8 vfrag(const LAS unsigned char* p) {
    const v4i16_t lo = __builtin_amdgcn_ds_read_tr16_b64_v4i16((LAS v4i16_t*)p);
    const v4i16_t hi = __builtin_amdgcn_ds_read_tr16_b64_v4i16((LAS v4i16_t*)(p + 512));
    return (bf16x8){lo[0], lo[1], lo[2], lo[3], hi[0], hi[1], hi[2], hi[3]};
}
__device__ __forceinline__ bf16x8 pack8(const float* a) {
    u32x4 w; w.x = cvtpk(a[0], a[1]); w.y = cvtpk(a[2], a[3]); w.z = cvtpk(a[4], a[5]); w.w = cvtpk(a[6], a[7]); return __builtin_bit_cast(bf16x8, w);
}

template <bool MASK> __device__ __forceinline__ void sb_subtile(const LAS unsigned char* kbuf, const LAS unsigned char* vbuf  , int sub, const bf16x8 (&qf)[4], const int (&kaddr)[4],
                                                                float& carry, f32x16 (&o)[2], int r32, int hh) {
    f32x16 S = {};
#pragma unroll
    for (int dk = 0; dk < 4; ++dk) { const bf16x8 kf = *(const LAS bf16x8*)(kbuf + kaddr[dk] + sub * 512); S = __builtin_amdgcn_mfma_f32_32x32x16_bf16(kf, qf[dk], S, 0, 0, 0); }
    float p[16];
#pragma unroll
    for (int r = 0; r < 16; ++r) { const float u = __builtin_amdgcn_exp2f(S[r]); float wv = __builtin_amdgcn_rcpf(1.0f + u);
        if (MASK) wv = (crow(r, hh) < r32) ? wv : 1.0f; p[r] = wv; }
    float go[4], t[4];
#pragma unroll
    for (int i = 0; i < 4; ++i) { p[4 * i + 2] *= p[4 * i + 3]; p[4 * i + 1] *= p[4 * i + 2]; p[4 * i] *= p[4 * i + 1];
        const auto rr = __builtin_amdgcn_permlane32_swap(__float_as_uint(p[4 * i]), __float_as_uint(p[4 * i]), false, false);
        go[i] = __uint_as_float(rr[1]); t[i] = __uint_as_float(rr[0]) * __uint_as_float(rr[1]); }
    const float R2 = t[3], R1 = t[3] * t[2], R0 = R1 * t[1];
    float E[4];
    E[3] = carry * (hh ? 1.0f : go[3]); E[2] = carry * R2 * (hh ? 1.0f : go[2]); E[1] = carry * R1 * (hh ? 1.0f : go[1]); E[0] = carry * R0 * (hh ? 1.0f : go[0]);
    carry = carry * R0 * t[0];
    float A[16];
#pragma unroll
    for (int i = 0; i < 4; ++i) { const float I3 = E[i] * p[4 * i + 3], I2 = E[i] * p[4 * i + 2], I1 = E[i] * p[4 * i + 1], I0 = E[i] * p[4 * i];
        A[4 * i + 3] = E[i] - I3; A[4 * i + 2] = I3 - I2; A[4 * i + 1] = I2 - I1; A[4 * i] = I1 - I0; }
    const bf16x8 pf0 = pack8(A), pf1 = pack8(A + 8);
#pragma unroll
    for (int dh = 0; dh < 2; ++dh) {
        const bf16x8 v0 = vfrag(vbuf + dh * 4096 + (32 * sub) * 64), v1 = vfrag(vbuf + dh * 4096 + (32 * sub + 16) * 64);
        o[dh] = __builtin_amdgcn_mfma_f32_32x32x16_bf16(pf0, v0, o[dh], 0, 0, 0);
        o[dh] = __builtin_amdgcn_mfma_f32_32x32x16_bf16(pf1, v1, o[dh], 0, 0, 0);
    }
}

__device__ __forceinline__ void attnA_phase(LAS unsigned char* lds, const bf16_t* __restrict__ QKV, bf16_t* __restrict__ O, int tid, int lane, int wid) {
    const int r32 = lane & 31, hh = lane >> 5;
    int kaddr[4];
#pragma unroll
    for (int dk = 0; dk < 4; ++dk) { const int c = 2 * dk + hh; kaddr[dk] = c * 1024 + ((r32 ^ c) << 4); }
    const int vlane = (4 * hh + ((lane & 15) >> 2)) * 64 + ((lane >> 4) & 1) * 32 + (lane & 3) * 8;
    LAS unsigned* flags = (LAS unsigned*)(lds + 32768);
    const int lkey = tid >> 3, lc = tid & 7;
    const int kwoff = lc * 1024 + ((lkey ^ lc) << 4), vwoff = 16384 + (lc >> 2) * 4096 + lkey * 64 + (lc & 3) * 16;
    bf16x8 qfn[4]; u32x4 k0r, v0r;
#define UNIT_FETCH(uu) do { const int bh_ = (uu) >> 3, qb_ = (((uu) & 7) + ((uu) >> 8)) & 7, b_ = bh_ >> 4, h_ = bh_ & 15; const size_t rb_ = (size_t)b_ * SEQ; \
        const bf16_t* qp_ = QKV + (rb_ + qb_ * 256 + 32 * wid + r32) * 3072 + h_ * 64 + 8 * hh; \
        _Pragma("unroll") for (int dk = 0; dk < 4; ++dk) qfn[dk] = *(const bf16x8*)(qp_ + 16 * dk); \
        const bf16_t* kg_ = QKV + (rb_ + lkey + 64 * (4 * qb_ + 3)) * 3072 + 1024 + h_ * 64 + 8 * lc; k0r = *(const u32x4*)kg_; v0r = *(const u32x4*)(kg_ + 1024); } while (0)
    if ((int)blockIdx.x < BATCH * NH * 8) UNIT_FETCH((int)blockIdx.x);
    for (int u = blockIdx.x; u < BATCH * NH * 8; u += gridDim.x) {
        const int bh = u >> 3, qb = ((u & 7) + (u >> 8)) & 7, b = bh >> 4, h = bh & 15;
        const size_t rowbase = (size_t)b * SEQ; const int q0 = qb * 256, R0 = q0 + 32 * wid;
        bf16x8 qf[4];
#pragma unroll
        for (int dk = 0; dk < 4; ++dk) qf[dk] = qfn[dk];
        const bf16_t* kvg = QKV + (rowbase + lkey) * 3072 + 1024 + h * 64 + 8 * lc;
        const int NT = 4 * qb + 4;
        *(LAS u32x4*)(lds + kwoff) = k0r; *(LAS u32x4*)(lds + vwoff) = v0r;
        __syncthreads();
        if (u + (int)gridDim.x < BATCH * NH * 8) UNIT_FETCH(u + (int)gridDim.x);
        float carry = 1.0f; f32x16 o[2]; o[0] = f32x16{}; o[1] = f32x16{};
        int cur = 0;
        for (int kt = NT - 1; kt >= 0; --kt) {
            u32x4 kr, vr;
            if (kt > 0) { const bf16_t* kg = kvg + (size_t)(64 * (kt - 1)) * 3072; kr = *(const u32x4*)kg; vr = *(const u32x4*)(kg + 1024); }
            const int diff = R0 - 64 * kt;
            const LAS unsigned char* kbuf = lds + cur * 8192; const LAS unsigned char* vbuf = lds + 16384 + cur * 8192 + vlane;
            bool walive = __any(carry >= 1.17549435e-38f);
            if (walive) {
            if (diff >= 64) { sb_subtile<false>(kbuf, vbuf, 1, qf, kaddr, carry, o, r32, hh); sb_subtile<false>(kbuf, vbuf, 0, qf, kaddr, carry, o, r32, hh); }
            else if (diff == 32) { sb_subtile<true>(kbuf, vbuf, 1, qf, kaddr, carry, o, r32, hh); sb_subtile<false>(kbuf, vbuf, 0, qf, kaddr, carry, o, r32, hh); }
            else if (diff == 0) { sb_subtile<true>(kbuf, vbuf, 0, qf, kaddr, carry, o, r32, hh); }
            walive = __any(carry >= 1.17549435e-38f); }
            if (kt > 0) { *(LAS u32x4*)(lds + (cur ^ 1) * 8192 + kwoff) = kr; *(LAS u32x4*)(lds + (cur ^ 1) * 8192 + vwoff) = vr; }
            if (lane == 0) flags[cur * 8 + wid] = walive ? 1u : 0u;
            __syncthreads();
            const u32x4 f0 = *(const LAS u32x4*)(flags + cur * 8), f1 = *(const LAS u32x4*)(flags + cur * 8 + 4);
            cur ^= 1;
            if (((f0.x | f0.y) | (f0.z | f0.w) | (f1.x | f1.y) | (f1.z | f1.w)) == 0u) break;
        }
        { LAS bf16_t* stg = (LAS bf16_t*)(lds + 36864 + wid * 4096);
#pragma unroll
          for (int r = 0; r < 16; ++r) { const int qq = crow(r, hh);
#pragma unroll
              for (int dh = 0; dh < 2; ++dh) stg[qq * 64 + 32 * dh + r32] = (bf16_t)(cvtpk(o[dh][r], 0.f) & 0xffffu); }
          LDS_WAIT();
          bf16_t* op = O + (rowbase + R0) * DM + h * 64;
#pragma unroll
          for (int i = 0; i < 4; ++i) { const int row = (lane >> 3) + 8 * i, ch = lane & 7; const u32x4 v = *(const LAS u32x4*)(stg + row * 64 + ch * 8); *(u32x4*)(op + (size_t)row * DM + ch * 8) = v; }
          LDS_WAIT(); }
    }
#undef UNIT_FETCH
}

template <int DL, bool FINAL> __device__ __forceinline__ void attnB_phase(LAS unsigned char* lds, const bf16_t* __restrict__ QKV, bf16_t* O, float* lse_out, const float* __restrict__ BT,
                                                                          const bf16_t* O1, const float* lse0, const float* lse1, int tid, int lane, int wid) {
    constexpr int NB = 16 / DL;
    const int r32 = lane & 31, hh = lane >> 5, half = wid >> 2, wq = wid & 3, ht = tid & 255;
    LAS unsigned char* hb = lds + half * 65536;
    LAS float* bl = (LAS float*)(lds + 131072 + half * 768);
    LAS float* scr = (LAS float*)(lds + 131072 + 1536 + wid * 512);
    LAS bf16_t* stg = (LAS bf16_t*)(lds + 131072 + 1536 + 4096 + wid * 2048);
    int kaddr[4];
#pragma unroll
    for (int dk = 0; dk < 4; ++dk) { const int c = 2 * dk + hh; kaddr[dk] = c * 2048 + ((r32 ^ c) << 4); }
    const int vlane = 16384 + (4 * hh + ((lane & 15) >> 2)) * 64 + ((lane >> 4) & 1) * 32 + (lane & 3) * 8;
    const int key_in = ht >> 3, c8 = ht & 7;
    const int kwo = c8 * 2048 + ((key_in ^ c8) << 4), vwo = 16384 + (c8 >> 2) * 8192 + key_in * 64 + (c8 & 3) * 16;
#define BLK_ISSUE(nblk, rres) do { _Pragma("unroll") for (int i_ = 0; i_ < 4; ++i_) { const bf16_t* kg_ = kvbase + (size_t)(((nblk) * 128 + 32 * i_ + key_in) * DL + (rres)) * 3072; \
        kr[i_] = *(const u32x4*)kg_; vr[i_] = *(const u32x4*)(kg_ + 1024); } } while (0)
#define BLK_WRITE(slot) do { _Pragma("unroll") for (int i_ = 0; i_ < 4; ++i_) { *(LAS u32x4*)(hb + (slot) * 32768 + kwo + 512 * i_) = kr[i_]; *(LAS u32x4*)(hb + (slot) * 32768 + vwo + 2048 * i_) = vr[i_]; } } while (0)
    for (int hidx = blockIdx.x; hidx < BATCH * NH; hidx += gridDim.x) {
        const int ub = (2 * hidx + half) * 8, bh = ub >> 4, b = bh >> 4, h = bh & 15;
        const bf16_t* kvbase = QKV + (size_t)b * SEQ * 3072 + 1024 + h * 64 + 8 * c8;
        const bf16_t* qbase = QKV + (size_t)b * SEQ * 3072 + h * 64 + 8 * hh;
        u32x4 kr[4], vr[4]; bf16x8 qf[4];
        __syncthreads();
        { const int cc = ub & 15, rr = cc / NB, n = cc % NB;
          BLK_ISSUE(n, rr); BLK_WRITE(n & 1);
          if (n > 0) { BLK_ISSUE(n - 1, rr); BLK_WRITE((n - 1) & 1); }
          if (ht < 192) bl[ht] = BT[h * 192 + ht];
          const bf16_t* qp = qbase + (size_t)((n * 128 + 32 * wq + r32) * DL + rr) * 3072;
#pragma unroll
          for (int dk = 0; dk < 4; ++dk) qf[dk] = *(const bf16x8*)(qp + 16 * dk); }
        __syncthreads();
        for (int i = 0; i < 8; ++i) {
            const int cc = (ub + i) & 15, rr = cc / NB, n = cc % NB;
            bf16x8 qn[4]; int n2 = 0;
            if (i < 7) { const int cc2 = (ub + i + 1) & 15, rr2 = cc2 / NB; n2 = cc2 % NB; BLK_ISSUE(n2, rr2);
                const bf16_t* qp = qbase + (size_t)((n2 * 128 + 32 * wq + r32) * DL + rr2) * 3072;
#pragma unroll
                for (int dk = 0; dk < 4; ++dk) qn[dk] = *(const bf16x8*)(qp + 16 * dk); }
            const int jstart = (n == 0) ? (4 - wq) : 0;
            const int par = (n - 1) & 1;
            const LAS float* blp = bl + 160 + r32 - 4 * hh;
            float mx = -INFINITY, l = 0.f; f32x16 o[2]; o[0] = f32x16{}; o[1] = f32x16{};
#pragma unroll
            for (int jj = 0; jj < 5; ++jj) {
                if (jj >= jstart) {
                    const int j = wq + jj; const LAS unsigned char* kb = hb + (par ^ (j >> 2)) * 32768 + (j & 3) * 512;
                    f32x16 s = {};
#pragma unroll
                    for (int dk = 0; dk < 4; ++dk) { const bf16x8 kf = *(const LAS bf16x8*)(kb + kaddr[dk]); s = __builtin_amdgcn_mfma_f32_32x32x16_bf16(kf, qf[dk], s, 0, 0, 0); }
                    float rm = -INFINITY;
#pragma unroll
                    for (int r = 0; r < 16; ++r) { const int kk = crow(r, hh); float v = s[r] + blp[-(32 * jj + (r & 3) + 8 * (r >> 2))];
                        if (jj == 0) v = (kk >= r32) ? v : -INFINITY;
                        if (jj == 4) v = (kk <= r32) ? v : -INFINITY;
                        s[r] = v; rm = fmaxf(rm, v); }
                    rm = fmaxf(rm, __shfl_xor(rm, 32));
                    const bool up = rm > mx + 8.0f;
                    if (__any(up)) {
                        const float mnew = up ? rm : mx; const float f = __builtin_amdgcn_exp2f(mx - mnew); l *= f; mx = mnew;
                        if (hh == 0) scr[r32] = f;
                        LDS_WAIT();
#pragma unroll
                        for (int r = 0; r < 16; ++r) { const float fr = scr[crow(r, hh)]; o[0][r] *= fr; o[1][r] *= fr; }
                        LDS_WAIT();
                    }
                    float pe[16];
#pragma unroll
                    for (int r = 0; r < 16; ++r) { pe[r] = __builtin_amdgcn_exp2f(s[r] - mx); l += pe[r]; }
                    const bf16x8 pf0 = pack8(pe), pf1 = pack8(pe + 8);
                    const LAS unsigned char* vb = hb + (par ^ (j >> 2)) * 32768 + (j & 3) * 2048 + vlane;
#pragma unroll
                    for (int dh = 0; dh < 2; ++dh) {
                        const bf16x8 v0 = vfrag(vb + dh * 8192), v1 = vfrag(vb + dh * 8192 + 16 * 64);
                        o[dh] = __builtin_amdgcn_mfma_f32_32x32x16_bf16(pf0, v0, o[dh], 0, 0, 0);
                        o[dh] = __builtin_amdgcn_mfma_f32_32x32x16_bf16(pf1, v1, o[dh], 0, 0, 0);
                    }
                }
            }
            l += __shfl_xor(l, 32);
            const float lse2 = mx + __builtin_amdgcn_logf(l);
            const size_t rowq0 = (size_t)b * SEQ + (size_t)((n * 128 + 32 * wq) * DL + rr);
            if (hh == 0) { scr[r32] = __builtin_amdgcn_rcpf(l);
                if (!FINAL) lse_out[(rowq0 + (size_t)r32 * DL) * 16 + h] = lse2;
                else { const size_t rg = (rowq0 + (size_t)r32 * DL) * 16 + h; const float l0 = lse0[rg], l1 = lse1[rg];
                    const float M = fmaxf(fmaxf(l0, l1), lse2); const float e0 = __builtin_amdgcn_exp2f(l0 - M), e1 = __builtin_amdgcn_exp2f(l1 - M), e2 = __builtin_amdgcn_exp2f(lse2 - M);
                    const float inv = __builtin_amdgcn_rcpf(e0 + e1 + e2); scr[32 + r32] = e0 * inv; scr[64 + r32] = e1 * inv; scr[96 + r32] = e2 * inv; } }
            LDS_WAIT();
            float linv[16];
#pragma unroll
            for (int r = 0; r < 16; ++r) linv[r] = scr[crow(r, hh)];
#pragma unroll
            for (int dh = 0; dh < 2; ++dh) {
#pragma unroll
                for (int r = 0; r < 16; ++r) stg[crow(r, hh) * 32 + r32] = (bf16_t)(cvtpk(o[dh][r] * linv[r], 0.f) & 0xffffu);
                LDS_WAIT();
#pragma unroll
                for (int i = 0; i < 2; ++i) { const int row = (lane >> 2) + 16 * i, ch = lane & 3; u32x4 v = *(const LAS u32x4*)(stg + row * 32 + ch * 8);
                    bf16_t* op = O + (rowq0 + (size_t)row * DL) * DM + h * 64 + 32 * dh + ch * 8;
                    if (FINAL) { const u32x4 a0 = *(const u32x4*)op, a1 = *(const u32x4*)(O1 + (rowq0 + (size_t)row * DL) * DM + h * 64 + 32 * dh + ch * 8);
                        const float w0 = scr[32 + row], w1 = scr[64 + row], w2 = scr[96 + row];
#define CMB(c) cvtpk(w0 * bf_lo(a0.c) + w1 * bf_lo(a1.c) + w2 * bf_lo(v.c), w0 * bf_hi(a0.c) + w1 * bf_hi(a1.c) + w2 * bf_hi(v.c))
                        u32x4 w; w.x = CMB(x); w.y = CMB(y); w.z = CMB(z); w.w = CMB(w); v = w;
#undef CMB
                    }
                    *(u32x4*)op = v; }
                LDS_WAIT();
            }
            __syncthreads();
            if (i < 7) { BLK_WRITE(n2 & 1);
#pragma unroll
                for (int dk = 0; dk < 4; ++dk) qf[dk] = qn[dk]; }
            __syncthreads();
        }
    }
#undef BLK_ISSUE
#undef BLK_WRITE
}

#define XB_TMO      128
#define XB_XCNT(j)  (256  + 64 * (j))
#define XB_XSUB(j)  (1280 + 64 * (j))
#define XB_XGEN(j)  (2304 + 64 * (j))
#define XB_TOP      3328
#define XB_TOPGEN   3392
#define XCD_BAR_WORDS 3456
#define XB_SPIN_CAP (1u << 18)

__device__ __forceinline__ unsigned xb_ld(unsigned* p)              { return __hip_atomic_load(p, __ATOMIC_RELAXED, __HIP_MEMORY_SCOPE_AGENT); }
__device__ __forceinline__ unsigned xb_add(unsigned* p, unsigned v) { return __hip_atomic_fetch_add(p, v, __ATOMIC_RELAXED, __HIP_MEMORY_SCOPE_AGENT); }
__device__ __forceinline__ unsigned xb_xcc_id() { return (unsigned)__builtin_amdgcn_s_getreg((3 << 11) | 20) & 0xFu; }
#define XB_SPIN(cond, bar) do { unsigned _sp = 0; while (cond) { __builtin_amdgcn_s_sleep(1); \
    if ((++_sp & 255u) == 0u) { if (xb_ld(&(bar)[XB_TMO])) break; if (_sp > XB_SPIN_CAP) { atomicAdd(&(bar)[XB_TMO], 1u); break; } } } } while (0)

struct XcdBarrier {
    unsigned* bar; unsigned x;
    volatile LAS unsigned* st;
};

__device__ __forceinline__ XcdBarrier xcd_barrier_post(unsigned* bar, volatile LAS unsigned* st) {
    XcdBarrier b; b.bar = bar; b.x = xb_xcc_id(); b.st = st;
    if (threadIdx.x == 0) (void)xb_add(&bar[XB_XCNT(b.x)], 1u);
    return b;
}
__device__ __forceinline__ void xcd_barrier_complete(unsigned* bar, unsigned x, unsigned& nloc, unsigned& nx) {
    const unsigned G = gridDim.x * gridDim.y * gridDim.z;
    unsigned sum, cnt, mine, sp = 0u;
    for (;;) {
        sum = 0u; cnt = 0u; mine = 0u;
#pragma unroll
        for (unsigned j = 0; j < 16; ++j) { const unsigned c = xb_ld(&bar[XB_XCNT(j)]); sum += c; cnt += (c > 0u) ? 1u : 0u; mine = (j == x) ? c : mine; }
        if (sum == G) break;
        __builtin_amdgcn_s_sleep(1);
        if ((++sp & 255u) == 0u) { if (xb_ld(&bar[XB_TMO])) break; if (sp > XB_SPIN_CAP) { atomicAdd(&bar[XB_TMO], 1u); break; } }
    }
    nloc = mine > 0u ? mine : 1u; nx = cnt > 0u ? cnt : 1u;
}

__device__ __forceinline__ void xcd_barrier(const XcdBarrier& b) {
    asm volatile("s_waitcnt vmcnt(0)" ::: "memory");
    __syncthreads();
    if (threadIdx.x == 0) {
        unsigned* bar = b.bar; asm volatile("" : "+s"(bar)); unsigned bx = b.x; asm volatile("" : "+s"(bx));
        __builtin_amdgcn_s_waitcnt(0);
        unsigned nloc = b.st[0], nx = b.st[1];
        if (nloc == 0u) { xcd_barrier_complete(bar, bx, nloc, nx); b.st[0] = nloc; b.st[1] = nx; }
        const unsigned old = xb_add(&bar[XB_XSUB(bx)], 1u);
        const unsigned gen = old / nloc;
        if (old + 1u == (gen + 1u) * nloc) {
            __builtin_amdgcn_fence(__ATOMIC_RELEASE, "agent");
            asm volatile("s_waitcnt vmcnt(0)" ::: "memory");
            const unsigned og = xb_add(&bar[XB_TOP], 1u);
            const unsigned tg = og / nx;
            if (og + 1u == (tg + 1u) * nx) xb_add(&bar[XB_TOPGEN], 1u);
            else XB_SPIN(xb_ld(&bar[XB_TOPGEN]) == tg, bar);
            __builtin_amdgcn_fence(__ATOMIC_ACQUIRE, "agent");
            asm volatile("s_waitcnt vmcnt(0)" ::: "memory");
        } else {
            XB_SPIN(xb_ld(&bar[XB_TOPGEN]) == gen, bar);
            __builtin_amdgcn_fence(__ATOMIC_ACQUIRE, "agent");
            asm volatile("s_waitcnt vmcnt(0)" ::: "memory");
        }
    }
    __syncthreads();
}

constexpr int PROBE_BAR = 0;
constexpr int PROBE_DUP = -1;
enum { K_PRO = 0, K_GS, K_GW, K_NR, K_AA, K_AB0, K_AB1, K_AB2 };
__global__ void __launch_bounds__(512, 2) yoco_fwd(Params P) {
    extern __shared__ __attribute__((aligned(16))) unsigned char lds_raw[];
    LAS unsigned char* lds = (LAS unsigned char*)lds_raw;
    cg::grid_group grid = cg::this_grid();
    volatile LAS unsigned* xst = (volatile LAS unsigned*)(lds + LDS_BYTES - 16);
    if (threadIdx.x < 4) xst[threadIdx.x] = 0u;
    __syncthreads();
    XcdBarrier xb = xcd_barrier_post((unsigned*)P.ws, xst);
    grid.sync();
#define PH_BEGIN() int tid = threadIdx.x; asm volatile("" : "+v"(tid)); const int lane = tid & 63, wid = __builtin_amdgcn_readfirstlane(tid >> 6); \
        unsigned char* ws = P.ws; asm volatile("" : "+s"(ws)); (void)lane; (void)wid;
#define BARRIER() do { for (int k_ = 0; k_ < 1 + PROBE_BAR; ++k_) xcd_barrier(xb); } while (0)
#define REPS(ph) for (int rep_ = 0; rep_ < ((PROBE_DUP == (ph)) ? 2 : 1); ++rep_)
#define PH_GS(ph, AOFF, BOFF, N_, K_, OOFF, RSP) { PH_BEGIN(); REPS(ph) { pg8::Gemm g{(const bf16_t*)(ws + (AOFF)), (const bf16_t*)(ws + (BOFF)), MROWS, N_, K_}; pg8::StaticOrder S; S.init(MROWS, N_, (int)gridDim.x, (int)blockIdx.x); \
        pg8::EpiStore E{(bf16_t*)(ws + (OOFF)), N_, RSP}; pg8::gemm_phase<pg8::EpiStore, pg8::StaticOrder, true, true>(lds, g, S, E); } } BARRIER();
#define PH_GW(ph, BOFF) { PH_BEGIN(); REPS(ph) { pg8::Gemm g{(const bf16_t*)(ws + WS_XN), (const bf16_t*)(ws + (BOFF)), MROWS, 2 * DFF, DM}; pg8::StaticOrder S; S.init(MROWS, 2 * DFF, (int)gridDim.x, (int)blockIdx.x); \
        pg8::EpiSwiglu E{(bf16_t*)(ws + WS_ACT), DFF, (const float*)(ws + WS_RS)}; pg8::gemm_phase<pg8::EpiSwiglu, pg8::StaticOrder, true, true>(lds, g, S, E); } } BARRIER();
#define PH_NR(XIN32, OUT32, GI) { PH_BEGIN(); norm_res_phase<XIN32, OUT32>((const bf16_t*)(ws + WS_H), P.gains + (GI) * DM, P.x, (bf16_t*)(ws + WS_XN), (float*)(ws + WS_RS), P.out, lane, wid); }
#define RSV ((const float*)(ws + WS_RS))
#define RS0 ((const float*)nullptr)
    { PH_BEGIN(); REPS(0) { prologue(P, lds, tid, lane, wid); } } BARRIER();
    PH_GS(1, WS_XN, WS_WQKVA, 3072, 1024, WS_QKV, RSV)
    { PH_BEGIN(); REPS(2) { attnA_phase(lds, (const bf16_t*)(ws + WS_QKV), (bf16_t*)(ws + WS_OB), tid, lane, wid); } } BARRIER();
    PH_GS(3, WS_OB, WS_WOA, 1024, 1024, WS_H, RS0)
    PH_NR(true, false, 1) BARRIER();
    PH_GW(5, WS_WGU0)
    PH_GS(6, WS_ACT, WS_WD0, 1024, DFF, WS_H, RS0)
    PH_NR(false, false, 3) BARRIER();
    PH_GS(8, WS_XN, WS_WB, 3072, 1024, WS_QKV, RSV)
    { PH_BEGIN(); REPS(9) { attnB_phase<1, false>(lds, (const bf16_t*)(ws + WS_QKV), (bf16_t*)(ws + WS_OB), (float*)(ws + WS_LSE0), (const float*)(ws + WS_BIAS), nullptr, nullptr, nullptr, tid, lane, wid); } } BARRIER();
    PH_GS(10, WS_XN, WS_WB + 6 * MiB, 3072, 1024, WS_QKV, RSV)
    { PH_BEGIN(); REPS(11) { attnB_phase<4, false>(lds, (const bf16_t*)(ws + WS_QKV), (bf16_t*)(ws + WS_H), (float*)(ws + WS_LSE1), (const float*)(ws + WS_BIAS) + 3072, nullptr, nullptr, nullptr, tid, lane, wid); } } BARRIER();
    PH_GS(12, WS_XN, WS_WB + 12 * MiB, 3072, 1024, WS_QKV, RSV)
    { PH_BEGIN(); attnB_phase<16, true>(lds, (const bf16_t*)(ws + WS_QKV), (bf16_t*)(ws + WS_OB), nullptr, (const float*)(ws + WS_BIAS) + 6144, (const bf16_t*)(ws + WS_H), (const float*)(ws + WS_LSE0), (const float*)(ws + WS_LSE1), tid, lane, wid); } BARRIER();
    PH_GS(14, WS_OB, WS_WOB, 1024, 1024, WS_H, RS0)
    PH_NR(false, false, 5) BARRIER();
    PH_GW(16, WS_WGU1)
    PH_GS(17, WS_ACT, WS_WD1, 1024, DFF, WS_H, RS0)
    PH_NR(false, true, 7)
}

extern "C" void kernel_launch(void* const* d_in, const int* in_sizes, int n_in, void* d_out, int out_size, void* d_ws, size_t ws_size, hipStream_t stream) {
    static int grid = 0;
    if (grid == 0) {
        if (n_in != 11 || out_size != MROWS * DM || ws_size < WS_END) { fprintf(stderr, "kernel_launch: unexpected shapes (n_in %d, out %d, ws %zu)\n", n_in, out_size, ws_size); grid = -1; return; }
        int dev = 0, cus = 0, per_cu = 0;
        (void)hipGetDevice(&dev); (void)hipDeviceGetAttribute(&cus, hipDeviceAttributeMultiprocessorCount, dev);
        if (hipFuncSetAttribute((const void*)yoco_fwd, hipFuncAttributeMaxDynamicSharedMemorySize, LDS_BYTES) != hipSuccess) { fprintf(stderr, "kernel_launch: hipFuncSetAttribute failed\n"); grid = -1; return; }
        if (hipOccupancyMaxActiveBlocksPerMultiprocessor(&per_cu, (const void*)yoco_fwd, 512, LDS_BYTES) != hipSuccess || per_cu < 1) { fprintf(stderr, "kernel_launch: occupancy query failed (%d)\n", per_cu); per_cu = 1; }
        (void)hipGetLastError();
        grid = cus * per_cu;
        if (grid <= 0) grid = 256;
    }
    if (grid < 0) return;
    if (hipMemsetAsync(d_ws, 0, 131072, stream) != hipSuccess) { fprintf(stderr, "kernel_launch: memset failed\n"); return; }
    Params p{};
    p.x = (const float*)d_in[0]; p.gains = (const float*)d_in[1]; p.w_qkv_a = (const float*)d_in[2]; p.w_o_a = (const float*)d_in[3]; p.g_kv = (const float*)d_in[4];
    p.w_kv_b = (const float*)d_in[5]; p.w_q_b = (const float*)d_in[6]; p.w_o_b = (const float*)d_in[7]; p.rel_bias = (const float*)d_in[8]; p.w_gu = (const float*)d_in[9]; p.w_down = (const float*)d_in[10];
    p.out = (float*)d_out; p.ws = (unsigned char*)d_ws;
    void* args[] = {&p};
    const hipError_t e = hipLaunchCooperativeKernel((const void*)yoco_fwd, dim3(grid), dim3(512), args, LDS_BYTES, stream);
    if (e != hipSuccess) fprintf(stderr, "kernel_launch: cooperative launch failed: %s (grid %d)\n", hipGetErrorString(e), grid);
}
```
